# Optimizing an MI355X kernel written in HIP

```python
import math
import jax, jax.numpy as jnp
from jax import lax
import numpy as np

D_MODEL = 2048
BATCH = 4
SEQ = 4096
DEPTH = 2

CHUNK = 64
Q_BLOCK = 128
MIX_WIDTH = D_MODEL
DIFF_WIDTH = MIX_WIDTH // 2
MLA_WIDTH = MIX_WIDTH - DIFF_WIDTH
DIFF_HEAD_DIM = 64
DIFF_HEADS = DIFF_WIDTH // (2 * DIFF_HEAD_DIM)
MLA_V_DIM = 128
MLA_HEADS = MLA_WIDTH // MLA_V_DIM
MLA_NOPE = 128
MLA_ROPE = 64
MLA_Q_LORA = 512
MLA_KV_LORA = 256
ROPE_BASE = 10000.0
REL_BUCKETS = 32
REL_MAX_DIST = 128
N_BIAS_HEADS = 2 * DIFF_HEADS
EPS = 1e-6
NEG = -1e30
SPLIT_SIZES = (
    DIFF_HEADS * 2 * DIFF_HEAD_DIM,
    DIFF_HEADS * 2 * DIFF_HEAD_DIM,
    DIFF_HEADS * 2 * DIFF_HEAD_DIM,
    MLA_Q_LORA,
    MLA_KV_LORA,
    MLA_ROPE,
    MIX_WIDTH,
)
IN_WIDTH = sum(SPLIT_SIZES)

kernel_name = 'hybrid_diffattn_mla_chunk_causal'


def _rmsnorm(x, g):
    xf = x.astype(jnp.float32)
    y = xf * lax.rsqrt(jnp.mean(xf * xf, axis=-1, keepdims=True) + EPS)
    return (y * g.astype(jnp.float32)).astype(x.dtype)


def _rel_bucket(rel):
    nb = REL_BUCKETS // 2
    max_exact = nb // 2
    ret = (rel > 0).astype(jnp.int32) * nb
    n = jnp.abs(rel)
    nf = jnp.maximum(n, 1).astype(jnp.float32)
    large = max_exact + (jnp.log(nf / max_exact) / math.log(REL_MAX_DIST / max_exact)
                         * (nb - max_exact)).astype(jnp.int32)
    large = jnp.minimum(large, nb - 1)
    return ret + jnp.where(n < max_exact, n, large)


def _chunk_mask(qs, ke):
    qpos = jnp.arange(qs, qs + Q_BLOCK)
    kpos = jnp.arange(ke)
    allowed = (kpos[None, :] // CHUNK) <= (qpos[:, None] // CHUNK)
    return qpos, kpos, allowed


def _rope(x, cos, sin):
    half = x.shape[-1] // 2
    x1 = x[..., :half].astype(jnp.float32)
    x2 = x[..., half:].astype(jnp.float32)
    return jnp.concatenate([x1 * cos - x2 * sin, x1 * sin + x2 * cos], axis=-1).astype(x.dtype)


def _diff_attention(q1, q2, k1, k2, v, lam, rel_bias):
    S = q1.shape[2]
    scale = DIFF_HEAD_DIM ** -0.5
    outs = []
    for qs in range(0, S, Q_BLOCK):
        ke = qs + Q_BLOCK
        qpos, kpos, allowed = _chunk_mask(qs, ke)
        bias = rel_bias[_rel_bucket(kpos[None, :] - qpos[:, None])].astype(jnp.float32)
        bias = bias.transpose(2, 0, 1).reshape(DIFF_HEADS, 2, Q_BLOCK, ke)

        def probs(qm, km, m):
            s = jnp.einsum('bhqd,bhkd->bhqk', qm[:, :, qs:ke], km[:, :, :ke]).astype(jnp.float32)
            s = s * scale + bias[:, m]
            return jax.nn.softmax(jnp.where(allowed, s, NEG), axis=-1)

        p = probs(q1, k1, 0) - lam * probs(q2, k2, 1)
        outs.append(jnp.einsum('bhqk,bhkd->bhqd', p.astype(v.dtype), v[:, :, :ke]))
    return jnp.concatenate(outs, axis=2)


def _mla_attention(qn, qr, kn, kr, v):
    S = qn.shape[2]
    scale = (MLA_NOPE + MLA_ROPE) ** -0.5
    outs = []
    for qs in range(0, S, Q_BLOCK):
        ke = qs + Q_BLOCK
        _, _, allowed = _chunk_mask(qs, ke)
        s = (jnp.einsum('bhqd,bhkd->bhqk', qn[:, :, qs:ke], kn[:, :, :ke])
             + jnp.einsum('bhqr,bkr->bhqk', qr[:, :, qs:ke], kr[:, :ke])).astype(jnp.float32) * scale
        p = jax.nn.softmax(jnp.where(allowed, s, NEG), axis=-1)
        outs.append(jnp.einsum('bhqk,bhkd->bhqd', p.astype(v.dtype), v[:, :, :ke]))
    return jnp.concatenate(outs, axis=2)


def setup_inputs(seed: int = 0) -> dict:
    key = jax.random.key(seed)
    ks = jax.random.split(key, 12)

    def nrm(k, shape, s):
        return jax.random.normal(k, shape, jnp.float32) * s

    return {
        'x': nrm(ks[0], (BATCH, SEQ, D_MODEL), 1.0),
        'norm_g': 1.0 + nrm(ks[1], (DEPTH, D_MODEL), 0.02),
        'w_in': nrm(ks[2], (DEPTH, D_MODEL, IN_WIDTH), D_MODEL ** -0.5),
        'diff_lambda': nrm(ks[3], (DEPTH, 4, DIFF_HEAD_DIM), 0.1),
        'diff_subln_g': 1.0 + nrm(ks[4], (DEPTH, 2 * DIFF_HEAD_DIM), 0.02),
        'mla_q_norm_g': 1.0 + nrm(ks[5], (DEPTH, MLA_Q_LORA), 0.02),
        'mla_w_q_b': nrm(ks[6], (DEPTH, MLA_Q_LORA, MLA_HEADS * (MLA_NOPE + MLA_ROPE)), MLA_Q_LORA ** -0.5),
        'mla_kv_norm_g': 1.0 + nrm(ks[7], (DEPTH, MLA_KV_LORA), 0.02),
        'mla_w_kv_b': nrm(ks[8], (DEPTH, MLA_KV_LORA, MLA_HEADS * (MLA_NOPE + MLA_V_DIM)), MLA_KV_LORA ** -0.5),
        'w_out': nrm(ks[9], (DEPTH, MIX_WIDTH, D_MODEL), MIX_WIDTH ** -0.5),
        'rel_bias': nrm(ks[10], (REL_BUCKETS, N_BIAS_HEADS), 0.2),
        'final_norm_g': 1.0 + nrm(ks[11], (D_MODEL,), 0.02),
    }


def reference(x, norm_g, w_in, diff_lambda, diff_subln_g, mla_q_norm_g, mla_w_q_b,
              mla_kv_norm_g, mla_w_kv_b, w_out, rel_bias, final_norm_g):
    B, S, _ = x.shape
    offs = [sum(SPLIT_SIZES[:i + 1]) for i in range(len(SPLIT_SIZES) - 1)]

    pos = jnp.arange(S, dtype=jnp.float32)
    inv_freq = ROPE_BASE ** (-jnp.arange(0, MLA_ROPE, 2, dtype=jnp.float32) / MLA_ROPE)
    ang = pos[:, None] * inv_freq[None, :]
    cos, sin = jnp.cos(ang), jnp.sin(ang)

    for l in range(DEPTH):
        h = _rmsnorm(x, norm_g[l])
        proj = jnp.einsum('bsd,de->bse', h, w_in[l])
        dq, dk, dv, cq, ckv, kr, gate = jnp.split(proj, offs, axis=-1)

        dq = dq.reshape(B, S, DIFF_HEADS, 2, DIFF_HEAD_DIM).transpose(0, 2, 3, 1, 4)
        dk = dk.reshape(B, S, DIFF_HEADS, 2, DIFF_HEAD_DIM).transpose(0, 2, 3, 1, 4)
        dv = dv.reshape(B, S, DIFF_HEADS, 2 * DIFF_HEAD_DIM).transpose(0, 2, 1, 3)
        lam_init = 0.8 - 0.6 * math.exp(-0.3 * l)
        lp = diff_lambda[l].astype(jnp.float32)
        lam = jnp.exp(jnp.sum(lp[0] * lp[1])) - jnp.exp(jnp.sum(lp[2] * lp[3])) + lam_init
        o_a = _diff_attention(dq[:, :, 0], dq[:, :, 1], dk[:, :, 0], dk[:, :, 1], dv, lam, rel_bias)
        o_a = _rmsnorm(o_a, diff_subln_g[l]) * (1.0 - lam_init)
        o_a = o_a.transpose(0, 2, 1, 3).reshape(B, S, DIFF_WIDTH)

        q = jnp.einsum('bsr,re->bse', _rmsnorm(cq, mla_q_norm_g[l]), mla_w_q_b[l])
        q = q.reshape(B, S, MLA_HEADS, MLA_NOPE + MLA_ROPE)
        q_nope = q[..., :MLA_NOPE].transpose(0, 2, 1, 3)
        q_rope = _rope(q[..., MLA_NOPE:], cos[None, :, None, :], sin[None, :, None, :]).transpose(0, 2, 1, 3)
        kv = jnp.einsum('bsr,re->bse', _rmsnorm(ckv, mla_kv_norm_g[l]), mla_w_kv_b[l])
        kv = kv.reshape(B, S, MLA_HEADS, MLA_NOPE + MLA_V_DIM)
        k_nope = kv[..., :MLA_NOPE].transpose(0, 2, 1, 3)
        v_b = kv[..., MLA_NOPE:].transpose(0, 2, 1, 3)
        k_rope = _rope(kr, cos[None], sin[None])
        o_b = _mla_attention(q_nope, q_rope, k_nope, k_rope, v_b)
        o_b = o_b.transpose(0, 2, 1, 3).reshape(B, S, MLA_WIDTH)

        y = jnp.concatenate([o_a, o_b], axis=-1) * jax.nn.silu(gate)
        x = x + jnp.einsum('bse,ed->bsd', y, w_out[l])

    return _rmsnorm(x, final_norm_g)
```

```cpp
#include <hip/hip_runtime.h>
#include <hip/hip_cooperative_groups.h>
#include <cstdio>
#include <cstdint>
namespace cg = cooperative_groups;

constexpr int BATCH = 4, SEQ = 4096, DM = 2048, MROWS = BATCH * SEQ, DEPTH = 2;
constexpr int NIN = 5952, NINP = 6144;
constexpr int QLORA = 512, KVLORA = 256, NQB = 1536, NKVB = 2048;
constexpr float EPS = 1e-6f;
constexpr float LOG2E = 1.4426950408889634f;
namespace pg8 {
#define PG8_LAS __attribute__((address_space(3)))
typedef unsigned short bf16_t;
typedef short bf16x8 __attribute__((ext_vector_type(8)));
typedef float f32x4 __attribute__((ext_vector_type(4)));
typedef unsigned u32x4 __attribute__((ext_vector_type(4)));
constexpr int BM = 256, BK = 64, HALF = 128, HTB = HALF * BK * 2  , STAGE_BYTES = 8 * HTB, NXCD = 8, WGM = 8;

__host__ __device__ __forceinline__ int lds_byte(int r, int c) { const int st = (r >> 4) * 2 + (c >> 5), rr = r & 15, cc = c & 31, ob = rr * 64 + cc * 2; return st * 1024 + (ob ^ (((ob >> 9) & 1) << 5)); }
__host__ __device__ __forceinline__ void stage_rc(int b, int& R, int& C) { const int st = b / 1024, sb = b % 1024, swz = sb ^ (((sb >> 9) & 1) << 5); R = (st >> 1) * 16 + swz / 64; C = (st & 1) * 32 + (swz % 64) / 2; }
__host__ __device__ __forceinline__ int perm32(int rho) { const int n = rho >> 4, i = rho & 15; return 8 * (i >> 2) + 4 * n + (i & 3); }

struct Unit { int pm, pn; };
struct Gemm { const bf16_t* A; const bf16_t* Bt; int M, N, K; };

struct StaticOrder {
    int nM, nN, nwg, G, c;
    __host__ __device__ void init(int M, int N, int G_, int c_) { nM = M / BM; nN = N / BM; nwg = nM * nN; G = G_; c = c_; }
    __host__ __device__ bool next(int i, Unit& u) const {
        const long L = (long)i * G + c; if (L >= nwg) return false;
        int wgid = (int)L; { const int q = nwg / NXCD, r = nwg % NXCD, xcd = wgid % NXCD, off = wgid / NXCD; wgid = (xcd < r ? xcd * (q + 1) : r * (q + 1) + (xcd - r) * q) + off; }
        const int nig = WGM * nN, gid = wgid / nig, fm = gid * WGM, gsz = (nM - fm) < WGM ? (nM - fm) : WGM;
        u.pm = fm + ((wgid % nig) % gsz); u.pn = (wgid % nig) / gsz; return true;
    }
    __device__ __forceinline__ void a_ready(const Unit&) const {}
    __device__ __forceinline__ void done(const Unit&) const {}
};

__device__ __forceinline__ unsigned cvt_pk_bf16(float lo, float hi) { unsigned r; asm volatile("v_cvt_pk_bf16_f32 %0, %1, %2" : "=v"(r) : "v"(lo), "v"(hi)); return r; }
typedef float f32x2 __attribute__((ext_vector_type(2)));
struct EpiInProj {
    static constexpr bool PERM = true, AFTER_DRAIN = false;
    bf16_t *QKV, *CQ, *CKV, *KR, *GATE; const float* ropec; const float* ropes;
    __device__ __forceinline__ void operator()(const f32x4 (&acc)[2][2][4][2], const Unit& u, int wr, int wc, int fr, int fq) const {
        const int row0 = u.pm * BM + wr * 64 + fr; const int pn = u.pn;
        if (pn == 15) {
            if (wc < 2) {
                const int a = wc * 4 + fq;
#pragma unroll
                for (int ai = 0; ai < 2; ++ai)
#pragma unroll
                    for (int m = 0; m < 4; ++m) { const int row = row0 + ai * HALF + m * 16, s = row & (SEQ - 1);
                        const f32x4 c = *(const f32x4*)(ropec + s * 32 + 4 * a), sn = *(const f32x4*)(ropes + s * 32 + 4 * a);
                        const f32x4 x1 = acc[ai][0][m][0], x2 = acc[ai][0][m][1];
                        const f32x4 y1 = x1 * c - x2 * sn, y2 = x1 * sn + x2 * c;
                        u32x4 w; w.x = cvt_pk_bf16(y1[0], y1[1]); w.y = cvt_pk_bf16(y1[2], y1[3]); w.z = cvt_pk_bf16(y2[0], y2[1]); w.w = cvt_pk_bf16(y2[2], y2[3]);
                        *(u32x4*)(KR + (size_t)row * 64 + 8 * a) = w; }
            }
            return;
        }
        bf16_t* base; int ldc, colt;
        if (pn < 12) { base = QKV; ldc = 3072; colt = pn * 256; }
        else if (pn < 14) { base = CQ; ldc = 512; colt = (pn - 12) * 256; }
        else if (pn == 14) { base = CKV; ldc = 256; colt = 0; }
        else { base = GATE; ldc = 2048; colt = (pn - 16) * 256; }
        const int col0 = colt + wc * 32 + 8 * fq;
#pragma unroll
        for (int ai = 0; ai < 2; ++ai)
#pragma unroll
            for (int m = 0; m < 4; ++m) { bf16_t* rowp = base + (size_t)(row0 + ai * HALF + m * 16) * ldc + col0;
#pragma unroll
                for (int bj = 0; bj < 2; ++bj) { const f32x4 v0 = acc[ai][bj][m][0], v1 = acc[ai][bj][m][1];
                    u32x4 w; w.x = cvt_pk_bf16(v0[0], v0[1]); w.y = cvt_pk_bf16(v0[2], v0[3]); w.z = cvt_pk_bf16(v1[0], v1[1]); w.w = cvt_pk_bf16(v1[2], v1[3]);
                    *(u32x4*)(rowp + bj * HALF) = w; } }
    }
};
template <bool ROPE> struct EpiRowScale {
    static constexpr bool PERM = true, AFTER_DRAIN = false;
    bf16_t* O; int ldc; const float* rs; const float* ropec; const float* ropes;
    __device__ __forceinline__ void operator()(const f32x4 (&acc)[2][2][4][2], const Unit& u, int wr, int wc, int fr, int fq) const {
        const int row0 = u.pm * BM + wr * 64 + fr; const int col0 = u.pn * BM + wc * 32 + 8 * fq;
        bool isr[2]; int ra[2];
#pragma unroll
        for (int bj = 0; bj < 2; ++bj) { const int c0 = col0 + bj * HALF, off = c0 % 192; isr[bj] = ROPE && (off >= 128); ra[bj] = (off - 128) >> 3; }
#pragma unroll
        for (int ai = 0; ai < 2; ++ai)
#pragma unroll
            for (int m = 0; m < 4; ++m) { const int row = row0 + ai * HALF + m * 16, s = row & (SEQ - 1); const float r = rs[row];
                bf16_t* rowp = O + (size_t)row * ldc + col0;
#pragma unroll
                for (int bj = 0; bj < 2; ++bj) { f32x4 v0 = acc[ai][bj][m][0] * r, v1 = acc[ai][bj][m][1] * r;
                    if (ROPE) { if (isr[bj]) { const f32x4 c = *(const f32x4*)(ropec + s * 32 + 4 * ra[bj]), sn = *(const f32x4*)(ropes + s * 32 + 4 * ra[bj]);
                        const f32x4 y1 = v0 * c - v1 * sn, y2 = v0 * sn + v1 * c; v0 = y1; v1 = y2; } }
                    u32x4 w; w.x = cvt_pk_bf16(v0[0], v0[1]); w.y = cvt_pk_bf16(v0[2], v0[3]); w.z = cvt_pk_bf16(v1[0], v1[1]); w.w = cvt_pk_bf16(v1[2], v1[3]);
                    *(u32x4*)(rowp + bj * HALF) = w; } }
    }
};
struct EpiResF32 {
    static constexpr bool PERM = false, AFTER_DRAIN = false;
    const float* base; float* out; int ldc;
    __device__ __forceinline__ void operator()(const f32x4 (&acc)[2][2][4][2], const Unit& u, int wr, int wc, int fr, int fq) const {
        const int row0 = u.pm * BM + wr * 64 + fr, col0 = u.pn * BM + wc * 32 + 4 * fq;
#pragma unroll
        for (int ai = 0; ai < 2; ++ai)
#pragma unroll
            for (int m = 0; m < 4; ++m) { const size_t off = (size_t)(row0 + ai * HALF + m * 16) * ldc + col0;
#pragma unroll
                for (int bj = 0; bj < 2; ++bj)
#pragma unroll
                    for (int n = 0; n < 2; ++n) { const f32x4 bs = *(const f32x4*)(base + off + bj * HALF + n * 16); *(f32x4*)(out + off + bj * HALF + n * 16) = bs + acc[ai][bj][m][n]; } }
    }
};
template <class Epi, class Sched, bool ALIGN_EPI = false, bool SP2 = false>
__device__ __forceinline__ void gemm_phase(PG8_LAS unsigned char* lds, const Gemm g, const Sched& S, const Epi& E) {
    int tid_ = threadIdx.x; asm volatile("" : "+v"(tid_));
    const int tid = tid_, wid = __builtin_amdgcn_readfirstlane(tid >> 6), lane = tid & 63, wr = wid >> 2, wc = wid & 3, fr = lane & 15, fq = lane >> 4;
    const int K = g.K, nt = K / BK;
    unsigned voffA[2], voffB[2];
#pragma unroll
    for (int i = 0; i < 2; ++i) { int R, C; stage_rc(tid * 16 + i * 8192, R, C); const int Rb = Epi::PERM ? ((R & ~31) + perm32(R & 31)) : R;
        voffA[i] = (unsigned)(R * K + C) * 2u; voffB[i] = (unsigned)(Rb * K + C) * 2u; }
    const size_t kstep = (size_t)(BK * 2);
    const size_t hstep = (size_t)HALF * K * 2;
    const size_t tstep = 2 * hstep;
    const unsigned ldsw = (unsigned)wid * 1024u;
    const int aoff = lds_byte(wr * 64 + fr, fq * 8), boff = lds_byte(wc * 32 + fr, fq * 8);
#define PG8_SA(b, h) (((b) * 2 + (h)) * HTB)
#define PG8_SB(b, h) ((4 + (b) * 2 + (h)) * HTB)
#define PG8_STAGE(bufoff, gbase, voff) do { _Pragma("unroll") for (int _i = 0; _i < 2; ++_i) \
        __builtin_amdgcn_global_load_lds((const unsigned*)((const char*)(gbase) + (voff)[_i]), (PG8_LAS unsigned*)(lds + (bufoff) + ldsw + _i * 8192), 16, 0, 0); } while (0)
#define PG8_LDA(dst, b, h) do { _Pragma("unroll") for (int m = 0; m < 4; ++m) _Pragma("unroll") for (int k = 0; k < 2; ++k) dst[m][k] = *(const PG8_LAS bf16x8*)(lds + PG8_SA(b, h) + aoff + m * 2048 + k * 1024); } while (0)
#define PG8_LDB(dst, b, h) do { _Pragma("unroll") for (int n = 0; n < 2; ++n) _Pragma("unroll") for (int k = 0; k < 2; ++k) dst[n][k] = *(const PG8_LAS bf16x8*)(lds + PG8_SB(b, h) + boff + n * 2048 + k * 1024); } while (0)
#define PG8_MMA(ai, bj, At, Bt) do { __builtin_amdgcn_s_setprio(1); _Pragma("unroll") for (int m = 0; m < 4; ++m) _Pragma("unroll") for (int n = 0; n < 2; ++n) _Pragma("unroll") for (int k = 0; k < 2; ++k) \
        acc[ai][bj][m][n] = __builtin_amdgcn_mfma_f32_16x16x32_bf16(Bt[n][k], At[m][k], acc[ai][bj][m][n], 0, 0, 0); __builtin_amdgcn_s_setprio(0); } while (0)
#define PG8_WAIT_V(n) asm volatile("s_waitcnt vmcnt(" #n ")" ::: "memory")
#define PG8_WAIT_L(n) asm volatile("s_waitcnt lgkmcnt(" #n ")" ::: "memory")
#define PG8_BAR __builtin_amdgcn_s_barrier()
#define PG8_SCHED __builtin_amdgcn_sched_barrier(0)
    Unit cur, nxt; int ui = 0;
    if (!S.next(0, cur)) return;
    f32x4 acc[2][2][4][2];
#pragma unroll
    for (int a = 0; a < 2; ++a)
#pragma unroll
        for (int b = 0; b < 2; ++b)
#pragma unroll
            for (int m = 0; m < 4; ++m)
#pragma unroll
                for (int n = 0; n < 2; ++n) acc[a][b][m][n] = (f32x4){0.f, 0.f, 0.f, 0.f};
    bf16x8 At[4][2], B0[2][2], B1[2][2];
    const char* cA = (const char*)g.A + (size_t)cur.pm * tstep; const char* cB = (const char*)g.Bt + (size_t)cur.pn * tstep;
    S.a_ready(cur);
    if constexpr (SP2) {
        PG8_STAGE(PG8_SB(0, 0), cB, voffB); PG8_STAGE(PG8_SB(0, 1), cB + hstep, voffB); PG8_STAGE(PG8_SA(0, 0), cA, voffA); PG8_STAGE(PG8_SA(0, 1), cA + hstep, voffA);
        if (wr == 1) PG8_BAR;
        PG8_WAIT_V(2); PG8_BAR;
        PG8_STAGE(PG8_SB(1, 0), cB + kstep, voffB); PG8_STAGE(PG8_SA(1, 0), cA + kstep, voffA); PG8_STAGE(PG8_SB(1, 1), cB + hstep + kstep, voffB);
        PG8_WAIT_V(6); PG8_BAR;
    } else {
        PG8_STAGE(PG8_SB(0, 0), cB, voffB); PG8_STAGE(PG8_SA(0, 0), cA, voffA); PG8_STAGE(PG8_SB(0, 1), cB + hstep, voffB); PG8_STAGE(PG8_SA(0, 1), cA + hstep, voffA);
        if (wr == 1) PG8_BAR;
        PG8_WAIT_V(4); PG8_BAR;
        PG8_STAGE(PG8_SB(1, 0), cB + kstep, voffB); PG8_STAGE(PG8_SA(1, 0), cA + kstep, voffA); PG8_STAGE(PG8_SB(1, 1), cB + hstep + kstep, voffB);
        PG8_WAIT_V(6); PG8_BAR;
    }
    for (;;) {
        const bool has_next = S.next(ui + 1, nxt);
        const char* nA = has_next ? (const char*)g.A + (size_t)nxt.pm * tstep : cA; const char* nB = has_next ? (const char*)g.Bt + (size_t)nxt.pn * tstep : cB;
        for (int t = 0; t < nt; t += 2) {
            const bool last = (t == nt - 2);
            const char* a1 = cA + (size_t)(t + 1) * kstep;
            const char* a2 = last ? nA : cA + (size_t)(t + 2) * kstep; const char* b2 = last ? nB : cB + (size_t)(t + 2) * kstep;
            const char* a3 = a2 + kstep; const char* b3 = b2 + kstep;
            if (last && has_next) S.a_ready(nxt);
            if constexpr (SP2) {
            PG8_LDB(B0, 0, 0); PG8_LDB(B1, 0, 1); PG8_SCHED; PG8_LDA(At, 0, 0); PG8_STAGE(PG8_SA(1, 1), a1 + hstep, voffA);
            PG8_WAIT_V(8); PG8_WAIT_L(0); PG8_BAR; PG8_MMA(0, 0, At, B0); PG8_MMA(0, 1, At, B1); PG8_BAR; PG8_SCHED;
            PG8_LDA(At, 0, 1); PG8_STAGE(PG8_SB(0, 0), b2, voffB); PG8_STAGE(PG8_SB(0, 1), b2 + hstep, voffB); PG8_STAGE(PG8_SA(0, 0), a2, voffA);
            PG8_WAIT_V(8); PG8_WAIT_L(0); PG8_BAR; PG8_MMA(1, 0, At, B0); PG8_MMA(1, 1, At, B1); PG8_BAR; PG8_SCHED;
            PG8_LDB(B0, 1, 0); PG8_LDB(B1, 1, 1); PG8_SCHED; PG8_LDA(At, 1, 0); PG8_STAGE(PG8_SA(0, 1), a2 + hstep, voffA);
            PG8_WAIT_V(8); PG8_WAIT_L(0); PG8_BAR; PG8_MMA(0, 0, At, B0); PG8_MMA(0, 1, At, B1); PG8_BAR; PG8_SCHED;
            PG8_LDA(At, 1, 1); PG8_STAGE(PG8_SB(1, 0), b3, voffB); PG8_STAGE(PG8_SB(1, 1), b3 + hstep, voffB); PG8_STAGE(PG8_SA(1, 0), a3, voffA);
            PG8_WAIT_V(8); PG8_WAIT_L(0); PG8_BAR; PG8_MMA(1, 0, At, B0); PG8_MMA(1, 1, At, B1); PG8_BAR; PG8_SCHED;
            } else {
            PG8_LDB(B0, 0, 0); PG8_SCHED; PG8_LDA(At, 0, 0); PG8_STAGE(PG8_SA(1, 1), a1 + hstep, voffA);
            PG8_WAIT_L(8); PG8_BAR; PG8_WAIT_L(0); PG8_MMA(0, 0, At, B0); PG8_BAR; PG8_SCHED;
            PG8_LDB(B1, 0, 1); PG8_STAGE(PG8_SB(0, 0), b2, voffB);
            PG8_BAR; PG8_WAIT_L(0); PG8_MMA(0, 1, At, B1); PG8_BAR;
            PG8_LDA(At, 0, 1); PG8_STAGE(PG8_SA(0, 0), a2, voffA);
            PG8_BAR; PG8_WAIT_L(0); PG8_MMA(1, 0, At, B0); PG8_BAR; PG8_SCHED;
            PG8_STAGE(PG8_SB(0, 1), b2 + hstep, voffB);
            PG8_WAIT_V(6); PG8_BAR; PG8_MMA(1, 1, At, B1); PG8_BAR;
            PG8_LDB(B0, 1, 0); PG8_SCHED; PG8_LDA(At, 1, 0); PG8_STAGE(PG8_SA(0, 1), a2 + hstep, voffA);
            PG8_WAIT_L(8); PG8_BAR; PG8_WAIT_L(0); PG8_MMA(0, 0, At, B0); PG8_BAR; PG8_SCHED;
            PG8_LDB(B1, 1, 1); PG8_STAGE(PG8_SB(1, 0), b3, voffB);
            PG8_BAR; PG8_WAIT_L(0); PG8_MMA(0, 1, At, B1); PG8_BAR;
            PG8_LDA(At, 1, 1); PG8_STAGE(PG8_SA(1, 0), a3, voffA);
            PG8_BAR; PG8_WAIT_L(0); PG8_MMA(1, 0, At, B0); PG8_BAR; PG8_SCHED;
            PG8_STAGE(PG8_SB(1, 1), b3 + hstep, voffB);
            PG8_WAIT_V(6); PG8_BAR; PG8_MMA(1, 1, At, B1); PG8_BAR;
            }
        }
        if constexpr (ALIGN_EPI) { if (wr == 0) PG8_BAR; }
        if constexpr (!Epi::AFTER_DRAIN) { E(acc, cur, wr, wc, fr, fq); S.done(cur); }
        if (!has_next) break;
#pragma unroll
        for (int a = 0; a < 2; ++a)
#pragma unroll
            for (int b = 0; b < 2; ++b)
#pragma unroll
                for (int m = 0; m < 4; ++m)
#pragma unroll
                    for (int n = 0; n < 2; ++n) acc[a][b][m][n] = (f32x4){0.f, 0.f, 0.f, 0.f};
        cur = nxt; cA = nA; cB = nB; ++ui;
        if constexpr (ALIGN_EPI) { if (wr == 1) PG8_BAR; }
    }
    PG8_WAIT_V(0);
    if constexpr (!ALIGN_EPI) { if (wr == 0) PG8_BAR; }
    PG8_BAR;
    if constexpr (Epi::AFTER_DRAIN) { E.fused(acc, cur, wr, wc, fr, fq, lds, wid, lane); S.done(cur); }
#undef PG8_SA
#undef PG8_SB
#undef PG8_STAGE
#undef PG8_LDA
#undef PG8_LDB
#undef PG8_MMA
#undef PG8_WAIT_V
#undef PG8_WAIT_L
#undef PG8_BAR
#undef PG8_SCHED
}
}
#define GAS __attribute__((address_space(1)))
#define LAS __attribute__((address_space(3)))
typedef unsigned short bf16;
typedef unsigned v4u __attribute__((ext_vector_type(4)));
typedef float f32x4 __attribute__((ext_vector_type(4)));
typedef short bf16x8 __attribute__((ext_vector_type(8)));
typedef GAS unsigned gu32;
typedef GAS unsigned long long gu64;
#define RLX_AGENT __ATOMIC_RELAXED, __HIP_MEMORY_SCOPE_AGENT
#define LDS_WAIT() asm volatile("s_waitcnt lgkmcnt(0)" ::: "memory")
#define VM_WAIT() asm volatile("s_waitcnt vmcnt(0)" ::: "memory")
__device__ __forceinline__ unsigned long long rt() { return __builtin_amdgcn_s_memrealtime(); }
__device__ __forceinline__ unsigned f2bf(float f) { unsigned u = __builtin_bit_cast(unsigned, f); return (u + 0x7fffu + ((u >> 16) & 1u)) >> 16; }
__device__ __forceinline__ unsigned pk2(float lo, float hi) { return f2bf(lo) | (f2bf(hi) << 16); }

#define XB_TMO      128
#define XB_XCNT(j)  (256  + 64 * (j))
#define XB_XSUB(j)  (1280 + 64 * (j))
#define XB_XGEN(j)  (2304 + 64 * (j))
#define XB_TOP      3328
#define XB_TOPGEN   3392
#define XCD_BAR_WORDS 3456
#define XB_SPIN_CAP (1u << 18)

__device__ __forceinline__ unsigned xb_ld(unsigned* p)              { return __hip_atomic_load(p, __ATOMIC_RELAXED, __HIP_MEMORY_SCOPE_AGENT); }
__device__ __forceinline__ unsigned xb_add(unsigned* p, unsigned v) { return __hip_atomic_fetch_add(p, v, __ATOMIC_RELAXED, __HIP_MEMORY_SCOPE_AGENT); }
__device__ __forceinline__ unsigned xb_xcc_id() { return (unsigned)__builtin_amdgcn_s_getreg((3 << 11) | 20) & 0xFu; }
#define XB_SPIN(cond, bar) do { unsigned _sp = 0; while (cond) { __builtin_amdgcn_s_sleep(1); \
    if ((++_sp & 255u) == 0u) { if (xb_ld(&(bar)[XB_TMO])) break; if (_sp > XB_SPIN_CAP) { atomicAdd(&(bar)[XB_TMO], 1u); break; } } } } while (0)

struct XcdBarrier {
    unsigned* bar; unsigned x;
    volatile LAS unsigned* st;
};

__device__ __forceinline__ XcdBarrier xcd_barrier_post(unsigned* bar, volatile LAS unsigned* st) {
    XcdBarrier b; b.bar = bar; b.x = xb_xcc_id(); b.st = st;
    if (threadIdx.x == 0) (void)xb_add(&bar[XB_XCNT(b.x)], 1u);
    return b;
}
__device__ __forceinline__ void xcd_barrier_complete(unsigned* bar, unsigned x, unsigned& nloc, unsigned& nx) {
    const unsigned G = gridDim.x * gridDim.y * gridDim.z;
    unsigned sum, cnt, mine, sp = 0u;
    for (;;) {
        sum = 0u; cnt = 0u; mine = 0u;
#pragma unroll
        for (unsigned j = 0; j < 16; ++j) { const unsigned c = xb_ld(&bar[XB_XCNT(j)]); sum += c; cnt += (c > 0u) ? 1u : 0u; mine = (j == x) ? c : mine; }
        if (sum == G) break;
        __builtin_amdgcn_s_sleep(1);
        if ((++sp & 255u) == 0u) { if (xb_ld(&bar[XB_TMO])) break; if (sp > XB_SPIN_CAP) { atomicAdd(&bar[XB_TMO], 1u); break; } }
    }
    nloc = mine > 0u ? mine : 1u; nx = cnt > 0u ? cnt : 1u;
}

__device__ __forceinline__ void xcd_barrier(const XcdBarrier& b) {
    asm volatile("s_waitcnt vmcnt(0)" ::: "memory");
    __syncthreads();
    if (threadIdx.x == 0) {
        unsigned* bar = b.bar;
        __builtin_amdgcn_s_waitcnt(0);
        unsigned nloc = b.st[0], nx = b.st[1];
        if (nloc == 0u) { xcd_barrier_complete(bar, b.x, nloc, nx); b.st[0] = nloc; b.st[1] = nx; }
        const unsigned old = xb_add(&bar[XB_XSUB(b.x)], 1u);
        const unsigned gen = old / nloc;
        if (old + 1u == (gen + 1u) * nloc) {
            __builtin_amdgcn_fence(__ATOMIC_RELEASE, "agent");
            asm volatile("s_waitcnt vmcnt(0)" ::: "memory");
            const unsigned og = xb_add(&bar[XB_TOP], 1u);
            const unsigned tg = og / nx;
            if (og + 1u == (tg + 1u) * nx) xb_add(&bar[XB_TOPGEN], 1u);
            else XB_SPIN(xb_ld(&bar[XB_TOPGEN]) == tg, bar);
            __builtin_amdgcn_fence(__ATOMIC_ACQUIRE, "agent");
            xb_add(&bar[XB_XGEN(b.x)], 1u);
            asm volatile("s_waitcnt vmcnt(0)" ::: "memory");
        } else {
            XB_SPIN(xb_ld(&bar[XB_XGEN(b.x)]) == gen, bar);
            __builtin_amdgcn_fence(__ATOMIC_ACQUIRE, "agent");
            asm volatile("s_waitcnt vmcnt(0)" ::: "memory");
        }
    }
    __syncthreads();
}
namespace att {
typedef unsigned short bf16;
typedef short bf16x8 __attribute__((ext_vector_type(8)));
typedef short s16x4 __attribute__((ext_vector_type(4)));
typedef short v4i16_t __attribute__((ext_vector_type(4)));
typedef float f32x16 __attribute__((ext_vector_type(16)));
typedef unsigned u32x4 __attribute__((ext_vector_type(4)));
typedef float f32x2_t __attribute__((ext_vector_type(2)));
typedef __bf16 bf16x2_t __attribute__((ext_vector_type(2)));
#define ALDS __attribute__((address_space(3)))
#define ASBAR() __builtin_amdgcn_sched_barrier(0)
constexpr int STG1 = 40960;
constexpr int WS_OFF = 81920;
constexpr int TAB_OFF = WS_OFF + 2048;
constexpr int ATT_LDS_BYTES = TAB_OFF + 2048;
constexpr float THR2 = 8.0f;
__device__ __forceinline__ int crow(int r, int hi) { return (r & 3) + 8 * (r >> 2) + 4 * hi; }
__device__ __forceinline__ void glds16(const void* gsrc, unsigned lds_dst) { unsigned keep;
    asm volatile("s_mov_b32 %0, m0\n\ts_mov_b32 m0, %2\n\ts_nop 0\n\tglobal_load_lds_dwordx4 %1, off\n\ts_mov_b32 m0, %0" : "=&s"(keep) : "v"(gsrc), "s"(lds_dst) : "memory"); }
__device__ __forceinline__ unsigned cvtpk_s(float lo, float hi) { f32x2_t v = {lo, hi}; bf16x2_t b = __builtin_convertvector(v, bf16x2_t); return __builtin_bit_cast(unsigned, b); }
__device__ __forceinline__ float swapmax(float v) { auto rr = __builtin_amdgcn_permlane32_swap(__float_as_uint(v), __float_as_uint(v), false, false); return fmaxf(__uint_as_float(rr[0]), __uint_as_float(rr[1])); }
__device__ __forceinline__ float swapsum(float v) { auto rr = __builtin_amdgcn_permlane32_swap(__float_as_uint(v), __float_as_uint(v), false, false); return __uint_as_float(rr[0]) + __uint_as_float(rr[1]); }
#define ATT_WAIT_BAR() asm volatile("s_waitcnt vmcnt(0) lgkmcnt(0)\n\ts_barrier" ::: "memory")

struct AttnArgs { const bf16* QKV; const bf16* QM; const bf16* KVM; const bf16* KR; const bf16* GATE; bf16* Y; const float* biastab; const float* subg; float lam; float oml; };

__device__ __forceinline__ void pv4(f32x16* o, int vb, bf16x8 pa0, bf16x8 pa1, bf16x8 pa2, bf16x8 pa3) {
#pragma unroll
    for (int d0 = 0; d0 < 4; ++d0) { s16x4 lo[4], hh[4];
#pragma unroll
        for (int ks = 0; ks < 4; ++ks) {
            asm volatile("ds_read_b64_tr_b16 %0, %1 offset:%c2" : "=&v"(lo[ks]) : "v"(vb), "i"(d0 * 4096 + ks * 1024) : "memory");
            asm volatile("ds_read_b64_tr_b16 %0, %1 offset:%c2" : "=&v"(hh[ks]) : "v"(vb), "i"(d0 * 4096 + ks * 1024 + 512) : "memory"); }
        asm volatile("s_waitcnt lgkmcnt(0)" ::: "memory"); ASBAR();
#define ATT_PK(k) (bf16x8){lo[k][0], lo[k][1], lo[k][2], lo[k][3], hh[k][0], hh[k][1], hh[k][2], hh[k][3]}
        o[d0] = __builtin_amdgcn_mfma_f32_32x32x16_bf16(pa0, ATT_PK(0), o[d0], 0, 0, 0);
        o[d0] = __builtin_amdgcn_mfma_f32_32x32x16_bf16(pa1, ATT_PK(1), o[d0], 0, 0, 0);
        o[d0] = __builtin_amdgcn_mfma_f32_32x32x16_bf16(pa2, ATT_PK(2), o[d0], 0, 0, 0);
        o[d0] = __builtin_amdgcn_mfma_f32_32x32x16_bf16(pa3, ATT_PK(3), o[d0], 0, 0, 0);
#undef ATT_PK
    }
}

template <bool DIFF>
__device__ __forceinline__ void attn_unit(const AttnArgs& A, int b, int h, int qb, unsigned char* shm) {
    constexpr int ND0 = DIFF ? 4 : 12;
    constexpr int QROWS = DIFF ? 128 : 256;
    constexpr int V_OFF = DIFF ? 16384 : 24576;
    int tid_ = threadIdx.x; asm volatile("" : "+v"(tid_));
    const int tid = tid_, lane = tid & 63, r32 = lane & 31, hi = lane >> 5; const int wid = __builtin_amdgcn_readfirstlane(tid >> 6);
    const int map = DIFF ? (wid >> 2) : 0, wrow = DIFF ? (wid & 3) : wid;
    const int q0 = qb * QROWS + wrow * 32;
    const int cw = q0 >> 6;
    const int NT = (qb * QROWS + QROWS) >> 6;
    const long rowbase = (long)b * SEQ;
    const unsigned lds0 = (unsigned)(uintptr_t)shm;
    ALDS unsigned char* shm3 = (ALDS unsigned char*)shm;
    ALDS float* wsf = (ALDS float*)(shm3 + WS_OFF) + wid * 64;
    ALDS float* tabl = (ALDS float*)(shm3 + TAB_OFF) + map * 256;
    const bf16 *ks0, *ks1, *ks2, *vs0, *vs1; long kstep, vstep;
    unsigned kd0, kd1, kd2, vd0, vd1;
    const int vrow = 16 * (wid & 3) + (lane >> 2), vcol = (wid >> 2) * 32 + (lane & 3) * 8;
    if (DIFF) {
        ks0 = A.QKV + (rowbase + lane) * 3072 + 1024 + h * 128 + wid * 8; ks1 = ks0 + 64; ks2 = ks0; kstep = 64L * 3072;
        vs0 = A.QKV + (rowbase + vrow) * 3072 + 2048 + h * 128 + vcol; vs1 = vs0 + 64; vstep = 64L * 3072;
        kd0 = lds0 + wid * 1024; kd1 = kd0 + 8192; kd2 = kd0;
    } else {
        ks0 = A.KVM + (rowbase + lane) * 2048 + h * 256 + wid * 8; ks1 = ks0 + 64; ks2 = A.KR + (rowbase + lane) * 64 + wid * 8; kstep = 64L * 2048;
        vs0 = A.KVM + (rowbase + vrow) * 2048 + h * 256 + 128 + vcol; vs1 = vs0 + 64; vstep = 64L * 2048;
        kd0 = lds0 + wid * 1024; kd1 = kd0 + 8192; kd2 = kd0 + 16384;
    }
    vd0 = lds0 + V_OFF + wid * 1024; vd1 = vd0 + 8192;
#define ATT_DMA(t, so) do { const long _t = (t); const unsigned _so = (so); \
        glds16(ks0 + _t * kstep, (unsigned)__builtin_amdgcn_readfirstlane(kd0 + _so)); \
        glds16(ks1 + _t * kstep, (unsigned)__builtin_amdgcn_readfirstlane(kd1 + _so)); \
        if (!DIFF) glds16(ks2 + _t * (64L * 64), (unsigned)__builtin_amdgcn_readfirstlane(kd2 + _so)); \
        glds16(vs0 + _t * vstep, (unsigned)__builtin_amdgcn_readfirstlane(vd0 + _so)); \
        glds16(vs1 + _t * vstep, (unsigned)__builtin_amdgcn_readfirstlane(vd1 + _so)); } while (0)
    ATT_DMA(0, 0u);
    if (DIFF) { ((ALDS float*)(shm3 + TAB_OFF))[tid] = A.biastab[(h * 2 + (tid >> 8)) * 256 + (tid & 255)]; }
    bf16x8 qr[ND0];
    { const bf16* Qw = DIFF ? A.QKV + (rowbase + q0 + r32) * 3072 + h * 128 + map * 64 + hi * 8 : A.QM + (rowbase + q0 + r32) * 1536 + h * 192 + hi * 8;
#pragma unroll
      for (int d0 = 0; d0 < ND0; ++d0) qr[d0] = *reinterpret_cast<const bf16x8*>(Qw + d0 * 16); }
    const float C = (DIFF ? 0.125f : 0.07216878364870323f) * LOG2E;
    float boff = 0.f; if (DIFF) boff = A.biastab[(h * 2 + map) * 256];
    float m_reg = -1e30f, l_reg = 0.f; f32x16 o[4];
#pragma unroll
    for (int d = 0; d < 4; ++d) o[d] = f32x16{};
    const int kfo = (DIFF ? map * 8192 : 0) + hi * 1024 + r32 * 16;
    const int vb0 = (int)lds0 + V_OFF + ((lane >> 4) & 1) * 32 + (lane & 3) * 8 + (4 * hi + ((lane & 15) >> 2)) * 64;
    for (int t = 0; t < NT; ++t) {
        ATT_WAIT_BAR();
        if (t + 1 < NT) ATT_DMA(t + 1, ((t + 1) & 1) ? (unsigned)STG1 : 0u);
        if (t <= cw) {
            const int so = (t & 1) ? STG1 : 0;
            ALDS const unsigned char* kp = shm3 + so + kfo;
            f32x16 p0 = f32x16{}, p1 = f32x16{};
#pragma unroll
            for (int d0 = 0; d0 < ND0; ++d0) {
                const bf16x8 b0 = *(ALDS const bf16x8*)(kp + d0 * 2048);
                const bf16x8 b1 = *(ALDS const bf16x8*)(kp + d0 * 2048 + 512);
                p0 = __builtin_amdgcn_mfma_f32_32x32x16_bf16(b0, qr[d0], p0, 0, 0, 0);
                p1 = __builtin_amdgcn_mfma_f32_32x32x16_bf16(b1, qr[d0], p1, 0, 0, 0);
            }
            const bool nearb = DIFF && (t + 2 >= cw);
            float tmax;
            if (nearb) {
                ALDS const float* tb = tabl + (64 * t - q0 - r32 + 192);
#pragma unroll
                for (int r = 0; r < 16; ++r) { const int kk = crow(r, hi); p0[r] = fmaf(p0[r], C, tb[kk]); p1[r] = fmaf(p1[r], C, tb[kk + 32]); }
                tmax = fmaxf(p0[0], p1[0]);
#pragma unroll
                for (int r = 1; r < 16; ++r) tmax = fmaxf(tmax, fmaxf(p0[r], p1[r]));
            } else {
                float rm = fmaxf(p0[0], p1[0]);
#pragma unroll
                for (int r = 1; r < 16; ++r) rm = fmaxf(rm, fmaxf(p0[r], p1[r]));
                tmax = fmaf(rm, C, boff);
            }
            tmax = swapmax(tmax);
            if (!__all(tmax - m_reg <= THR2)) {
                const float mn = fmaxf(m_reg, tmax); const float alpha = __builtin_amdgcn_exp2f(m_reg - mn); m_reg = mn; l_reg *= alpha;
                if (hi == 0) wsf[r32] = alpha;
                asm volatile("s_waitcnt lgkmcnt(0)" ::: "memory");
#pragma unroll
                for (int r = 0; r < 16; ++r) { const float al = wsf[crow(r, hi)];
#pragma unroll
                    for (int d = 0; d < 4; ++d) o[d][r] *= al; }
            }
            if (nearb) {
#pragma unroll
                for (int r = 0; r < 16; ++r) { p0[r] = __builtin_amdgcn_exp2f(p0[r] - m_reg); p1[r] = __builtin_amdgcn_exp2f(p1[r] - m_reg); }
            } else { const float bm = boff - m_reg;
#pragma unroll
                for (int r = 0; r < 16; ++r) { p0[r] = __builtin_amdgcn_exp2f(fmaf(p0[r], C, bm)); p1[r] = __builtin_amdgcn_exp2f(fmaf(p1[r], C, bm)); }
            }
            float ps = 0.f;
#pragma unroll
            for (int r = 0; r < 16; ++r) ps += p0[r] + p1[r];
            l_reg += ps;
            u32x4 pw0, pw1, pw2, pw3;
            pw0 = (u32x4){cvtpk_s(p0[0], p0[1]), cvtpk_s(p0[2], p0[3]), cvtpk_s(p0[4], p0[5]), cvtpk_s(p0[6], p0[7])};
            pw1 = (u32x4){cvtpk_s(p0[8], p0[9]), cvtpk_s(p0[10], p0[11]), cvtpk_s(p0[12], p0[13]), cvtpk_s(p0[14], p0[15])};
            pw2 = (u32x4){cvtpk_s(p1[0], p1[1]), cvtpk_s(p1[2], p1[3]), cvtpk_s(p1[4], p1[5]), cvtpk_s(p1[6], p1[7])};
            pw3 = (u32x4){cvtpk_s(p1[8], p1[9]), cvtpk_s(p1[10], p1[11]), cvtpk_s(p1[12], p1[13]), cvtpk_s(p1[14], p1[15])};
            pv4(o, vb0 + so, __builtin_bit_cast(bf16x8, pw0), __builtin_bit_cast(bf16x8, pw1), __builtin_bit_cast(bf16x8, pw2), __builtin_bit_cast(bf16x8, pw3));
        }
    }
#undef ATT_DMA
    ATT_WAIT_BAR();
    l_reg = swapsum(l_reg);
    if (hi == 0) wsf[32 + r32] = __builtin_amdgcn_rcpf(l_reg);
    asm volatile("s_waitcnt lgkmcnt(0)" ::: "memory");
    float rli[16];
#pragma unroll
    for (int r = 0; r < 16; ++r) rli[r] = wsf[32 + crow(r, hi)];
    ALDS bf16* stg;
    bool writer = true;
    if (DIFF) {
        ALDS float* X = (ALDS float*)(shm3 + (wid & 3) * 16384);
        if (map == 1) {
            const float lam = A.lam;
#pragma unroll
            for (int r = 0; r < 16; ++r) { const float f = rli[r] * lam; const int orow = crow(r, hi);
#pragma unroll
                for (int d = 0; d < 4; ++d) X[orow * 128 + d * 32 + r32] = o[d][r] * f; }
        }
        ATT_WAIT_BAR();
        stg = (ALDS bf16*)(shm3 + (wid & 3) * 16384);
        if (map == 0) {
            float g4[4];
#pragma unroll
            for (int d = 0; d < 4; ++d) g4[d] = A.subg[d * 32 + r32] * A.oml;
            float ss[16];
#pragma unroll
            for (int r = 0; r < 16; ++r) { const int orow = crow(r, hi); float s = 0.f;
#pragma unroll
                for (int d = 0; d < 4; ++d) { const float v = o[d][r] * rli[r] - X[orow * 128 + d * 32 + r32]; o[d][r] = v; s += v * v; }
                ss[r] = s; }
#pragma unroll
            for (int r = 0; r < 16; ++r) { float s = ss[r];
                s += __shfl_xor(s, 1); s += __shfl_xor(s, 2); s += __shfl_xor(s, 4); s += __shfl_xor(s, 8); s += __shfl_xor(s, 16);
                ss[r] = 1.0f / sqrtf(s * (1.0f / 128.0f) + EPS); }
            asm volatile("s_waitcnt lgkmcnt(0)" ::: "memory");
#pragma unroll
            for (int r = 0; r < 16; ++r) { const int orow = crow(r, hi);
#pragma unroll
                for (int d = 0; d < 4; ++d) stg[orow * 128 + d * 32 + r32] = (bf16)(cvtpk_s(o[d][r] * ss[r] * g4[d], 0.f) & 0xffffu); }
        } else writer = false;
    } else {
        stg = (ALDS bf16*)(shm3 + wid * 8192);
#pragma unroll
        for (int r = 0; r < 16; ++r) { const int orow = crow(r, hi);
#pragma unroll
            for (int d = 0; d < 4; ++d) stg[orow * 128 + d * 32 + r32] = (bf16)(cvtpk_s(o[d][r] * rli[r], 0.f) & 0xffffu); }
    }
    if (writer) {
        asm volatile("s_waitcnt lgkmcnt(0)" ::: "memory");
        const int gcol = (DIFF ? 0 : 1024) + h * 128;
#pragma unroll
        for (int i = 0; i < 8; ++i) { const int row = i * 4 + (lane >> 4), ch = lane & 15;
            const u32x4 ov = *(ALDS const u32x4*)(stg + row * 128 + ch * 8);
            const size_t gi = (size_t)(rowbase + q0 + row) * 2048 + gcol + ch * 8;
            const u32x4 gv = *(const u32x4*)(A.GATE + gi);
            u32x4 yv;
#pragma unroll
            for (int e = 0; e < 4; ++e) {
                const float o_lo = __uint_as_float(ov[e] << 16), o_hi = __uint_as_float(ov[e] & 0xffff0000u);
                const float g_lo = __uint_as_float(gv[e] << 16), g_hi = __uint_as_float(gv[e] & 0xffff0000u);
                const float s_lo = g_lo * __builtin_amdgcn_rcpf(1.0f + __builtin_amdgcn_exp2f(-g_lo * LOG2E));
                const float s_hi = g_hi * __builtin_amdgcn_rcpf(1.0f + __builtin_amdgcn_exp2f(-g_hi * LOG2E));
                yv[e] = cvtpk_s(o_lo * s_lo, o_hi * s_hi); }
            *(u32x4*)(A.Y + gi) = yv; }
    }
    ATT_WAIT_BAR();
}
#undef ASBAR
}
constexpr size_t MiB = 1u << 20;
constexpr size_t WS_CTL = 0, CTL_ZERO_BYTES = 1 * MiB;
constexpr size_t WS_ROPEC = 1 * MiB, WS_ROPES = WS_ROPEC + 512 * 1024;
constexpr size_t WS_SMALL = 2 * MiB;
constexpr size_t SM_BIAS = 1024, SM_RSQ = 128 * 1024, SM_RSKV = 256 * 1024;
constexpr size_t WS_WIN = 4 * MiB;
constexpr size_t WS_WQB = 52 * MiB;
constexpr size_t WS_WKVB = 55 * MiB;
constexpr size_t WS_WOUT = 57 * MiB;
constexpr size_t WS_H = 80 * MiB;
constexpr size_t WS_Y = WS_H;
constexpr size_t WS_QKV = 144 * MiB;
constexpr size_t WS_CQ = 240 * MiB;
constexpr size_t WS_CKV = 256 * MiB;
constexpr size_t WS_KR = 264 * MiB;
constexpr size_t WS_GATE = 272 * MiB;
constexpr size_t WS_QM = 336 * MiB;
constexpr size_t WS_KVM = 384 * MiB;
constexpr size_t WS_END = 448 * MiB;
constexpr int CW_BAR = 4096;

constexpr int RING_OFF = 0, RING_BYTES = 131072;
constexpr int LDSCTL_OFF = RING_BYTES, MISC_OFF = LDSCTL_OFF + 320;
constexpr int LDS_BYTES = 147456;
constexpr int NWAVES = 8;
static_assert(att::ATT_LDS_BYTES <= RING_BYTES, "attention scratch fits the ring region");

__device__ __forceinline__ float wave_sum(float v) {
#pragma unroll
    for (int o = 1; o < 64; o <<= 1) v += __shfl_xor(v, o);
    return v;
}
__device__ __forceinline__ int in_srccol(int n) {
    if (n < 3840) return n;
    if (n < 3904) { const int p = n - 3840, a = p >> 3, j = p & 7; return 3840 + (j < 4 ? 4 * a + j : 32 + 4 * a + (j - 4)); }
    if (n < 4096) return -1;
    return n - 192;
}
__device__ __forceinline__ int qb_srccol(int n) {
    const int hh = n / 192, off = n - hh * 192; if (off < 128) return n;
    const int p = off - 128, a = p >> 3, j = p & 7; return hh * 192 + 128 + (j < 4 ? 4 * a + j : 32 + 4 * a + (j - 4));
}
template <int MODE>
__device__ __forceinline__ void transpose_item(const float* W, int K, int Nsrc, int Ndst, bf16* WT, const float* gk, LAS float* scr, int item, int lane) {
    const int nblk = Ndst / 32, kb = item / nblk, nb = item - kb * nblk, k0 = 64 * kb, n0 = 32 * nb;
    const int nd = n0 + (lane & 31);
    const int src = (MODE == 1) ? in_srccol(nd) : (MODE == 2) ? qb_srccol(nd) : nd;
#pragma unroll 8
    for (int i = 0; i < 32; ++i) { const int kk = 2 * i + (lane >> 5); float v = 0.f;
        if (src >= 0) { v = W[(size_t)(k0 + kk) * Nsrc + src]; if (gk) v *= gk[k0 + kk]; }
        scr[kk * 33 + (lane & 31)] = v; }
    LDS_WAIT(); asm volatile("" ::: "memory");
    const int c = lane & 7;
#pragma unroll
    for (int j = 0; j < 4; ++j) { const int n = (lane >> 3) + 8 * j; const LAS float* s = scr + (8 * c) * 33 + n;
        v4u o; o.x = pk2(s[0 * 33], s[1 * 33]); o.y = pk2(s[2 * 33], s[3 * 33]); o.z = pk2(s[4 * 33], s[5 * 33]); o.w = pk2(s[6 * 33], s[7 * 33]);
        *(GAS v4u*)(WT + (size_t)(n0 + n) * K + k0 + 8 * c) = o; }
    LDS_WAIT(); asm volatile("" ::: "memory");
}
__device__ __forceinline__ void rms_row_to_bf16(const float* xrow, const float* g, bf16* orow, int lane) {
    const GAS f32x4* xr = (const GAS f32x4*)xrow + lane; const GAS f32x4* gr = (const GAS f32x4*)g + lane;
    f32x4 v[8]; float s = 0.f;
#pragma unroll
    for (int j = 0; j < 8; ++j) { v[j] = xr[64 * j]; s += (v[j].x * v[j].x + v[j].y * v[j].y) + (v[j].z * v[j].z + v[j].w * v[j].w); }
    const float rstd = 1.0f / sqrtf(wave_sum(s) * (1.0f / DM) + EPS);
    GAS unsigned long long* o8 = (GAS unsigned long long*)orow + lane;
#pragma unroll
    for (int j = 0; j < 8; ++j) { const f32x4 gg = gr[64 * j];
        o8[64 * j] = (unsigned long long)pk2(v[j].x * rstd * gg.x, v[j].y * rstd * gg.y) | ((unsigned long long)pk2(v[j].z * rstd * gg.z, v[j].w * rstd * gg.w) << 32); }
}
__device__ __forceinline__ void rms_row_f32(const float* xrow, const float* g, float* orow, int lane) {
    const GAS f32x4* xr = (const GAS f32x4*)xrow + lane; const GAS f32x4* gr = (const GAS f32x4*)g + lane;
    f32x4 v[8]; float s = 0.f;
#pragma unroll
    for (int j = 0; j < 8; ++j) { v[j] = xr[64 * j]; s += (v[j].x * v[j].x + v[j].y * v[j].y) + (v[j].z * v[j].z + v[j].w * v[j].w); }
    const float rstd = 1.0f / sqrtf(wave_sum(s) * (1.0f / DM) + EPS);
    GAS f32x4* o4 = (GAS f32x4*)orow + lane;
#pragma unroll
    for (int j = 0; j < 8; ++j) { const f32x4 gg = gr[64 * j]; o4[64 * j] = v[j] * rstd * gg; }
}
__device__ __forceinline__ int rel_bucket(int rel) {
    const int n = rel < 0 ? -rel : rel; int bk;
    if (n < 8) bk = n; else if (n < 12) bk = 8; else if (n < 16) bk = 9; else if (n < 23) bk = 10; else if (n < 32) bk = 11;
    else if (n < 46) bk = 12; else if (n < 64) bk = 13; else if (n < 91) bk = 14; else bk = 15;
    return (rel > 0 ? 16 : 0) + bk;
}

struct Args { const float* in[12]; float* out; unsigned char* ws; int ph_lo, ph_hi; };
constexpr int N_PHASES = 13;

#define IN(k) (lo <= (k) && (k) < hi)
#define SEAM(k) do { if (IN(k) && IN((k) + 1)) grid.sync(); } while (0)
#define WSP(T, off) ((T*)(args.ws + (off)))

__device__ __forceinline__ void prologue_phase(const Args& args, unsigned char* lds, int G, int vcu) {
    int tid_ = threadIdx.x; asm volatile("" : "+v"(tid_));
    const int tid = tid_, lane = tid & 63, wave = __builtin_amdgcn_readfirstlane(tid >> 6);
    const int gw = vcu * NWAVES + wave, NGW = G * NWAVES;
    const float* x = args.in[0]; const float* norm_g = args.in[1]; const float* w_in = args.in[2]; const float* diff_lambda = args.in[3];
    const float* qnorm_g = args.in[5]; const float* w_qb = args.in[6]; const float* kvnorm_g = args.in[7];
    const float* w_kvb = args.in[8]; const float* w_out = args.in[9]; const float* rel_bias = args.in[10];
    float* ropec = WSP(float, WS_ROPEC); float* ropes = WSP(float, WS_ROPES); float* smallf = WSP(float, WS_SMALL); float* biastab = WSP(float, WS_SMALL + SM_BIAS);
    bf16* Win_t = WSP(bf16, WS_WIN); bf16* Wqb_t = WSP(bf16, WS_WQB); bf16* Wkvb_t = WSP(bf16, WS_WKVB); bf16* Wout_t = WSP(bf16, WS_WOUT); bf16* Hb = WSP(bf16, WS_H);
    LAS float* scr = (LAS float*)((LAS unsigned char*)lds + RING_OFF + wave * 16384);
    constexpr int I_IN = (DM / 64) * (NINP / 32), I_QB = (QLORA / 64) * (NQB / 32), I_KVB = (KVLORA / 64) * (NKVB / 32), I_OUT = (DM / 64) * (DM / 32);
    constexpr int PER_L = I_IN + I_QB + I_KVB + I_OUT;
    for (int it = gw; it < DEPTH * PER_L; it += NGW) {
        const int l = it / PER_L; int r = it - l * PER_L;
        if (r < I_IN) { transpose_item<1>(w_in + (size_t)l * DM * NIN, DM, NIN, NINP, Win_t + (size_t)l * NINP * DM, nullptr, scr, r, lane); continue; } r -= I_IN;
        if (r < I_QB) { transpose_item<2>(w_qb + (size_t)l * QLORA * NQB, QLORA, NQB, NQB, Wqb_t + (size_t)l * NQB * QLORA, qnorm_g + l * QLORA, scr, r, lane); continue; } r -= I_QB;
        if (r < I_KVB) { transpose_item<0>(w_kvb + (size_t)l * KVLORA * NKVB, KVLORA, NKVB, NKVB, Wkvb_t + (size_t)l * NKVB * KVLORA, kvnorm_g + l * KVLORA, scr, r, lane); continue; } r -= I_KVB;
        transpose_item<0>(w_out + (size_t)l * DM * DM, DM, DM, DM, Wout_t + (size_t)l * DM * DM, nullptr, scr, r, lane);
    }
    const int gt = vcu * (NWAVES * 64) + tid, NGT = G * NWAVES * 64;
    for (int e = gt; e < SEQ * 32; e += NGT) { const int s = e >> 5, i = e & 31;
        const float inv = powf(10000.0f, -(float)i * (1.0f / 32.0f)); const float ang = (float)s * inv;
        ropec[e] = cosf(ang); ropes[e] = sinf(ang); }
    for (int e = gt; e < 16 * 256; e += NGT) { const int mh = e >> 8, idx = e & 255; biastab[e] = rel_bias[rel_bucket(idx - 192) * 16 + mh] * LOG2E; }
    if (gt < DEPTH) { const float* lp = diff_lambda + gt * 256; float s01 = 0.f, s23 = 0.f;
        for (int i = 0; i < 64; ++i) { s01 += lp[i] * lp[64 + i]; s23 += lp[128 + i] * lp[192 + i]; }
        const float lam_init = 0.8f - 0.6f * expf(-0.3f * (float)gt);
        smallf[gt] = expf(s01) - expf(s23) + lam_init; smallf[8 + gt] = 1.0f - lam_init; }
    for (int m = gw; m < MROWS; m += NGW) rms_row_to_bf16(x + (size_t)m * DM, norm_g, Hb + (size_t)m * DM, lane);
}

template <int L>
__device__ __forceinline__ void layer_phases(const Args& args, unsigned char* lds, cg::grid_group& grid, int lo, int hi, int G, int bx, int vcu) {
    constexpr int pb = 1 + 6 * L;
    LAS unsigned char* ldsl = (LAS unsigned char*)lds;
    if (IN(pb)) {
        pg8::Gemm g{WSP(bf16, WS_H), WSP(bf16, WS_WIN) + (size_t)L * NINP * DM, MROWS, NINP, DM}; pg8::StaticOrder S; S.init(MROWS, NINP, G, bx);
        pg8::EpiInProj E{WSP(bf16, WS_QKV), WSP(bf16, WS_CQ), WSP(bf16, WS_CKV), WSP(bf16, WS_KR), WSP(bf16, WS_GATE), WSP(float, WS_ROPEC), WSP(float, WS_ROPES)};
#ifndef NO_G1
        pg8::gemm_phase<pg8::EpiInProj, pg8::StaticOrder, true, true>(ldsl + RING_OFF, g, S, E);
#endif
    }
    SEAM(pb);
    if (IN(pb + 1)) {
        int tid_ = threadIdx.x; asm volatile("" : "+v"(tid_));
        const int lane = tid_ & 63, wave = __builtin_amdgcn_readfirstlane(tid_ >> 6); const int gw = vcu * NWAVES + wave, NGW = G * NWAVES;
        const bf16* CQ = WSP(bf16, WS_CQ); const bf16* CKV = WSP(bf16, WS_CKV); float* rsq = WSP(float, WS_SMALL + SM_RSQ); float* rskv = WSP(float, WS_SMALL + SM_RSKV);
        for (int m = gw; m < MROWS; m += NGW) {
            const v4u a = *((const GAS v4u*)(CQ + (size_t)m * QLORA) + lane); float s = 0.f;
#pragma unroll
            for (int e = 0; e < 4; ++e) { const float lo_ = __uint_as_float(a[e] << 16), hi_ = __uint_as_float(a[e] & 0xffff0000u); s += lo_ * lo_ + hi_ * hi_; }
            s = wave_sum(s);
            const unsigned long long c = *((const GAS unsigned long long*)(CKV + (size_t)m * KVLORA) + lane);
            const unsigned c0 = (unsigned)c, c1 = (unsigned)(c >> 32); float s2;
            { const float a0 = __uint_as_float(c0 << 16), a1 = __uint_as_float(c0 & 0xffff0000u), a2 = __uint_as_float(c1 << 16), a3 = __uint_as_float(c1 & 0xffff0000u); s2 = (a0 * a0 + a1 * a1) + (a2 * a2 + a3 * a3); }
            s2 = wave_sum(s2);
            if (lane == 0) { rsq[m] = 1.0f / sqrtf(s * (1.0f / QLORA) + EPS); rskv[m] = 1.0f / sqrtf(s2 * (1.0f / KVLORA) + EPS); }
        }
    }
    SEAM(pb + 1);
    if (IN(pb + 2)) {
        { pg8::Gemm g{WSP(bf16, WS_CQ), WSP(bf16, WS_WQB) + (size_t)L * NQB * QLORA, MROWS, NQB, QLORA}; pg8::StaticOrder S; S.init(MROWS, NQB, G, bx);
          pg8::EpiRowScale<true> E{WSP(bf16, WS_QM), NQB, WSP(float, WS_SMALL + SM_RSQ), WSP(float, WS_ROPEC), WSP(float, WS_ROPES)};
#ifndef NO_G2
          pg8::gemm_phase<pg8::EpiRowScale<true>, pg8::StaticOrder, true, true>(ldsl + RING_OFF, g, S, E);
#endif
        }
        { pg8::Gemm g{WSP(bf16, WS_CKV), WSP(bf16, WS_WKVB) + (size_t)L * NKVB * KVLORA, MROWS, NKVB, KVLORA}; pg8::StaticOrder S; S.init(MROWS, NKVB, G, G - 1 - bx);
          pg8::EpiRowScale<false> E{WSP(bf16, WS_KVM), NKVB, WSP(float, WS_SMALL + SM_RSKV), nullptr, nullptr};
#ifndef NO_G3
          pg8::gemm_phase<pg8::EpiRowScale<false>, pg8::StaticOrder, true, true>(ldsl + RING_OFF, g, S, E);
#endif
        }
    }
    SEAM(pb + 2);
    if (IN(pb + 3)) {
        const float* smallf = WSP(float, WS_SMALL);
        att::AttnArgs A{WSP(bf16, WS_QKV), WSP(bf16, WS_QM), WSP(bf16, WS_KVM), WSP(bf16, WS_KR), WSP(bf16, WS_GATE), WSP(bf16, WS_Y), WSP(float, WS_SMALL + SM_BIAS), args.in[4] + L * 128, smallf[L], smallf[8 + L]};
        for (int p = vcu; p < 256; p += G) {
            const int bh = p >> 3, s = p & 7, b = bh >> 3, h = bh & 7;
#ifndef NO_ATT_MLA
            for (int i = 0; i < 2; ++i) att::attn_unit<false>(A, b, h, i == 0 ? 15 - s : s, lds + RING_OFF);
#endif
#ifndef NO_ATT_DIFF
            for (int i = 0; i < 4; ++i) att::attn_unit<true>(A, b, h, i == 0 ? 31 - 2 * s : i == 1 ? 30 - 2 * s : i == 2 ? 2 * s + 1 : 2 * s, lds + RING_OFF);
#endif
        }
    }
    SEAM(pb + 3);
    if (IN(pb + 4)) {
        pg8::Gemm g{WSP(bf16, WS_Y), WSP(bf16, WS_WOUT) + (size_t)L * DM * DM, MROWS, DM, DM}; pg8::StaticOrder S; S.init(MROWS, DM, G, bx);
        pg8::EpiResF32 E{L == 0 ? args.in[0] : (const float*)args.out, args.out, DM};
#ifndef NO_G4
        pg8::gemm_phase<pg8::EpiResF32, pg8::StaticOrder, true, true>(ldsl + RING_OFF, g, S, E);
#endif
    }
    SEAM(pb + 4);
    if (IN(pb + 5)) {
        int tid_ = threadIdx.x; asm volatile("" : "+v"(tid_));
        const int lane = tid_ & 63, wave = __builtin_amdgcn_readfirstlane(tid_ >> 6); const int gw = vcu * NWAVES + wave, NGW = G * NWAVES;
        if (L == 0) { const float* X1 = args.out; bf16* Hb = WSP(bf16, WS_H); const float* g = args.in[1] + DM;
            for (int m = gw; m < MROWS; m += NGW) rms_row_to_bf16(X1 + (size_t)m * DM, g, Hb + (size_t)m * DM, lane); }
        else { const float* g = args.in[11]; float* out = args.out;
            for (int m = gw; m < MROWS; m += NGW) rms_row_f32(out + (size_t)m * DM, g, out + (size_t)m * DM, lane); }
    }
    SEAM(pb + 5);
}

__global__ void __launch_bounds__(NWAVES * 64, 2) mk_fwd(Args args) {
    extern __shared__ __attribute__((aligned(16))) unsigned char lds[];
    cg::grid_group grid = cg::this_grid();
    const int G = gridDim.x; const int bx = blockIdx.x; const int vcu = (G % 8 == 0) ? (bx % 8) * (G / 8) + bx / 8 : bx;
    const int lo = args.ph_lo, hi = args.ph_hi;
    if (IN(0)) prologue_phase(args, lds, G, vcu);
    SEAM(0);
    layer_phases<0>(args, lds, grid, lo, hi, G, bx, vcu);
    layer_phases<1>(args, lds, grid, lo, hi, G, bx, vcu);
}
#undef IN
#undef SEAM
#undef WSP

#ifndef MK_PH_MAX
#define MK_PH_MAX N_PHASES
#endif
#ifndef MK_PH_MIN
#define MK_PH_MIN 0
#endif
#ifndef MK_LAUNCH_PER_PHASE
#define MK_LAUNCH_PER_PHASE 1
#endif
__global__ void diag_fill(float* o, int n, float c) { for (int i = blockIdx.x * 256 + threadIdx.x; i < n; i += gridDim.x * 256) o[i] = c; }
extern "C" void kernel_launch(void* const* d_in, const int* in_sizes, int n_in, void* d_out, int out_size, void* d_ws, size_t ws_size, hipStream_t stream) {
    static int grid = 0;
    if (grid == 0) {
        if (n_in != 12 || in_sizes[0] != MROWS * DM || out_size != MROWS * DM || ws_size < WS_END) {
            fprintf(stderr, "kernel_launch: unexpected shapes: n_in %d in0 %d out %d ws %zu (need >= %zu)\n", n_in, n_in > 0 ? in_sizes[0] : -1, out_size, ws_size, (size_t)WS_END);
            const float code = (n_in != 12) ? 30.f : (in_sizes[0] != MROWS * DM) ? 40.f : (out_size != MROWS * DM) ? 50.f : (float)(ws_size >> 26);
            hipLaunchKernelGGL(diag_fill, dim3(1024), dim3(256), 0, stream, (float*)d_out, out_size, code); return; }
        int dev = 0, cus = 0, per_cu = 0;
        if (hipGetDevice(&dev) != hipSuccess || hipDeviceGetAttribute(&cus, hipDeviceAttributeMultiprocessorCount, dev) != hipSuccess) { fprintf(stderr, "kernel_launch: device query failed\n"); grid = -1; return; }
        if (hipFuncSetAttribute((const void*)mk_fwd, hipFuncAttributeMaxDynamicSharedMemorySize, LDS_BYTES) != hipSuccess) { fprintf(stderr, "kernel_launch: hipFuncSetAttribute failed\n"); grid = -1; return; }
        if (hipOccupancyMaxActiveBlocksPerMultiprocessor(&per_cu, (const void*)mk_fwd, NWAVES * 64, LDS_BYTES) != hipSuccess || per_cu < 1) {
            fprintf(stderr, "kernel_launch: occupancy query reports %d workgroups per CU\n", per_cu); (void)hipGetLastError(); per_cu = 1; }
        grid = cus;
        if (grid > 256) grid = 256;
    }
    if (grid < 0) return;
    (void)hipMemsetAsync((char*)d_ws + WS_CTL, 0, CTL_ZERO_BYTES, stream);
    Args a{};
    for (int i = 0; i < 12; ++i) a.in[i] = (const float*)d_in[i];
    a.out = (float*)d_out; a.ws = (unsigned char*)d_ws;
#if MK_LAUNCH_PER_PHASE
    for (int p = MK_PH_MIN; p < MK_PH_MAX; ++p) { a.ph_lo = p; a.ph_hi = p + 1; hipLaunchKernelGGL(mk_fwd, dim3(grid), dim3(NWAVES * 64), LDS_BYTES, stream, a); }
    { const hipError_t le = hipPeekAtLastError(); if (le != hipSuccess) fprintf(stderr, "kernel_launch: launch failed: %s\n", hipGetErrorName(le)); }
#else
    a.ph_lo = 0; a.ph_hi = N_PHASES;
    void* kargs[] = {&a};
    const hipError_t e = hipLaunchCooperativeKernel((const void*)mk_fwd, dim3(grid), dim3(NWAVES * 64), kargs, LDS_BYTES, stream);
    if (e != hipSuccess) fprintf(stderr, "kernel_launch: cooperative launch failed: %s (grid %d)\n", hipGetErrorString(e), grid);
#endif
}
```

```cpp
#include <hip/hip_runtime.h>
#include <hip/hip_cooperative_groups.h>
#include <cstdio>
#include <cstdint>
namespace cg = cooperative_groups;

constexpr int BATCH = 4, SEQ = 4096, DM = 2048, MROWS = BATCH * SEQ, DEPTH = 2;
constexpr int NIN = 5952, NINP = 6144;
constexpr int QLORA = 512, KVLORA = 256, NQB = 1536, NKVB = 2048;
constexpr float EPS = 1e-6f;
constexpr float LOG2E = 1.4426950408889634f;
namespace pg8 {
#define PG8_LAS __attribute__((address_space(3)))
typedef unsigned short bf16_t;
typedef short bf16x8 __attribute__((ext_vector_type(8)));
typedef float f32x4 __attribute__((ext_vector_type(4)));
typedef unsigned u32x4 __attribute__((ext_vector_type(4)));
constexpr int BM = 256, BK = 64, HALF = 128, HTB = HALF * BK * 2  , STAGE_BYTES = 8 * HTB, NXCD = 8, WGM = 8;

__host__ __device__ __forceinline__ int lds_byte(int r, int c) { const int st = (r >> 4) * 2 + (c >> 5), rr = r & 15, cc = c & 31, ob = rr * 64 + cc * 2; return st * 1024 + (ob ^ (((ob >> 9) & 1) << 5)); }
__host__ __device__ __forceinline__ void stage_rc(int b, int& R, int& C) { const int st = b / 1024, sb = b % 1024, swz = sb ^ (((sb >> 9) & 1) << 5); R = (st >> 1) * 16 + swz / 64; C = (st & 1) * 32 + (swz % 64) / 2; }
__host__ __device__ __forceinline__ int perm32(int rho) { const int n = rho >> 4, i = rho & 15; return 8 * (i >> 2) + 4 * n + (i & 3); }

struct Unit { int pm, pn; };
struct Gemm { const bf16_t* A; const bf16_t* Bt; int M, N, K; };

struct StaticOrder {
    int nM, nN, nwg, G, c;
    __host__ __device__ void init(int M, int N, int G_, int c_) { nM = M / BM; nN = N / BM; nwg = nM * nN; G = G_; c = c_; }
    __host__ __device__ bool next(int i, Unit& u) const {
        const long L = (long)i * G + c; if (L >= nwg) return false;
        int wgid = (int)L; { const int q = nwg / NXCD, r = nwg % NXCD, xcd = wgid % NXCD, off = wgid / NXCD; wgid = (xcd < r ? xcd * (q + 1) : r * (q + 1) + (xcd - r) * q) + off; }
        const int nig = WGM * nN, gid = wgid / nig, fm = gid * WGM, gsz = (nM - fm) < WGM ? (nM - fm) : WGM;
        u.pm = fm + ((wgid % nig) % gsz); u.pn = (wgid % nig) / gsz; return true;
    }
    __device__ __forceinline__ void a_ready(const Unit&) const {}
    __device__ __forceinline__ void done(const Unit&) const {}
};

__device__ __forceinline__ unsigned cvt_pk_bf16(float lo, float hi) { unsigned r; asm volatile("v_cvt_pk_bf16_f32 %0, %1, %2" : "=v"(r) : "v"(lo), "v"(hi)); return r; }
typedef float f32x2 __attribute__((ext_vector_type(2)));
struct EpiInProj {
    static constexpr bool PERM = true, AFTER_DRAIN = false;
    bf16_t *QKV, *CQ, *CKV, *KR, *GATE; const float* ropec; const float* ropes; float* ssq_q; float* ssq_kv;
    __device__ __forceinline__ void operator()(const f32x4 (&acc)[2][2][4][2], const Unit& u, int wr, int wc, int fr, int fq) const {
        const int row0 = u.pm * BM + wr * 64 + fr; const int pn = u.pn;
        if (pn == 15) {
            if (wc < 2) {
                const int a = wc * 4 + fq;
#pragma unroll
                for (int ai = 0; ai < 2; ++ai)
#pragma unroll
                    for (int m = 0; m < 4; ++m) { const int row = row0 + ai * HALF + m * 16, s = row & (SEQ - 1);
                        const f32x4 c = *(const f32x4*)(ropec + s * 32 + 4 * a), sn = *(const f32x4*)(ropes + s * 32 + 4 * a);
                        const f32x4 x1 = acc[ai][0][m][0], x2 = acc[ai][0][m][1];
                        const f32x4 y1 = x1 * c - x2 * sn, y2 = x1 * sn + x2 * c;
                        u32x4 w; w.x = cvt_pk_bf16(y1[0], y1[1]); w.y = cvt_pk_bf16(y1[2], y1[3]); w.z = cvt_pk_bf16(y2[0], y2[1]); w.w = cvt_pk_bf16(y2[2], y2[3]);
                        *(u32x4*)(KR + (size_t)row * 64 + 8 * a) = w; }
            }
            return;
        }
        bf16_t* base; int ldc, colt;
        if (pn < 12) { base = QKV; ldc = 3072; colt = pn * 256; }
        else if (pn < 14) { base = CQ; ldc = 512; colt = (pn - 12) * 256; }
        else if (pn == 14) { base = CKV; ldc = 256; colt = 0; }
        else { base = GATE; ldc = 2048; colt = (pn - 16) * 256; }
        const int col0 = colt + wc * 32 + 8 * fq;
        const float sc = (pn < 4) ? 0.125f * 1.4426950408889634f : 1.0f;
#pragma unroll
        for (int ai = 0; ai < 2; ++ai)
#pragma unroll
            for (int m = 0; m < 4; ++m) { bf16_t* rowp = base + (size_t)(row0 + ai * HALF + m * 16) * ldc + col0;
#pragma unroll
                for (int bj = 0; bj < 2; ++bj) { const f32x4 v0 = acc[ai][bj][m][0] * sc, v1 = acc[ai][bj][m][1] * sc;
                    u32x4 w; w.x = cvt_pk_bf16(v0[0], v0[1]); w.y = cvt_pk_bf16(v0[2], v0[3]); w.z = cvt_pk_bf16(v1[0], v1[1]); w.w = cvt_pk_bf16(v1[2], v1[3]);
                    *(u32x4*)(rowp + bj * HALF) = w; } }
        if (pn >= 12 && pn <= 14) {
            float* ssq = (pn == 14) ? ssq_kv : ssq_q;
#pragma unroll
            for (int ai = 0; ai < 2; ++ai)
#pragma unroll
                for (int m = 0; m < 4; ++m) { float s = 0.f;
#pragma unroll
                    for (int bj = 0; bj < 2; ++bj)
#pragma unroll
                        for (int n = 0; n < 2; ++n) { const f32x4 v = acc[ai][bj][m][n]; s += (v[0] * v[0] + v[1] * v[1]) + (v[2] * v[2] + v[3] * v[3]); }
                    s += __shfl_xor(s, 16); s += __shfl_xor(s, 32);
                    if (fq == 0) __hip_atomic_fetch_add(ssq + row0 + ai * HALF + m * 16, s, __ATOMIC_RELAXED, __HIP_MEMORY_SCOPE_AGENT); }
        }
    }
};
template <bool ROPE> struct EpiRowScale {
    static constexpr bool PERM = true, AFTER_DRAIN = false;
    bf16_t* O; int ldc; const float* ssq; float inv_n; const float* ropec; const float* ropes; float qscale;
    __device__ __forceinline__ void operator()(const f32x4 (&acc)[2][2][4][2], const Unit& u, int wr, int wc, int fr, int fq) const {
        const int row0 = u.pm * BM + wr * 64 + fr; const int col0 = u.pn * BM + wc * 32 + 8 * fq;
        bool isr[2]; int ra[2];
#pragma unroll
        for (int bj = 0; bj < 2; ++bj) { const int c0 = col0 + bj * HALF, off = c0 % 192; isr[bj] = ROPE && (off >= 128); ra[bj] = (off - 128) >> 3; }
#pragma unroll
        for (int ai = 0; ai < 2; ++ai)
#pragma unroll
            for (int m = 0; m < 4; ++m) { const int row = row0 + ai * HALF + m * 16, s = row & (SEQ - 1); const float r = qscale / sqrtf(ssq[row] * inv_n + 1e-6f);
                bf16_t* rowp = O + (size_t)row * ldc + col0;
#pragma unroll
                for (int bj = 0; bj < 2; ++bj) { f32x4 v0 = acc[ai][bj][m][0] * r, v1 = acc[ai][bj][m][1] * r;
                    if (ROPE) { if (isr[bj]) { const f32x4 c = *(const f32x4*)(ropec + s * 32 + 4 * ra[bj]), sn = *(const f32x4*)(ropes + s * 32 + 4 * ra[bj]);
                        const f32x4 y1 = v0 * c - v1 * sn, y2 = v0 * sn + v1 * c; v0 = y1; v1 = y2; } }
                    u32x4 w; w.x = cvt_pk_bf16(v0[0], v0[1]); w.y = cvt_pk_bf16(v0[2], v0[3]); w.z = cvt_pk_bf16(v1[0], v1[1]); w.w = cvt_pk_bf16(v1[2], v1[3]);
                    *(u32x4*)(rowp + bj * HALF) = w; } }
    }
};
struct EpiResF32 {
    static constexpr bool PERM = false, AFTER_DRAIN = false;
    const float* base; float* out; int ldc;
    __device__ __forceinline__ void operator()(const f32x4 (&acc)[2][2][4][2], const Unit& u, int wr, int wc, int fr, int fq) const {
        const int row0 = u.pm * BM + wr * 64 + fr, col0 = u.pn * BM + wc * 32 + 4 * fq;
#pragma unroll
        for (int ai = 0; ai < 2; ++ai)
#pragma unroll
            for (int m = 0; m < 4; ++m) { const size_t off = (size_t)(row0 + ai * HALF + m * 16) * ldc + col0;
#pragma unroll
                for (int bj = 0; bj < 2; ++bj)
#pragma unroll
                    for (int n = 0; n < 2; ++n) { const f32x4 bs = *(const f32x4*)(base + off + bj * HALF + n * 16); *(f32x4*)(out + off + bj * HALF + n * 16) = bs + acc[ai][bj][m][n]; } }
    }
};
struct KvOrder : StaticOrder {
    __host__ __device__ bool next(int i, Unit& u) const {
        long L; if (G != 256) { L = (long)i * G + c; if (L >= nwg) return false; }
        else if (c < 128) { if (i > 0) return false; L = c; }
        else { if (i > 2) return false; L = 128 + 3 * (c - 128) + i; }
        int wgid = (int)L; { const int q = nwg / NXCD, r = nwg % NXCD, xcd = wgid % NXCD, off = wgid / NXCD; wgid = (xcd < r ? xcd * (q + 1) : r * (q + 1) + (xcd - r) * q) + off; }
        const int nig = WGM * nN, gid = wgid / nig, fm = gid * WGM, gsz = (nM - fm) < WGM ? (nM - fm) : WGM;
        u.pm = fm + ((wgid % nig) % gsz); u.pn = (wgid % nig) / gsz; return true;
    }
};
template <class Epi, class Sched, bool ALIGN_EPI = false, bool SP2 = false>
__device__ __forceinline__ void gemm_phase(PG8_LAS unsigned char* lds, const Gemm g, const Sched& S, const Epi& E) {
    int tid_ = threadIdx.x; asm volatile("" : "+v"(tid_));
    const int tid = tid_, wid = __builtin_amdgcn_readfirstlane(tid >> 6), lane = tid & 63, wr = wid >> 2, wc = wid & 3, fr = lane & 15, fq = lane >> 4;
    const int K = g.K, nt = K / BK;
    unsigned voffA[2], voffB[2];
#pragma unroll
    for (int i = 0; i < 2; ++i) { int R, C; stage_rc(tid * 16 + i * 8192, R, C); const int Rb = Epi::PERM ? ((R & ~31) + perm32(R & 31)) : R;
        voffA[i] = (unsigned)(R * K + C) * 2u; voffB[i] = (unsigned)(Rb * K + C) * 2u; }
    const size_t kstep = (size_t)(BK * 2);
    const size_t hstep = (size_t)HALF * K * 2;
    const size_t tstep = 2 * hstep;
    const unsigned ldsw = (unsigned)wid * 1024u;
    const int aoff = lds_byte(wr * 64 + fr, fq * 8), boff = lds_byte(wc * 32 + fr, fq * 8);
#define PG8_SA(b, h) (((b) * 2 + (h)) * HTB)
#define PG8_SB(b, h) ((4 + (b) * 2 + (h)) * HTB)
#define PG8_STAGE(bufoff, gbase, voff) do { _Pragma("unroll") for (int _i = 0; _i < 2; ++_i) \
        __builtin_amdgcn_global_load_lds((const unsigned*)((const char*)(gbase) + (voff)[_i]), (PG8_LAS unsigned*)(lds + (bufoff) + ldsw + _i * 8192), 16, 0, 0); } while (0)
#define PG8_LDA(dst, b, h) do { _Pragma("unroll") for (int m = 0; m < 4; ++m) _Pragma("unroll") for (int k = 0; k < 2; ++k) dst[m][k] = *(const PG8_LAS bf16x8*)(lds + PG8_SA(b, h) + aoff + m * 2048 + k * 1024); } while (0)
#define PG8_LDB(dst, b, h) do { _Pragma("unroll") for (int n = 0; n < 2; ++n) _Pragma("unroll") for (int k = 0; k < 2; ++k) dst[n][k] = *(const PG8_LAS bf16x8*)(lds + PG8_SB(b, h) + boff + n * 2048 + k * 1024); } while (0)
#define PG8_MMA(ai, bj, At, Bt) do { __builtin_amdgcn_s_setprio(1); _Pragma("unroll") for (int m = 0; m < 4; ++m) _Pragma("unroll") for (int n = 0; n < 2; ++n) _Pragma("unroll") for (int k = 0; k < 2; ++k) \
        acc[ai][bj][m][n] = __builtin_amdgcn_mfma_f32_16x16x32_bf16(Bt[n][k], At[m][k], acc[ai][bj][m][n], 0, 0, 0); __builtin_amdgcn_s_setprio(0); } while (0)
#define PG8_WAIT_V(n) asm volatile("s_waitcnt vmcnt(" #n ")" ::: "memory")
#define PG8_WAIT_L(n) asm volatile("s_waitcnt lgkmcnt(" #n ")" ::: "memory")
#define PG8_BAR __builtin_amdgcn_s_barrier()
#define PG8_SCHED __builtin_amdgcn_sched_barrier(0)
    Unit cur, nxt; int ui = 0;
    if (!S.next(0, cur)) return;
    f32x4 acc[2][2][4][2];
#pragma unroll
    for (int a = 0; a < 2; ++a)
#pragma unroll
        for (int b = 0; b < 2; ++b)
#pragma unroll
            for (int m = 0; m < 4; ++m)
#pragma unroll
                for (int n = 0; n < 2; ++n) acc[a][b][m][n] = (f32x4){0.f, 0.f, 0.f, 0.f};
    bf16x8 At[4][2], B0[2][2], B1[2][2];
    const char* cA = (const char*)g.A + (size_t)cur.pm * tstep; const char* cB = (const char*)g.Bt + (size_t)cur.pn * tstep;
    S.a_ready(cur);
    if constexpr (SP2) {
        PG8_STAGE(PG8_SB(0, 0), cB, voffB); PG8_STAGE(PG8_SB(0, 1), cB + hstep, voffB); PG8_STAGE(PG8_SA(0, 0), cA, voffA); PG8_STAGE(PG8_SA(0, 1), cA + hstep, voffA);
        if (wr == 1) PG8_BAR;
        PG8_WAIT_V(2); PG8_BAR;
        PG8_STAGE(PG8_SB(1, 0), cB + kstep, voffB); PG8_STAGE(PG8_SA(1, 0), cA + kstep, voffA); PG8_STAGE(PG8_SB(1, 1), cB + hstep + kstep, voffB);
        PG8_WAIT_V(6); PG8_BAR;
    } else {
        PG8_STAGE(PG8_SB(0, 0), cB, voffB); PG8_STAGE(PG8_SA(0, 0), cA, voffA); PG8_STAGE(PG8_SB(0, 1), cB + hstep, voffB); PG8_STAGE(PG8_SA(0, 1), cA + hstep, voffA);
        if (wr == 1) PG8_BAR;
        PG8_WAIT_V(4); PG8_BAR;
        PG8_STAGE(PG8_SB(1, 0), cB + kstep, voffB); PG8_STAGE(PG8_SA(1, 0), cA + kstep, voffA); PG8_STAGE(PG8_SB(1, 1), cB + hstep + kstep, voffB);
        PG8_WAIT_V(6); PG8_BAR;
    }
    for (;;) {
        const bool has_next = S.next(ui + 1, nxt);
        const char* nA = has_next ? (const char*)g.A + (size_t)nxt.pm * tstep : cA; const char* nB = has_next ? (const char*)g.Bt + (size_t)nxt.pn * tstep : cB;
        for (int t = 0; t < nt; t += 2) {
            const bool last = (t == nt - 2);
            const char* a1 = cA + (size_t)(t + 1) * kstep;
            const char* a2 = last ? nA : cA + (size_t)(t + 2) * kstep; const char* b2 = last ? nB : cB + (size_t)(t + 2) * kstep;
            const char* a3 = a2 + kstep; const char* b3 = b2 + kstep;
            if (last && has_next) S.a_ready(nxt);
            if constexpr (SP2) {
            PG8_LDB(B0, 0, 0); PG8_LDB(B1, 0, 1); PG8_SCHED; PG8_LDA(At, 0, 0); PG8_STAGE(PG8_SA(1, 1), a1 + hstep, voffA);
            PG8_WAIT_V(8); PG8_WAIT_L(0); PG8_BAR; PG8_MMA(0, 0, At, B0); PG8_MMA(0, 1, At, B1); PG8_BAR; PG8_SCHED;
            PG8_LDA(At, 0, 1); PG8_STAGE(PG8_SB(0, 0), b2, voffB); PG8_STAGE(PG8_SB(0, 1), b2 + hstep, voffB); PG8_STAGE(PG8_SA(0, 0), a2, voffA);
            PG8_WAIT_V(8); PG8_WAIT_L(0); PG8_BAR; PG8_MMA(1, 0, At, B0); PG8_MMA(1, 1, At, B1); PG8_BAR; PG8_SCHED;
            PG8_LDB(B0, 1, 0); PG8_LDB(B1, 1, 1); PG8_SCHED; PG8_LDA(At, 1, 0); PG8_STAGE(PG8_SA(0, 1), a2 + hstep, voffA);
            PG8_WAIT_V(8); PG8_WAIT_L(0); PG8_BAR; PG8_MMA(0, 0, At, B0); PG8_MMA(0, 1, At, B1); PG8_BAR; PG8_SCHED;
            PG8_LDA(At, 1, 1); PG8_STAGE(PG8_SB(1, 0), b3, voffB); PG8_STAGE(PG8_SB(1, 1), b3 + hstep, voffB); PG8_STAGE(PG8_SA(1, 0), a3, voffA);
            PG8_WAIT_V(8); PG8_WAIT_L(0); PG8_BAR; PG8_MMA(1, 0, At, B0); PG8_MMA(1, 1, At, B1); PG8_BAR; PG8_SCHED;
            } else {
            PG8_LDB(B0, 0, 0); PG8_SCHED; PG8_LDA(At, 0, 0); PG8_STAGE(PG8_SA(1, 1), a1 + hstep, voffA);
            PG8_WAIT_L(8); PG8_BAR; PG8_WAIT_L(0); PG8_MMA(0, 0, At, B0); PG8_BAR; PG8_SCHED;
            PG8_LDB(B1, 0, 1); PG8_STAGE(PG8_SB(0, 0), b2, voffB);
            PG8_BAR; PG8_WAIT_L(0); PG8_MMA(0, 1, At, B1); PG8_BAR;
            PG8_LDA(At, 0, 1); PG8_STAGE(PG8_SA(0, 0), a2, voffA);
            PG8_BAR; PG8_WAIT_L(0); PG8_MMA(1, 0, At, B0); PG8_BAR; PG8_SCHED;
            PG8_STAGE(PG8_SB(0, 1), b2 + hstep, voffB);
            PG8_WAIT_V(6); PG8_BAR; PG8_MMA(1, 1, At, B1); PG8_BAR;
            PG8_LDB(B0, 1, 0); PG8_SCHED; PG8_LDA(At, 1, 0); PG8_STAGE(PG8_SA(0, 1), a2 + hstep, voffA);
            PG8_WAIT_L(8); PG8_BAR; PG8_WAIT_L(0); PG8_MMA(0, 0, At, B0); PG8_BAR; PG8_SCHED;
            PG8_LDB(B1, 1, 1); PG8_STAGE(PG8_SB(1, 0), b3, voffB);
            PG8_BAR; PG8_WAIT_L(0); PG8_MMA(0, 1, At, B1); PG8_BAR;
            PG8_LDA(At, 1, 1); PG8_STAGE(PG8_SA(1, 0), a3, voffA);
            PG8_BAR; PG8_WAIT_L(0); PG8_MMA(1, 0, At, B0); PG8_BAR; PG8_SCHED;
            PG8_STAGE(PG8_SB(1, 1), b3 + hstep, voffB);
            PG8_WAIT_V(6); PG8_BAR; PG8_MMA(1, 1, At, B1); PG8_BAR;
            }
        }
        if constexpr (ALIGN_EPI) { if (wr == 0) PG8_BAR; }
        if constexpr (!Epi::AFTER_DRAIN) { E(acc, cur, wr, wc, fr, fq); S.done(cur); }
        if (!has_next) break;
#pragma unroll
        for (int a = 0; a < 2; ++a)
#pragma unroll
            for (int b = 0; b < 2; ++b)
#pragma unroll
                for (int m = 0; m < 4; ++m)
#pragma unroll
                    for (int n = 0; n < 2; ++n) acc[a][b][m][n] = (f32x4){0.f, 0.f, 0.f, 0.f};
        cur = nxt; cA = nA; cB = nB; ++ui;
        if constexpr (ALIGN_EPI) { if (wr == 1) PG8_BAR; }
    }
    PG8_WAIT_V(0);
    if constexpr (!ALIGN_EPI) { if (wr == 0) PG8_BAR; }
    PG8_BAR;
    if constexpr (Epi::AFTER_DRAIN) { E.fused(acc, cur, wr, wc, fr, fq, lds, wid, lane); S.done(cur); }
#undef PG8_SA
#undef PG8_SB
#undef PG8_STAGE
#undef PG8_LDA
#undef PG8_LDB
#undef PG8_MMA
#undef PG8_WAIT_V
#undef PG8_WAIT_L
#undef PG8_BAR
#undef PG8_SCHED
}
}
#define GAS __attribute__((address_space(1)))
#define LAS __attribute__((address_space(3)))
typedef unsigned short bf16;
typedef unsigned v4u __attribute__((ext_vector_type(4)));
typedef float f32x4 __attribute__((ext_vector_type(4)));
typedef short bf16x8 __attribute__((ext_vector_type(8)));
typedef GAS unsigned gu32;
typedef GAS unsigned long long gu64;
#define RLX_AGENT __ATOMIC_RELAXED, __HIP_MEMORY_SCOPE_AGENT
#define LDS_WAIT() asm volatile("s_waitcnt lgkmcnt(0)" ::: "memory")
#define VM_WAIT() asm volatile("s_waitcnt vmcnt(0)" ::: "memory")
__device__ __forceinline__ unsigned long long rt() { return __builtin_amdgcn_s_memrealtime(); }
__device__ __forceinline__ unsigned f2bf(float f) { unsigned u = __builtin_bit_cast(unsigned, f); return (u + 0x7fffu + ((u >> 16) & 1u)) >> 16; }
__device__ __forceinline__ unsigned pk2(float lo, float hi) { return f2bf(lo) | (f2bf(hi) << 16); }

#define XB_TMO      128
#define XB_XCNT(j)  (256  + 64 * (j))
#define XB_XSUB(j)  (1280 + 64 * (j))
#define XB_XGEN(j)  (2304 + 64 * (j))
#define XB_TOP      3328
#define XB_TOPGEN   3392
#define XCD_BAR_WORDS 3456
#define XB_SPIN_CAP (1u << 18)

__device__ __forceinline__ unsigned xb_ld(unsigned* p)              { return __hip_atomic_load(p, __ATOMIC_RELAXED, __HIP_MEMORY_SCOPE_AGENT); }
__device__ __forceinline__ unsigned xb_add(unsigned* p, unsigned v) { return __hip_atomic_fetch_add(p, v, __ATOMIC_RELAXED, __HIP_MEMORY_SCOPE_AGENT); }
__device__ __forceinline__ unsigned xb_xcc_id() { return (unsigned)__builtin_amdgcn_s_getreg((3 << 11) | 20) & 0xFu; }
#define XB_SPIN(cond, bar) do { unsigned _sp = 0; while (cond) { __builtin_amdgcn_s_sleep(1); \
    if ((++_sp & 255u) == 0u) { if (xb_ld(&(bar)[XB_TMO])) break; if (_sp > XB_SPIN_CAP) { atomicAdd(&(bar)[XB_TMO], 1u); break; } } } } while (0)

struct XcdBarrier {
    unsigned* bar; unsigned x;
    volatile LAS unsigned* st;
};

__device__ __forceinline__ XcdBarrier xcd_barrier_post(unsigned* bar, volatile LAS unsigned* st) {
    XcdBarrier b; b.bar = bar; b.x = xb_xcc_id(); b.st = st;
    if (threadIdx.x == 0) (void)xb_add(&bar[XB_XCNT(b.x)], 1u);
    return b;
}
__device__ __forceinline__ void xcd_barrier_complete(unsigned* bar, unsigned x, unsigned& nloc, unsigned& nx) {
    const unsigned G = gridDim.x * gridDim.y * gridDim.z;
    unsigned sum, cnt, mine, sp = 0u;
    for (;;) {
        sum = 0u; cnt = 0u; mine = 0u;
#pragma unroll
        for (unsigned j = 0; j < 16; ++j) { const unsigned c = xb_ld(&bar[XB_XCNT(j)]); sum += c; cnt += (c > 0u) ? 1u : 0u; mine = (j == x) ? c : mine; }
        if (sum == G) break;
        __builtin_amdgcn_s_sleep(1);
        if ((++sp & 255u) == 0u) { if (xb_ld(&bar[XB_TMO])) break; if (sp > XB_SPIN_CAP) { atomicAdd(&bar[XB_TMO], 1u); break; } }
    }
    nloc = mine > 0u ? mine : 1u; nx = cnt > 0u ? cnt : 1u;
}

__device__ __forceinline__ void xcd_barrier(const XcdBarrier& b) {
    asm volatile("s_waitcnt vmcnt(0)" ::: "memory");
    __syncthreads();
    if (threadIdx.x == 0) {
        unsigned* bar = b.bar;
        __builtin_amdgcn_s_waitcnt(0);
        unsigned nloc = b.st[0], nx = b.st[1];
        if (nloc == 0u) { xcd_barrier_complete(bar, b.x, nloc, nx); b.st[0] = nloc; b.st[1] = nx; }
        const unsigned old = xb_add(&bar[XB_XSUB(b.x)], 1u);
        const unsigned gen = old / nloc;
        if (old + 1u == (gen + 1u) * nloc) {
            __builtin_amdgcn_fence(__ATOMIC_RELEASE, "agent");
            asm volatile("s_waitcnt vmcnt(0)" ::: "memory");
            const unsigned og = xb_add(&bar[XB_TOP], 1u);
            const unsigned tg = og / nx;
            if (og + 1u == (tg + 1u) * nx) xb_add(&bar[XB_TOPGEN], 1u);
            else XB_SPIN(xb_ld(&bar[XB_TOPGEN]) == tg, bar);
            __builtin_amdgcn_fence(__ATOMIC_ACQUIRE, "agent");
            xb_add(&bar[XB_XGEN(b.x)], 1u);
            asm volatile("s_waitcnt vmcnt(0)" ::: "memory");
        } else {
            XB_SPIN(xb_ld(&bar[XB_XGEN(b.x)]) == gen, bar);
            __builtin_amdgcn_fence(__ATOMIC_ACQUIRE, "agent");
            asm volatile("s_waitcnt vmcnt(0)" ::: "memory");
        }
    }
    __syncthreads();
}
namespace att {
typedef unsigned short bf16;
typedef short bf16x8 __attribute__((ext_vector_type(8)));
typedef short s16x4 __attribute__((ext_vector_type(4)));
typedef short v4i16_t __attribute__((ext_vector_type(4)));
typedef float f32x16 __attribute__((ext_vector_type(16)));
typedef unsigned u32x4 __attribute__((ext_vector_type(4)));
typedef float f32x2_t __attribute__((ext_vector_type(2)));
typedef __bf16 bf16x2_t __attribute__((ext_vector_type(2)));
#define ALDS __attribute__((address_space(3)))
#define ASBAR() __builtin_amdgcn_sched_barrier(0)
constexpr int WS_OFF = 135168;
constexpr int TAB_OFF = WS_OFF + 2048;
constexpr int QR_OFF = 81920;
constexpr int NQL = 6;
constexpr int ATT_LDS_BYTES = TAB_OFF + 2048;
static_assert(QR_OFF + 8 * NQL * 1024 <= WS_OFF, "MLA query park fits below the scratch");
#ifndef ATT_STAGGER
#define ATT_STAGGER 0
#endif
#ifndef ATT_PRIO
#define ATT_PRIO 0
#endif
constexpr float THR2 = 8.0f;
__device__ __forceinline__ int crow(int r, int hi) { return (r & 3) + 8 * (r >> 2) + 4 * hi; }
__device__ __forceinline__ void glds16(const void* gsrc, unsigned lds_dst) { unsigned keep;
    asm volatile("s_mov_b32 %0, m0\n\ts_mov_b32 m0, %2\n\ts_nop 0\n\tglobal_load_lds_dwordx4 %1, off\n\ts_mov_b32 m0, %0" : "=&s"(keep) : "v"(gsrc), "s"(lds_dst) : "memory"); }
template <int IMM> __device__ __forceinline__ void glds16s(const void* sbase, unsigned voff, unsigned lds_dst_) { unsigned keep; const unsigned lds_dst = lds_dst_ - (unsigned)IMM;
    asm volatile("s_mov_b32 %0, m0\n\ts_mov_b32 m0, %3\n\ts_nop 3\n\tglobal_load_lds_dwordx4 %1, %2 offset:%c4\n\ts_mov_b32 m0, %0" : "=&s"(keep) : "v"(voff), "s"(sbase), "s"(lds_dst), "i"(IMM) : "memory"); }
__device__ __forceinline__ const unsigned char* uni_ptr(const void* p) { const unsigned long long v = (unsigned long long)p;
    const unsigned lo = __builtin_amdgcn_readfirstlane((unsigned)v), hi = __builtin_amdgcn_readfirstlane((unsigned)(v >> 32)); return (const unsigned char*)(((unsigned long long)hi << 32) | lo); }
__device__ __forceinline__ unsigned cvtpk_s(float lo, float hi) { f32x2_t v = {lo, hi}; bf16x2_t b = __builtin_convertvector(v, bf16x2_t); return __builtin_bit_cast(unsigned, b); }
__device__ __forceinline__ float swapmax(float v) { auto rr = __builtin_amdgcn_permlane32_swap(__float_as_uint(v), __float_as_uint(v), false, false); return fmaxf(__uint_as_float(rr[0]), __uint_as_float(rr[1])); }
__device__ __forceinline__ float swapsum(float v) { auto rr = __builtin_amdgcn_permlane32_swap(__float_as_uint(v), __float_as_uint(v), false, false); return __uint_as_float(rr[0]) + __uint_as_float(rr[1]); }
#define ATT_WAIT_BAR() asm volatile("s_waitcnt vmcnt(0) lgkmcnt(0)\n\ts_barrier" ::: "memory")
#define ATT_WAIT_BAR_N(N) asm volatile("s_waitcnt vmcnt(" #N ") lgkmcnt(0)\n\ts_barrier" ::: "memory")

__device__ __forceinline__ s16x4 vtr(ALDS const unsigned char* p) { return __builtin_bit_cast(s16x4, __builtin_amdgcn_ds_read_tr16_b64_v4i16((ALDS v4i16_t*)p)); }

struct AttnArgs { void* prof; const bf16* QKV; const bf16* QM; const bf16* KVM; const bf16* KR; const bf16* GATE; bf16* Y; const float* biastab; const float* subg; float lam; float oml; };

__device__ __forceinline__ void pv4(f32x16* o, int vb, bf16x8 pa0, bf16x8 pa1, bf16x8 pa2, bf16x8 pa3) {
#pragma unroll
    for (int d0 = 0; d0 < 4; ++d0) { s16x4 lo[4], hh[4];
#pragma unroll
        for (int ks = 0; ks < 4; ++ks) {
            asm volatile("ds_read_b64_tr_b16 %0, %1 offset:%c2" : "=&v"(lo[ks]) : "v"(vb), "i"(d0 * 4096 + ks * 1024) : "memory");
            asm volatile("ds_read_b64_tr_b16 %0, %1 offset:%c2" : "=&v"(hh[ks]) : "v"(vb), "i"(d0 * 4096 + ks * 1024 + 512) : "memory"); }
        asm volatile("s_waitcnt lgkmcnt(0)" ::: "memory"); ASBAR();
#define ATT_PK(k) (bf16x8){lo[k][0], lo[k][1], lo[k][2], lo[k][3], hh[k][0], hh[k][1], hh[k][2], hh[k][3]}
        o[d0] = __builtin_amdgcn_mfma_f32_32x32x16_bf16(pa0, ATT_PK(0), o[d0], 0, 0, 0);
        o[d0] = __builtin_amdgcn_mfma_f32_32x32x16_bf16(pa1, ATT_PK(1), o[d0], 0, 0, 0);
        o[d0] = __builtin_amdgcn_mfma_f32_32x32x16_bf16(pa2, ATT_PK(2), o[d0], 0, 0, 0);
        o[d0] = __builtin_amdgcn_mfma_f32_32x32x16_bf16(pa3, ATT_PK(3), o[d0], 0, 0, 0);
#undef ATT_PK
    }
}

template <bool DIFF, int MODE = 0>
__device__ __forceinline__ void attn_unit(const AttnArgs& A, int b, int h, int qb, unsigned char* shm) {
    constexpr int ND0 = DIFF ? 4 : 12;
    constexpr int QROWS = DIFF ? 128 : 256;
    constexpr int KSLOT = DIFF ? 16384 : 24576;
    constexpr int LEAD = DIFF ? 2 : 1;
    constexpr int NSLOT = LEAD + 1;
    constexpr int V_OFF = NSLOT * KSLOT;
    int tid_ = threadIdx.x; asm volatile("" : "+v"(tid_));
    const int tid = tid_, lane = tid & 63, r32 = lane & 31, hi = lane >> 5; const int wid = __builtin_amdgcn_readfirstlane(tid >> 6);
    const int map = DIFF ? (wid >> 2) : 0, wrow = DIFF ? (wid & 3) : wid;
    const int q0 = qb * QROWS + wrow * 32;
    const int cw = q0 >> 6;
    const int NT = (qb * QROWS + QROWS) >> 6;
    const long rowbase = (long)b * SEQ;
    const unsigned lds0 = (unsigned)(uintptr_t)shm;
    ALDS unsigned char* shm3 = (ALDS unsigned char*)shm;
    ALDS float* wsf = (ALDS float*)(shm3 + WS_OFF) + wid * 64;
    ALDS float* tabl = (ALDS float*)(shm3 + TAB_OFF) + map * 256;
    const int vrow = 16 * (wid & 3) + (lane >> 2), vcol = (wid >> 2) * 32 + (lane & 3) * 8;
    constexpr int PITCHB = DIFF ? 6144 : 4096;
    const int krow = 8 * wid + (lane >> 3), kchk = (lane & 7) ^ ((krow >> 1) & 7);
    const unsigned voffK = (unsigned)(krow * PITCHB + kchk * 16), voffV = (unsigned)(vrow * PITCHB + vcol * 2), voffR = (unsigned)(krow * 128 + kchk * 16);
    const unsigned char* kvbase = DIFF ? (const unsigned char*)(A.QKV + rowbase * 3072 + 1024 + h * 128) : (const unsigned char*)(A.KVM + rowbase * 2048 + h * 256);
    const unsigned char* krbase = (const unsigned char*)(A.KR + rowbase * 64);
    const unsigned kd0 = lds0 + wid * 1024, vd0 = lds0 + V_OFF + wid * 1024;
    constexpr int VIMM = DIFF ? 2048 : 256;
#define ATT_DMA_K(t, sl) do { const long _t = (t); const unsigned _so = (unsigned)((sl) * KSLOT); const unsigned char* _b = uni_ptr(kvbase + _t * (64L * PITCHB)); \
        glds16s<0>(_b, voffK, (unsigned)__builtin_amdgcn_readfirstlane(kd0 + _so)); \
        glds16s<128>(_b, voffK, (unsigned)__builtin_amdgcn_readfirstlane(kd0 + 8192 + _so)); \
        if (!DIFF) glds16s<0>(uni_ptr(krbase + _t * (64L * 128)), voffR, (unsigned)__builtin_amdgcn_readfirstlane(kd0 + 16384 + _so)); } while (0)
#define ATT_DMA_V(t, sl) do { const long _t = (t); const unsigned _so = (unsigned)((sl) * 16384); const unsigned char* _b = uni_ptr(kvbase + _t * (64L * PITCHB)); \
        glds16s<VIMM>(_b, voffV, (unsigned)__builtin_amdgcn_readfirstlane(vd0 + _so)); \
        glds16s<VIMM + 128>(_b, voffV, (unsigned)__builtin_amdgcn_readfirstlane(vd0 + 8192 + _so)); } while (0)
    if (MODE < 2) { ATT_DMA_K(0, 0); if (LEAD == 2) { if (1 < NT) ATT_DMA_K(1, 1); ATT_DMA_V(0, 0); } }
    if (DIFF) { ((ALDS float*)(shm3 + TAB_OFF))[tid] = A.biastab[(h * 2 + (tid >> 8)) * 256 + (tid & 255)]; }
    constexpr int NQREG = DIFF ? ND0 : ND0 - NQL;
    bf16x8 qr[NQREG];
    ALDS unsigned char* qlds = shm3 + QR_OFF + wid * (NQL * 1024) + lane * 16;
    { const bf16* Qw = DIFF ? A.QKV + (rowbase + q0 + r32) * 3072 + h * 128 + map * 64 + hi * 8 : A.QM + (rowbase + q0 + r32) * 1536 + h * 192 + hi * 8;
#pragma unroll
      for (int d0 = 0; d0 < NQREG; ++d0) qr[d0] = *reinterpret_cast<const bf16x8*>(Qw + d0 * 16);
      if (!DIFF) {
#pragma unroll
          for (int d0 = NQREG; d0 < ND0; ++d0) *(ALDS bf16x8*)(qlds + (d0 - NQREG) * 1024) = *reinterpret_cast<const bf16x8*>(Qw + d0 * 16); } }
    float boff = 0.f; if (DIFF) boff = A.biastab[(h * 2 + map) * 256];
    float m_ref = 0.f, l_reg = 0.f; f32x16 o[4];
#pragma unroll
    for (int d = 0; d < 4; ++d) o[d] = f32x16{};
    const int kfo = (DIFF ? map * 8192 : 0) + r32 * 128;
    int ko[4];
#pragma unroll
    for (int i = 0; i < 4; ++i) ko[i] = 16 * ((2 * i + hi) ^ ((r32 >> 1) & 7));
    const int vbo = V_OFF + ((lane >> 4) & 1) * 32 + (lane & 3) * 8 + (4 * hi + ((lane & 15) >> 2)) * 64;
    f32x16 pA0, pA1, pB0, pB1; float alA = 1.f, alB = 1.f;
    u32x4 pw0, pw1, pw2, pw3;
    s16x4 vAl[4], vAh[4], vBl[4], vBh[4]; bf16x8 kf[8]; f32x16 negm; float negv = 3e38f;
#pragma unroll
    for (int r = 0; r < 16; ++r) negm[r] = 0.f;
#define ATT_MF(acc, a, b) acc = __builtin_amdgcn_mfma_f32_32x32x16_bf16(a, b, acc, 0, 0, 0)
#define ATT_QK(P0, P1, T) do { ALDS const unsigned char* kp_ = shm3 + sj * KSLOT + kfo; \
        const float nb_ = ((DIFF && ((T) + 2 < cw)) ? boff : 0.f) - m_ref; \
        _Pragma("unroll") for (int r = 0; r < 16; ++r) { P0[r] = nb_; P1[r] = nb_; } \
        _Pragma("unroll") for (int d0 = 0; d0 < ND0; ++d0) { \
            const bf16x8 b0_ = *(ALDS const bf16x8*)(kp_ + (d0 >> 2) * 8192 + ko[d0 & 3]); const bf16x8 b1_ = *(ALDS const bf16x8*)(kp_ + (d0 >> 2) * 8192 + ko[d0 & 3] + 4096); \
            bf16x8 q_; if (d0 < NQREG) q_ = qr[d0 < NQREG ? d0 : 0]; else q_ = *(ALDS const bf16x8*)(qlds + (d0 - NQREG) * 1024); \
            ATT_MF(P0, b0_, q_); ATT_MF(P1, b1_, q_); } } while (0)
#define ATT_FIN(P0, P1, AL) do { float ps_;   \
        { float s0_ = P0[0] + P1[0], s1_ = P0[1] + P1[1], s2_ = P0[2] + P1[2], s3_ = P0[3] + P1[3]; \
          _Pragma("unroll") for (int r = 4; r < 16; r += 4) { s0_ += P0[r] + P1[r]; s1_ += P0[r + 1] + P1[r + 1]; s2_ += P0[r + 2] + P1[r + 2]; s3_ += P0[r + 3] + P1[r + 3]; } \
          ps_ = (s0_ + s1_) + (s2_ + s3_); } \
        l_reg = l_reg * (AL) + ps_; \
        pw0 = (u32x4){cvtpk_s(P0[0], P0[1]), cvtpk_s(P0[2], P0[3]), cvtpk_s(P0[4], P0[5]), cvtpk_s(P0[6], P0[7])}; \
        pw1 = (u32x4){cvtpk_s(P0[8], P0[9]), cvtpk_s(P0[10], P0[11]), cvtpk_s(P0[12], P0[13]), cvtpk_s(P0[14], P0[15])}; \
        pw2 = (u32x4){cvtpk_s(P1[0], P1[1]), cvtpk_s(P1[2], P1[3]), cvtpk_s(P1[4], P1[5]), cvtpk_s(P1[6], P1[7])}; \
        pw3 = (u32x4){cvtpk_s(P1[8], P1[9]), cvtpk_s(P1[10], P1[11]), cvtpk_s(P1[12], P1[13]), cvtpk_s(P1[14], P1[15])}; } while (0)
#define ATT_VRD(VL, VH, d0) do { if (MODE == 5) break; _Pragma("unroll") for (int ks = 0; ks < 4; ++ks) { VL[ks] = vtr(vp_ + (d0) * 4096 + ks * 1024); VH[ks] = vtr(vp_ + (d0) * 4096 + ks * 1024 + 512); } } while (0)
#define ATT_VF(VL, VH, k) (bf16x8){VL[k][0], VL[k][1], VL[k][2], VL[k][3], VH[k][0], VH[k][1], VH[k][2], VH[k][3]}
#define ATT_MF4(od, VL, VH) do { if (MODE == 6 || MODE == 8) break; ATT_MF(od, __builtin_bit_cast(bf16x8, pw0), ATT_VF(VL, VH, 0)); ATT_MF(od, __builtin_bit_cast(bf16x8, pw1), ATT_VF(VL, VH, 1)); \
        ATT_MF(od, __builtin_bit_cast(bf16x8, pw2), ATT_VF(VL, VH, 2)); ATT_MF(od, __builtin_bit_cast(bf16x8, pw3), ATT_VF(VL, VH, 3)); } while (0)
#define ATT_SM_BIAS(P0, P1, T) do { if (MODE == 3) break; if (DIFF && ((T) + 2 >= cw) && ((T) <= cw)) { ALDS const float* tb_ = tabl + (64 * (T) - q0 - r32 + 192); \
        _Pragma("unroll") for (int r = 0; r < 16; ++r) { const int kk_ = crow(r, hi); P0[r] += tb_[kk_]; P1[r] += tb_[kk_ + 32]; } } } while (0)
#define ATT_SM_MAX0(P0) do { if (MODE == 3) break; rma_ = fmaxf(fmaxf(P0[0], P0[1]), P0[2]); rmb_ = fmaxf(fmaxf(P0[3], P0[4]), P0[5]); rmc_ = fmaxf(fmaxf(P0[6], P0[7]), P0[8]); rmd_ = fmaxf(fmaxf(P0[9], P0[10]), P0[11]); \
        rma_ = fmaxf(fmaxf(rma_, P0[12]), P0[13]); rmb_ = fmaxf(fmaxf(rmb_, P0[14]), P0[15]); } while (0)
#define ATT_SM_MAX1(P1) do { if (MODE == 3) break; rmc_ = fmaxf(fmaxf(rmc_, P1[0]), P1[1]); rmd_ = fmaxf(fmaxf(rmd_, P1[2]), P1[3]); rma_ = fmaxf(fmaxf(rma_, P1[4]), P1[5]); rmb_ = fmaxf(fmaxf(rmb_, P1[6]), P1[7]); \
        rmc_ = fmaxf(fmaxf(rmc_, P1[8]), P1[9]); rmd_ = fmaxf(fmaxf(rmd_, P1[10]), P1[11]); rma_ = fmaxf(fmaxf(rma_, P1[12]), P1[13]); rmb_ = fmaxf(fmaxf(rmb_, P1[14]), P1[15]); \
        rma_ = swapmax(fmaxf(fmaxf(rma_, rmb_), fmaxf(rmc_, rmd_))); } while (0)
#define ATT_SM_DEC(P0, P1, AL, FIRST) do { if (MODE == 3) break; AL = 1.f; if ((FIRST) || __any(rma_ > THR2)) { const float dl_ = (FIRST) ? rma_ : fmaxf(rma_, 0.f); m_ref += dl_; \
        _Pragma("unroll") for (int r = 0; r < 16; ++r) { P0[r] -= dl_; P1[r] -= dl_; } \
        AL = (FIRST) ? 1.f : __builtin_amdgcn_exp2f(-dl_); } } while (0)
#define ATT_SM_EXP(P) do { if (MODE == 3) break; _Pragma("unroll") for (int r = 0; r < 16; ++r) P[r] = __builtin_amdgcn_exp2f(P[r]); } while (0)
#define ATT_RESC(AL) do { if (__any((AL) < 1.f)) { if (hi == 0) wsf[r32] = (AL); asm volatile("s_waitcnt lgkmcnt(0)" ::: "memory"); \
        _Pragma("unroll") for (int r = 0; r < 16; ++r) { const float al_ = wsf[crow(r, hi)]; _Pragma("unroll") for (int d = 0; d < 4; ++d) o[d][r] *= al_; } } } while (0)
#define ATT_STEP(PQ0, PQ1, ALQ, PF0, PF1, ALF, J) do { const int j_ = (J); \
        const int sm1_ = (sj == 0) ? NSLOT - 1 : sj - 1, sm2_ = (sm1_ == 0) ? NSLOT - 1 : sm1_ - 1;     \
        int nd_ = 0; if (MODE < 2) { if (j_ + LEAD < NT) { ATT_DMA_K(j_ + LEAD, sm1_); nd_ += DIFF ? 2 : 3; } if (j_ + LEAD - 1 < NT) { ATT_DMA_V(j_ + LEAD - 1, sm2_); nd_ += 2; } } \
        if (MODE != 1 && MODE != 9 && j_ <= cw + 1) { \
            ALDS const unsigned char* vp_ = shm3 + vbo + sm1_ * 16384; float rma_, rmb_, rmc_, rmd_; const bool first_ = (j_ == 0); \
            if (DIFF) {   \
                const int sp1_ = (sj + 1 == NSLOT) ? 0 : sj + 1; \
                ASBAR(); \
                { const float nb_ = ((j_ + 2 < cw) ? boff : 0.f) - m_ref;     \
                  if (__any(nb_ != negv)) { negv = nb_; _Pragma("unroll") for (int r = 0; r < 16; ++r) negm[r] = nb_; asm volatile("" : "+v"(negm)); } \
                  PQ0 = __builtin_amdgcn_mfma_f32_32x32x16_bf16(kf[0], qr[0], negm, 0, 0, 0); PQ1 = __builtin_amdgcn_mfma_f32_32x32x16_bf16(kf[1], qr[0], negm, 0, 0, 0); \
                  _Pragma("unroll") for (int d0 = 1; d0 < 4; ++d0) { ATT_MF(PQ0, kf[2 * d0], qr[d0]); ATT_MF(PQ1, kf[2 * d0 + 1], qr[d0]); } } \
                ATT_FIN(PF0, PF1, ALF); ASBAR(); \
                { ALDS const unsigned char* kpn_ = shm3 + sp1_ * KSLOT + kfo;     \
                  _Pragma("unroll") for (int d0 = 0; d0 < 4; ++d0) { kf[2 * d0] = *(ALDS const bf16x8*)(kpn_ + ko[d0]); kf[2 * d0 + 1] = *(ALDS const bf16x8*)(kpn_ + ko[d0] + 4096); } } \
                ASBAR(); \
                ATT_SM_BIAS(PQ0, PQ1, j_); ASBAR(); \
                ATT_VRD(vAl, vAh, 0); ATT_MF4(o[0], vAl, vAh); ATT_SM_MAX0(PQ0); ASBAR(); \
                ATT_VRD(vAl, vAh, 1); ATT_MF4(o[1], vAl, vAh); ATT_SM_MAX1(PQ1); ASBAR(); \
                ATT_SM_DEC(PQ0, PQ1, ALQ, first_); ASBAR(); \
                ATT_VRD(vAl, vAh, 2); ATT_MF4(o[2], vAl, vAh); ATT_SM_EXP(PQ0); ASBAR(); \
                ATT_VRD(vAl, vAh, 3); ATT_MF4(o[3], vAl, vAh); ATT_SM_EXP(PQ1); ASBAR(); \
            } else { \
            ASBAR(); ATT_QK(PQ0, PQ1, j_); ATT_FIN(PF0, PF1, ALF); ASBAR(); \
            ATT_SM_BIAS(PQ0, PQ1, j_); ASBAR(); \
            ATT_VRD(vAl, vAh, 0); ATT_MF4(o[0], vAl, vAh); ATT_SM_MAX0(PQ0); ASBAR(); \
            ATT_VRD(vAl, vAh, 1); ATT_MF4(o[1], vAl, vAh); ATT_SM_MAX1(PQ1); ASBAR(); \
            ATT_SM_DEC(PQ0, PQ1, ALQ, first_); ASBAR(); \
            ATT_VRD(vAl, vAh, 2); ATT_MF4(o[2], vAl, vAh); ATT_SM_EXP(PQ0); ASBAR(); \
            ATT_VRD(vAl, vAh, 3); ATT_MF4(o[3], vAl, vAh); ATT_SM_EXP(PQ1); ASBAR(); \
            } \
            if (j_ > cw) ALQ = 1.f; \
        } \
        if (MODE != 4) ATT_WAIT_BAR();     \
        if (ATT_STAGGER > 0 && wid >= 4) __builtin_amdgcn_s_sleep(ATT_STAGGER);     \
        if (j_ <= cw) ATT_RESC(ALQ); \
        sj = (sj + 1 == NSLOT) ? 0 : sj + 1; } while (0)
    { const u32x4 z_ = {0u, 0u, 0u, 0u}; ALDS u32x4* vz_ = (ALDS u32x4*)(shm3 + V_OFF + (NSLOT - 1) * 16384) + tid * 2; vz_[0] = z_; vz_[1] = z_; }
#pragma unroll
    for (int r = 0; r < 16; ++r) { pB0[r] = 0.f; pB1[r] = 0.f; }
    ATT_WAIT_BAR();
#if ATT_PRIO
    if (wid >= 4) __builtin_amdgcn_s_setprio(1);
#endif
    int sj = 0;
    if (DIFF && MODE != 1) { ALDS const unsigned char* kp0_ = shm3 + kfo; ALDS const unsigned char* vp0_ = shm3 + vbo + (NSLOT - 1) * 16384;
#pragma unroll
        for (int d0 = 0; d0 < 4; ++d0) { kf[2 * d0] = *(ALDS const bf16x8*)(kp0_ + ko[d0]); kf[2 * d0 + 1] = *(ALDS const bf16x8*)(kp0_ + ko[d0] + 4096); }
 }
    for (int j = 0; j <= NT; j += 2) {
        ATT_STEP(pA0, pA1, alA, pB0, pB1, alB, j);
        if (j + 1 <= NT) ATT_STEP(pB0, pB1, alB, pA0, pA1, alA, j + 1);
    }
#undef ATT_DMA_K
#undef ATT_DMA_V
#undef ATT_QK
#undef ATT_FIN
#undef ATT_VRD
#undef ATT_VF
#undef ATT_MF4
#undef ATT_MF
#undef ATT_SM_BIAS
#undef ATT_SM_MAX0
#undef ATT_SM_MAX1
#undef ATT_SM_DEC
#undef ATT_SM_EXP
#undef ATT_RESC
#undef ATT_STEP
    if (MODE == 1) { ATT_WAIT_BAR(); return; }
    if (MODE >= 2) { ATT_WAIT_BAR(); if (l_reg == 123456.f) A.Y[tid] = (bf16)(int)(o[0][0] + o[1][1] + o[2][2] + o[3][3] + m_ref); ATT_WAIT_BAR(); return; }
#if ATT_PRIO
    __builtin_amdgcn_s_setprio(0);
#endif
    {
    int tid2_ = threadIdx.x; asm volatile("" : "+v"(tid2_));
    const int lane = tid2_ & 63, r32 = lane & 31, hi = lane >> 5; const int wid = __builtin_amdgcn_readfirstlane(tid2_ >> 6);
    const int map = DIFF ? (wid >> 2) : 0, wrow = DIFF ? (wid & 3) : wid;
    const int q0 = qb * QROWS + wrow * 32;
    ALDS float* wsf = (ALDS float*)(shm3 + WS_OFF) + wid * 64;
    ATT_WAIT_BAR();
    l_reg = swapsum(l_reg);
    if (hi == 0) wsf[32 + r32] = __builtin_amdgcn_rcpf(l_reg);
    asm volatile("s_waitcnt lgkmcnt(0)" ::: "memory");
    float rli[16];
#pragma unroll
    for (int r = 0; r < 16; ++r) rli[r] = wsf[32 + crow(r, hi)];
    ALDS bf16* stg;
    bool writer = true;
    if (DIFF) {
        ALDS float* X = (ALDS float*)(shm3 + (wid & 3) * 16384);
        if (map == 1) {
            const float lam = A.lam;
#pragma unroll
            for (int r = 0; r < 16; ++r) { const float f = rli[r] * lam; const int orow = crow(r, hi);
#pragma unroll
                for (int d = 0; d < 4; ++d) X[orow * 128 + d * 32 + r32] = o[d][r] * f; }
        }
        ATT_WAIT_BAR();
        stg = (ALDS bf16*)(shm3 + (wid & 3) * 16384);
        if (map == 0) {
            float g4[4];
#pragma unroll
            for (int d = 0; d < 4; ++d) g4[d] = A.subg[d * 32 + r32] * A.oml;
            float ss[16];
#pragma unroll
            for (int r = 0; r < 16; ++r) { const int orow = crow(r, hi); float s = 0.f;
#pragma unroll
                for (int d = 0; d < 4; ++d) { const float v = o[d][r] * rli[r] - X[orow * 128 + d * 32 + r32]; o[d][r] = v; s += v * v; }
                ss[r] = s; }
#pragma unroll
            for (int r = 0; r < 16; ++r) { float s = ss[r];
                s += __shfl_xor(s, 1); s += __shfl_xor(s, 2); s += __shfl_xor(s, 4); s += __shfl_xor(s, 8); s += __shfl_xor(s, 16);
                ss[r] = 1.0f / sqrtf(s * (1.0f / 128.0f) + EPS); }
            asm volatile("s_waitcnt lgkmcnt(0)" ::: "memory");
#pragma unroll
            for (int r = 0; r < 16; ++r) { const int orow = crow(r, hi);
#pragma unroll
                for (int d = 0; d < 4; ++d) stg[orow * 128 + d * 32 + r32] = (bf16)(cvtpk_s(o[d][r] * ss[r] * g4[d], 0.f) & 0xffffu); }
        } else writer = false;
    } else {
        stg = (ALDS bf16*)(shm3 + wid * 8192);
#pragma unroll
        for (int r = 0; r < 16; ++r) { const int orow = crow(r, hi);
#pragma unroll
            for (int d = 0; d < 4; ++d) stg[orow * 128 + d * 32 + r32] = (bf16)(cvtpk_s(o[d][r] * rli[r], 0.f) & 0xffffu); }
    }
    if (writer) {
        asm volatile("s_waitcnt lgkmcnt(0)" ::: "memory");
        const int gcol = (DIFF ? 0 : 1024) + h * 128;
#pragma unroll
        for (int i = 0; i < 8; ++i) { const int row = i * 4 + (lane >> 4), ch = lane & 15;
            const u32x4 ov = *(ALDS const u32x4*)(stg + row * 128 + ch * 8);
            const size_t gi = (size_t)(rowbase + q0 + row) * 2048 + gcol + ch * 8;
            const u32x4 gv = *(const u32x4*)(A.GATE + gi);
            u32x4 yv;
#pragma unroll
            for (int e = 0; e < 4; ++e) {
                const float o_lo = __uint_as_float(ov[e] << 16), o_hi = __uint_as_float(ov[e] & 0xffff0000u);
                const float g_lo = __uint_as_float(gv[e] << 16), g_hi = __uint_as_float(gv[e] & 0xffff0000u);
                const float s_lo = g_lo * __builtin_amdgcn_rcpf(1.0f + __builtin_amdgcn_exp2f(-g_lo * LOG2E));
                const float s_hi = g_hi * __builtin_amdgcn_rcpf(1.0f + __builtin_amdgcn_exp2f(-g_hi * LOG2E));
                yv[e] = cvtpk_s(o_lo * s_lo, o_hi * s_hi); }
            *(u32x4*)(A.Y + gi) = yv; }
    }
    ATT_WAIT_BAR();
    }
}
#undef ASBAR
}
constexpr size_t MiB = 1u << 20;
constexpr size_t WS_CTL = 0, CTL_ZERO_BYTES = 1 * MiB;
constexpr size_t WS_ROPEC = 1 * MiB, WS_ROPES = WS_ROPEC + 512 * 1024;
constexpr size_t WS_SMALL = 2 * MiB;
constexpr size_t SM_BIAS = 1024, SM_RSQ = 128 * 1024, SM_RSKV = 256 * 1024;
constexpr size_t WS_WIN = 4 * MiB;
constexpr size_t WS_WQB = 52 * MiB;
constexpr size_t WS_WKVB = 55 * MiB;
constexpr size_t WS_WOUT = 57 * MiB;
constexpr size_t WS_H = 80 * MiB;
constexpr size_t WS_Y = WS_H;
constexpr size_t WS_QKV = 144 * MiB;
constexpr size_t WS_CQ = 240 * MiB;
constexpr size_t WS_CKV = 256 * MiB;
constexpr size_t WS_KR = 264 * MiB;
constexpr size_t WS_GATE = 272 * MiB;
constexpr size_t WS_QM = 336 * MiB;
constexpr size_t WS_KVM = 384 * MiB;
constexpr size_t WS_END = 448 * MiB;
constexpr int CW_BAR = 4096;
constexpr size_t CTL_SSQ = 65536;

constexpr int RING_OFF = 0, RING_BYTES = 139264;
constexpr int LDSCTL_OFF = RING_BYTES, MISC_OFF = LDSCTL_OFF + 320;
constexpr int LDS_BYTES = 147456;
constexpr int NWAVES = 8;
static_assert(att::ATT_LDS_BYTES <= RING_BYTES, "attention scratch fits the ring region");

__device__ __forceinline__ float wave_sum(float v) {
#pragma unroll
    for (int o = 1; o < 64; o <<= 1) v += __shfl_xor(v, o);
    return v;
}
__device__ __forceinline__ int in_srccol(int n) {
    if (n < 3840) return n;
    if (n < 3904) { const int p = n - 3840, a = p >> 3, j = p & 7; return 3840 + (j < 4 ? 4 * a + j : 32 + 4 * a + (j - 4)); }
    if (n < 4096) return -1;
    return n - 192;
}
__device__ __forceinline__ int qb_srccol(int n) {
    const int hh = n / 192, off = n - hh * 192; if (off < 128) return n;
    const int p = off - 128, a = p >> 3, j = p & 7; return hh * 192 + 128 + (j < 4 ? 4 * a + j : 32 + 4 * a + (j - 4));
}
template <int MODE>
__device__ __forceinline__ void transpose_item(const float* W, int K, int Nsrc, int Ndst, bf16* WT, const float* gk, LAS float* scr, int item, int lane) {
    const int nblk = Ndst / 32, kb = item / nblk, nb = item - kb * nblk, k0 = 64 * kb, n0 = 32 * nb;
    const int nd = n0 + (lane & 31);
    const int src = (MODE == 1) ? in_srccol(nd) : (MODE == 2) ? qb_srccol(nd) : nd;
    float v[32];
#pragma unroll
    for (int i = 0; i < 32; ++i) { const int kk = 2 * i + (lane >> 5); v[i] = 0.f;
        if (src >= 0) { v[i] = W[(size_t)(k0 + kk) * Nsrc + src]; if (gk) v[i] *= gk[k0 + kk]; } }
#pragma unroll
    for (int i = 0; i < 32; ++i) { const int kk = 2 * i + (lane >> 5); scr[kk * 33 + (lane & 31)] = v[i]; }
    LDS_WAIT(); asm volatile("" ::: "memory");
    const int c = lane & 7;
#pragma unroll
    for (int j = 0; j < 4; ++j) { const int n = (lane >> 3) + 8 * j; const LAS float* s = scr + (8 * c) * 33 + n;
        v4u o; o.x = pk2(s[0 * 33], s[1 * 33]); o.y = pk2(s[2 * 33], s[3 * 33]); o.z = pk2(s[4 * 33], s[5 * 33]); o.w = pk2(s[6 * 33], s[7 * 33]);
        *(GAS v4u*)(WT + (size_t)(n0 + n) * K + k0 + 8 * c) = o; }
    LDS_WAIT(); asm volatile("" ::: "memory");
}
__device__ __forceinline__ void rms_row_to_bf16(const float* xrow, const float* g, bf16* orow, int lane) {
    const GAS f32x4* xr = (const GAS f32x4*)xrow + lane; const GAS f32x4* gr = (const GAS f32x4*)g + lane;
    f32x4 v[8]; float s = 0.f;
#pragma unroll
    for (int j = 0; j < 8; ++j) { v[j] = xr[64 * j]; s += (v[j].x * v[j].x + v[j].y * v[j].y) + (v[j].z * v[j].z + v[j].w * v[j].w); }
    const float rstd = 1.0f / sqrtf(wave_sum(s) * (1.0f / DM) + EPS);
    GAS unsigned long long* o8 = (GAS unsigned long long*)orow + lane;
#pragma unroll
    for (int j = 0; j < 8; ++j) { const f32x4 gg = gr[64 * j];
        o8[64 * j] = (unsigned long long)pk2(v[j].x * rstd * gg.x, v[j].y * rstd * gg.y) | ((unsigned long long)pk2(v[j].z * rstd * gg.z, v[j].w * rstd * gg.w) << 32); }
}
__device__ __forceinline__ void rms_row_f32(const float* xrow, const float* g, float* orow, int lane) {
    const GAS f32x4* xr = (const GAS f32x4*)xrow + lane; const GAS f32x4* gr = (const GAS f32x4*)g + lane;
    f32x4 v[8]; float s = 0.f;
#pragma unroll
    for (int j = 0; j < 8; ++j) { v[j] = xr[64 * j]; s += (v[j].x * v[j].x + v[j].y * v[j].y) + (v[j].z * v[j].z + v[j].w * v[j].w); }
    const float rstd = 1.0f / sqrtf(wave_sum(s) * (1.0f / DM) + EPS);
    GAS f32x4* o4 = (GAS f32x4*)orow + lane;
#pragma unroll
    for (int j = 0; j < 8; ++j) { const f32x4 gg = gr[64 * j]; o4[64 * j] = v[j] * rstd * gg; }
}
__device__ __forceinline__ int rel_bucket(int rel) {
    const int n = rel < 0 ? -rel : rel; int bk;
    if (n < 8) bk = n; else if (n < 12) bk = 8; else if (n < 16) bk = 9; else if (n < 23) bk = 10; else if (n < 32) bk = 11;
    else if (n < 46) bk = 12; else if (n < 64) bk = 13; else if (n < 91) bk = 14; else bk = 15;
    return (rel > 0 ? 16 : 0) + bk;
}

struct Args { const float* in[12]; float* out; unsigned char* ws; int ph_lo, ph_hi; };
constexpr int N_PHASES = 11;

#define IN(k) (lo <= (k) && (k) < hi)
#ifndef MK_REP_G23
#define MK_REP_G23 1
#endif
#ifndef MK_REP_G4
#define MK_REP_G4 1
#endif
#ifndef MK_REP_NORM
#define MK_REP_NORM 1
#endif
#ifndef MK_REP_RS
#define MK_REP_RS 1
#endif
#ifndef MK_ATT_MIX
#define MK_ATT_MIX 1
#endif
#ifndef MK_ATT_PROBE
#define MK_ATT_PROBE 0
#endif
#ifndef MK_REP_G1
#define MK_REP_G1 1
#endif
#ifndef MK_REP_P0
#define MK_REP_P0 1
#endif
#ifndef MK_CG_ONLY
#define MK_CG_ONLY 0
#endif
#ifdef MK_STAMP
#define STAMP(k) do { if (blockIdx.x == 0 && threadIdx.x == 0) WSP(unsigned long long, WS_SMALL + 64)[(k)] = __builtin_amdgcn_s_memrealtime(); } while (0)
#else
#define STAMP(k) do { } while (0)
#endif
#define SEAM(k) do { if (IN(k) && IN((k) + 1)) { if (MK_CG_ONLY || (k) == 0) grid.sync(); else xcd_barrier(bar); } STAMP((k) + 1); } while (0)
#define WSP(T, off) ((T*)(args.ws + (off)))

__device__ __forceinline__ void prologue_phase(const Args& args, unsigned char* lds, int G, int vcu) {
    int tid_ = threadIdx.x; asm volatile("" : "+v"(tid_));
    const int tid = tid_, lane = tid & 63, wave = __builtin_amdgcn_readfirstlane(tid >> 6);
    const int gw = vcu * NWAVES + wave, NGW = G * NWAVES;
    const float* x = args.in[0]; const float* norm_g = args.in[1]; const float* w_in = args.in[2]; const float* diff_lambda = args.in[3];
    const float* qnorm_g = args.in[5]; const float* w_qb = args.in[6]; const float* kvnorm_g = args.in[7];
    const float* w_kvb = args.in[8]; const float* w_out = args.in[9]; const float* rel_bias = args.in[10];
    float* ropec = WSP(float, WS_ROPEC); float* ropes = WSP(float, WS_ROPES); float* smallf = WSP(float, WS_SMALL); float* biastab = WSP(float, WS_SMALL + SM_BIAS);
    bf16* Win_t = WSP(bf16, WS_WIN); bf16* Wqb_t = WSP(bf16, WS_WQB); bf16* Wkvb_t = WSP(bf16, WS_WKVB); bf16* Wout_t = WSP(bf16, WS_WOUT); bf16* Hb = WSP(bf16, WS_H);
    LAS float* scr = (LAS float*)((LAS unsigned char*)lds + RING_OFF + wave * 16384);
    constexpr int I_IN = (DM / 64) * (NINP / 32), I_QB = (QLORA / 64) * (NQB / 32), I_KVB = (KVLORA / 64) * (NKVB / 32), I_OUT = (DM / 64) * (DM / 32);
    constexpr int PER_L = I_IN + I_QB + I_KVB + I_OUT;
    for (int it = gw; it < DEPTH * PER_L; it += NGW) {
        const int l = it / PER_L; int r = it - l * PER_L;
        if (r < I_IN) { transpose_item<1>(w_in + (size_t)l * DM * NIN, DM, NIN, NINP, Win_t + (size_t)l * NINP * DM, nullptr, scr, r, lane); continue; } r -= I_IN;
        if (r < I_QB) { transpose_item<2>(w_qb + (size_t)l * QLORA * NQB, QLORA, NQB, NQB, Wqb_t + (size_t)l * NQB * QLORA, qnorm_g + l * QLORA, scr, r, lane); continue; } r -= I_QB;
        if (r < I_KVB) { transpose_item<0>(w_kvb + (size_t)l * KVLORA * NKVB, KVLORA, NKVB, NKVB, Wkvb_t + (size_t)l * NKVB * KVLORA, kvnorm_g + l * KVLORA, scr, r, lane); continue; } r -= I_KVB;
        transpose_item<0>(w_out + (size_t)l * DM * DM, DM, DM, DM, Wout_t + (size_t)l * DM * DM, nullptr, scr, r, lane);
    }
    const int gt = vcu * (NWAVES * 64) + tid, NGT = G * NWAVES * 64;
    for (int e = gt; e < SEQ * 32; e += NGT) { const int s = e >> 5, i = e & 31;
        const float inv = powf(10000.0f, -(float)i * (1.0f / 32.0f)); const float ang = (float)s * inv;
        ropec[e] = cosf(ang); ropes[e] = sinf(ang); }
    for (int e = gt; e < 16 * 256; e += NGT) { const int mh = e >> 8, idx = e & 255; biastab[e] = rel_bias[rel_bucket(idx - 192) * 16 + mh] * LOG2E; }
    if (gt < DEPTH) { const float* lp = diff_lambda + gt * 256; float s01 = 0.f, s23 = 0.f;
        for (int i = 0; i < 64; ++i) { s01 += lp[i] * lp[64 + i]; s23 += lp[128 + i] * lp[192 + i]; }
        const float lam_init = 0.8f - 0.6f * expf(-0.3f * (float)gt);
        smallf[gt] = expf(s01) - expf(s23) + lam_init; smallf[8 + gt] = 1.0f - lam_init; }
    for (int m = gw; m < MROWS; m += NGW) rms_row_to_bf16(x + (size_t)m * DM, norm_g, Hb + (size_t)m * DM, lane);
}

template <int L>
__device__ __forceinline__ void layer_phases(const Args& args, unsigned char* lds, cg::grid_group& grid, const XcdBarrier& bar, int lo, int hi, int G, int bx, int vcu) {
    constexpr int pb = 1 + 5 * L;
    LAS unsigned char* ldsl = (LAS unsigned char*)lds;
#ifdef MK_CLK
    if (L == 0 && blockIdx.x == 0 && threadIdx.x == 0) { unsigned long long* ts = WSP(unsigned long long, WS_SMALL + 64); ts[10] = __builtin_amdgcn_s_memtime(); ts[11] = __builtin_amdgcn_s_memrealtime(); }
#endif
    if (IN(pb)) {
        pg8::Gemm g{WSP(bf16, WS_H), WSP(bf16, WS_WIN) + (size_t)L * NINP * DM, MROWS, NINP, DM}; pg8::StaticOrder S; S.init(MROWS, NINP, G, bx);
        pg8::EpiInProj E{WSP(bf16, WS_QKV), WSP(bf16, WS_CQ), WSP(bf16, WS_CKV), WSP(bf16, WS_KR), WSP(bf16, WS_GATE), WSP(float, WS_ROPEC), WSP(float, WS_ROPES), WSP(float, WS_CTL + CTL_SSQ + (size_t)(2 * L) * 65536), WSP(float, WS_CTL + CTL_SSQ + (size_t)(2 * L + 1) * 65536)};
        for (int rep_ = 0; rep_ < MK_REP_G1; ++rep_)
        pg8::gemm_phase<pg8::EpiInProj, pg8::StaticOrder, true, true>(ldsl + RING_OFF, g, S, E);
    }
#ifdef MK_CLK
    if (L == 0 && blockIdx.x == 0 && threadIdx.x == 0) { unsigned long long* ts = WSP(unsigned long long, WS_SMALL + 64); ts[12] = __builtin_amdgcn_s_memtime(); ts[13] = __builtin_amdgcn_s_memrealtime(); }
#endif
    SEAM(pb);
    if (IN(pb + 1)) for (int rep_ = 0; rep_ < MK_REP_G23; ++rep_) {
        { pg8::Gemm g{WSP(bf16, WS_CQ), WSP(bf16, WS_WQB) + (size_t)L * NQB * QLORA, MROWS, NQB, QLORA}; pg8::StaticOrder S; S.init(MROWS, NQB, G, bx);
          pg8::EpiRowScale<true> E{WSP(bf16, WS_QM), NQB, WSP(float, WS_CTL + CTL_SSQ + (size_t)(2 * L) * 65536), 1.0f / QLORA, WSP(float, WS_ROPEC), WSP(float, WS_ROPES), 0.07216878364870323f * LOG2E};
#ifndef NO_G2
          pg8::gemm_phase<pg8::EpiRowScale<true>, pg8::StaticOrder, true, true>(ldsl + RING_OFF, g, S, E);
#endif
        }
        { pg8::Gemm g{WSP(bf16, WS_CKV), WSP(bf16, WS_WKVB) + (size_t)L * NKVB * KVLORA, MROWS, NKVB, KVLORA}; pg8::KvOrder S; S.init(MROWS, NKVB, G, bx);
          pg8::EpiRowScale<false> E{WSP(bf16, WS_KVM), NKVB, WSP(float, WS_CTL + CTL_SSQ + (size_t)(2 * L + 1) * 65536), 1.0f / KVLORA, nullptr, nullptr, 1.0f};
#ifndef NO_G3
          pg8::gemm_phase<pg8::EpiRowScale<false>, pg8::KvOrder, true, true>(ldsl + RING_OFF, g, S, E);
#endif
        }
    }
    SEAM(pb + 1);
#ifdef MK_CLK
    if (L == 0 && blockIdx.x == 0 && threadIdx.x == 0) { unsigned long long* ts = WSP(unsigned long long, WS_SMALL + 64); ts[2] = __builtin_amdgcn_s_memtime(); ts[3] = __builtin_amdgcn_s_memrealtime(); }
#endif
    if (IN(pb + 2)) {
        const float* smallf = WSP(float, WS_SMALL);
        att::AttnArgs A{WSP(void, WS_CTL + 524288), WSP(bf16, WS_QKV), WSP(bf16, WS_QM), WSP(bf16, WS_KVM), WSP(bf16, WS_KR), WSP(bf16, WS_GATE), WSP(bf16, WS_Y), WSP(float, WS_SMALL + SM_BIAS), args.in[4] + L * 128, smallf[L], smallf[8 + L]};
        for (int p = vcu; p < 256; p += G) {
            const int bh = p >> 3, s = p & 7, b = bh >> 3, h = bh & 7;
            for (int pass_ = 0; pass_ < 2; ++pass_) {
                const bool mla_ = ((pass_ == 0) == ((s & 1) == 0)) || !MK_ATT_MIX;
                if (MK_ATT_MIX ? mla_ : pass_ == 0) { for (int i = 0; i < 2; ++i) att::attn_unit<false>(A, b, h, i == 0 ? 15 - s : s, lds + RING_OFF); }
                else { for (int i = 0; i < 4; ++i) att::attn_unit<true>(A, b, h, i == 0 ? 31 - 2 * s : i == 1 ? 30 - 2 * s : i == 2 ? 2 * s + 1 : 2 * s, lds + RING_OFF); }
            }
#if MK_ATT_PROBE
#ifndef MK_ATT_PROBE_KIND
#define MK_ATT_PROBE_KIND 3
#endif
            if (MK_ATT_PROBE_KIND & 1) for (int i = 0; i < 2; ++i) att::attn_unit<false, MK_ATT_PROBE>(A, b, h, i == 0 ? 15 - s : s, lds + RING_OFF);
            if (MK_ATT_PROBE_KIND & 2) for (int i = 0; i < 4; ++i) att::attn_unit<true, MK_ATT_PROBE>(A, b, h, i == 0 ? 31 - 2 * s : i == 1 ? 30 - 2 * s : i == 2 ? 2 * s + 1 : 2 * s, lds + RING_OFF);
#endif
        }
    }
#ifdef MK_CLK
    if (L == 0 && blockIdx.x == 0 && threadIdx.x == 0) { unsigned long long* ts = WSP(unsigned long long, WS_SMALL + 64); ts[4] = __builtin_amdgcn_s_memtime(); ts[5] = __builtin_amdgcn_s_memrealtime(); }
#endif
    SEAM(pb + 2);
    if (IN(pb + 3)) {
        pg8::Gemm g{WSP(bf16, WS_Y), WSP(bf16, WS_WOUT) + (size_t)L * DM * DM, MROWS, DM, DM}; pg8::StaticOrder S; S.init(MROWS, DM, G, bx);
        pg8::EpiResF32 E{L == 0 ? args.in[0] : (const float*)args.out, args.out, DM};
        for (int rep_ = 0; rep_ < (L == 0 ? MK_REP_G4 : 1); ++rep_)
        pg8::gemm_phase<pg8::EpiResF32, pg8::StaticOrder, true, true>(ldsl + RING_OFF, g, S, E);
    }
    SEAM(pb + 3);
    if (IN(pb + 4)) {
        int tid_ = threadIdx.x; asm volatile("" : "+v"(tid_));
        const int lane = tid_ & 63, wave = __builtin_amdgcn_readfirstlane(tid_ >> 6); const int gw = vcu * NWAVES + wave, NGW = G * NWAVES;
        if (L == 0) { const float* X1 = args.out; bf16* Hb = WSP(bf16, WS_H); const float* g = args.in[1] + DM;
            for (int rep_ = 0; rep_ < MK_REP_NORM; ++rep_) for (int m = gw; m < MROWS; m += NGW) rms_row_to_bf16(X1 + (size_t)m * DM, g, Hb + (size_t)m * DM, lane); }
        else { const float* g = args.in[11]; float* out = args.out;
            for (int m = gw; m < MROWS; m += NGW) rms_row_f32(out + (size_t)m * DM, g, out + (size_t)m * DM, lane); }
    }
    SEAM(pb + 4);
}

__global__ void __launch_bounds__(NWAVES * 64, 2) mk_fwd(Args args) {
    extern __shared__ __attribute__((aligned(16))) unsigned char lds[];
    cg::grid_group grid = cg::this_grid();
    const int G = gridDim.x; const int bx = blockIdx.x; const int vcu = (G % 8 == 0) ? (bx % 8) * (G / 8) + bx / 8 : bx;
    const int lo = args.ph_lo, hi = args.ph_hi;
    volatile LAS unsigned* MISC = (volatile LAS unsigned*)((LAS unsigned char*)lds + MISC_OFF);
    if (threadIdx.x < 32) MISC[threadIdx.x] = 0u;
    __syncthreads();
    const XcdBarrier bar = xcd_barrier_post(WSP(unsigned, WS_CTL) + CW_BAR, MISC + 8);
    STAMP(0);
#ifdef MK_UB
    {
        typedef short ub8 __attribute__((ext_vector_type(8))); typedef float uf16 __attribute__((ext_vector_type(16))); typedef short us4 __attribute__((ext_vector_type(4)));
        LAS unsigned char* lb_ = (LAS unsigned char*)lds + (threadIdx.x & 63) * 16 + (threadIdx.x >> 6) * 8192;
        ub8 a_, b_; for (int i = 0; i < 8; ++i) { a_[i] = (short)(0x3c00 + threadIdx.x + i); b_[i] = (short)(0x3a00 + i); }
        for (int i = 0; i < 8; ++i) *(LAS ub8*)(lb_ + i * 1024) = a_;
        __syncthreads();
        uf16 acc_; for (int i = 0; i < 16; ++i) acc_[i] = 0.f;
        float x_[12]; for (int i = 0; i < 12; ++i) x_[i] = 0.001f * (float)(threadIdx.x + i);
        ub8 nx_ = *(LAS const ub8*)(lb_);
        for (int it = 0; it < MK_UB_IT; ++it) {
            ub8 cur_ = a_;
            if (MK_UB_LDS == 1) cur_ = *(LAS const ub8*)(lb_ + (it & 7) * 1024);
            if (MK_UB_LDS == 2) { cur_ = nx_; nx_ = *(LAS const ub8*)(lb_ + ((it + 1) & 7) * 1024); }
            if (MK_UB_LDS == 3) { cur_ = nx_; const us4 l_ = __builtin_bit_cast(us4, __builtin_amdgcn_ds_read_tr16_b64_v4i16((LAS us4*)(lb_ - (threadIdx.x & 63) * 8 + ((it + 1) & 7) * 1024))), h_ = __builtin_bit_cast(us4, __builtin_amdgcn_ds_read_tr16_b64_v4i16((LAS us4*)(lb_ - (threadIdx.x & 63) * 8 + ((it + 1) & 7) * 1024 + 512))); nx_ = (ub8){l_[0], l_[1], l_[2], l_[3], h_[0], h_[1], h_[2], h_[3]}; }
            acc_ = __builtin_amdgcn_mfma_f32_32x32x16_bf16(cur_, b_, acc_, 0, 0, 0);
#pragma unroll
            for (int i = 0; i < MK_UB_N; ++i) { if (MK_UB_EXP) x_[i] = __builtin_amdgcn_exp2f(x_[i]); else x_[i] = fmaf(x_[i], 0.999f, 0.001f); asm volatile("" : "+v"(x_[i])); }
            __builtin_amdgcn_sched_barrier(0);
        }
        float sum_ = acc_[0] + acc_[5]; for (int i = 0; i < 12; ++i) sum_ += x_[i];
        if (sum_ == 123456.789f) args.out[threadIdx.x] = sum_;
        __syncthreads();
    }
#endif
    if (IN(0)) { for (int rep_ = 0; rep_ < MK_REP_P0; ++rep_) prologue_phase(args, lds, G, vcu); }
    SEAM(0);
    layer_phases<0>(args, lds, grid, bar, lo, hi, G, bx, vcu);
    layer_phases<1>(args, lds, grid, bar, lo, hi, G, bx, vcu);
#ifdef MK_TPROF
    xcd_barrier(bar);
    { const unsigned long long* a_ = WSP(unsigned long long, WS_CTL + 524288); const float n_ = (float)a_[3];
      const float qa = floorf((float)a_[MK_TPROF_A] / n_ * (1.0f / MK_TPROF_Q) + 0.5f), qb = floorf((float)a_[MK_TPROF_B] / n_ * (1.0f / MK_TPROF_Q) + 0.5f);
      float* o = args.out; const int gt = blockIdx.x * 512 + threadIdx.x;
      for (int i = gt; i < MROWS * DM; i += gridDim.x * 512) o[i] = (i == 0) ? 16.f * qb : qa; }
#endif
#ifdef MK_CLK
    xcd_barrier(bar);
    { const unsigned long long* ts = WSP(unsigned long long, WS_SMALL + 64);
      const float ca = (float)(ts[4] - ts[2]) / (float)(ts[5] - ts[3]), cg = (float)(ts[12] - ts[10]) / (float)(ts[13] - ts[11]);
      const float qa = floorf(ca + 0.5f), qg = floorf(cg + 0.5f);
      float* o = args.out; const int gt = blockIdx.x * 512 + threadIdx.x;
      for (int i = gt; i < MROWS * DM; i += gridDim.x * 512) o[i] = (i == 0) ? 16.f * qg : qa; }
#endif
#ifdef MK_STAMP
    xcd_barrier(bar);
    { const unsigned long long* ts = WSP(unsigned long long, WS_SMALL + 64);
      float da = 0.f, db = 0.f;
      for (int p = 0; p < N_PHASES; ++p) { const int kind = p == 0 ? 0 : 1 + (p - 1) % 6; const float d = (float)(ts[p + 1] - ts[p]) * 0.01f; if (kind == MK_STAMP_A) da += d; if (kind == MK_STAMP_B) db += d; }
      float* o = args.out; const int gt = blockIdx.x * 512 + threadIdx.x;
      for (int i = gt; i < MROWS * DM; i += gridDim.x * 512) o[i] = (i == 0) ? 16.f * db : da; }
#endif
}
#undef IN
#undef SEAM
#undef WSP

#ifndef MK_PH_MAX
#define MK_PH_MAX N_PHASES
#endif
#ifndef MK_PH_MIN
#define MK_PH_MIN 0
#endif
#ifndef MK_LAUNCH_PER_PHASE
#define MK_LAUNCH_PER_PHASE 0
#endif
__global__ void diag_fill(float* o, int n, float c) { for (int i = blockIdx.x * 256 + threadIdx.x; i < n; i += gridDim.x * 256) o[i] = c; }
extern "C" void kernel_launch(void* const* d_in, const int* in_sizes, int n_in, void* d_out, int out_size, void* d_ws, size_t ws_size, hipStream_t stream) {
    static int grid = 0;
    if (grid == 0) {
        if (n_in != 12 || in_sizes[0] != MROWS * DM || out_size != MROWS * DM || ws_size < WS_END) {
            fprintf(stderr, "kernel_launch: unexpected shapes: n_in %d in0 %d out %d ws %zu (need >= %zu)\n", n_in, n_in > 0 ? in_sizes[0] : -1, out_size, ws_size, (size_t)WS_END);
            const float code = (n_in != 12) ? 30.f : (in_sizes[0] != MROWS * DM) ? 40.f : (out_size != MROWS * DM) ? 50.f : (float)(ws_size >> 26);
            hipLaunchKernelGGL(diag_fill, dim3(1024), dim3(256), 0, stream, (float*)d_out, out_size, code); return; }
        int dev = 0, cus = 0, per_cu = 0;
        if (hipGetDevice(&dev) != hipSuccess || hipDeviceGetAttribute(&cus, hipDeviceAttributeMultiprocessorCount, dev) != hipSuccess) { fprintf(stderr, "kernel_launch: device query failed\n"); grid = -1; return; }
        if (hipFuncSetAttribute((const void*)mk_fwd, hipFuncAttributeMaxDynamicSharedMemorySize, LDS_BYTES) != hipSuccess) { fprintf(stderr, "kernel_launch: hipFuncSetAttribute failed\n"); grid = -1; return; }
        if (hipOccupancyMaxActiveBlocksPerMultiprocessor(&per_cu, (const void*)mk_fwd, NWAVES * 64, LDS_BYTES) != hipSuccess || per_cu < 1) {
            fprintf(stderr, "kernel_launch: occupancy query reports %d workgroups per CU\n", per_cu); (void)hipGetLastError(); per_cu = 1; }
        grid = cus;
        if (grid > 256) grid = 256;
    }
    if (grid < 0) return;
    (void)hipMemsetAsync((char*)d_ws + WS_CTL, 0, CTL_ZERO_BYTES, stream);
    Args a{};
    for (int i = 0; i < 12; ++i) a.in[i] = (const float*)d_in[i];
    a.out = (float*)d_out; a.ws = (unsigned char*)d_ws;
#if MK_LAUNCH_PER_PHASE
    for (int p = MK_PH_MIN; p < MK_PH_MAX; ++p) { a.ph_lo = p; a.ph_hi = p + 1; hipLaunchKernelGGL(mk_fwd, dim3(grid), dim3(NWAVES * 64), LDS_BYTES, stream, a); }
    { const hipError_t le = hipPeekAtLastError(); if (le != hipSuccess) fprintf(stderr, "kernel_launch: launch failed: %s\n", hipGetErrorName(le)); }
#else
    a.ph_lo = 0; a.ph_hi = N_PHASES;
    void* kargs[] = {&a};
    const hipError_t e = hipLaunchCooperativeKernel((const void*)mk_fwd, dim3(grid), dim3(NWAVES * 64), kargs, LDS_BYTES, stream);
    if (e != hipSuccess) fprintf(stderr, "kernel_launch: cooperative launch failed: %s (grid %d)\n", hipGetErrorString(e), grid);
#endif
}
```

```cpp
#include <hip/hip_runtime.h>
#include <hip/hip_cooperative_groups.h>
#include <cstdio>
#include <cstdint>
namespace cg = cooperative_groups;

constexpr int BATCH = 4, SEQ = 4096, DM = 2048, MROWS = BATCH * SEQ, DEPTH = 2;
constexpr int NIN = 5952, NINP = 6144;
constexpr int QLORA = 512, KVLORA = 256, NQB = 1536, NKVB = 2048;
constexpr float EPS = 1e-6f;
constexpr float LOG2E = 1.4426950408889634f;
namespace pg8 {
#define PG8_LAS __attribute__((address_space(3)))
typedef unsigned short bf16_t;
typedef short bf16x8 __attribute__((ext_vector_type(8)));
typedef float f32x4 __attribute__((ext_vector_type(4)));
typedef unsigned u32x4 __attribute__((ext_vector_type(4)));
constexpr int BM = 256, BK = 64, HALF = 128, HTB = HALF * BK * 2  , STAGE_BYTES = 8 * HTB, NXCD = 8, WGM = 8;

__host__ __device__ __forceinline__ int lds_byte(int r, int c) { const int st = (r >> 4) * 2 + (c >> 5), rr = r & 15, cc = c & 31, ob = rr * 64 + cc * 2; return st * 1024 + (ob ^ (((ob >> 9) & 1) << 5)); }
__host__ __device__ __forceinline__ void stage_rc(int b, int& R, int& C) { const int st = b / 1024, sb = b % 1024, swz = sb ^ (((sb >> 9) & 1) << 5); R = (st >> 1) * 16 + swz / 64; C = (st & 1) * 32 + (swz % 64) / 2; }
__host__ __device__ __forceinline__ int perm32(int rho) { const int n = rho >> 4, i = rho & 15; return 8 * (i >> 2) + 4 * n + (i & 3); }

struct Unit { int pm, pn; };
struct Gemm { const bf16_t* A; const bf16_t* Bt; int M, N, K; };

struct StaticOrder {
    int nM, nN, nwg, G, c;
    __host__ __device__ void init(int M, int N, int G_, int c_) { nM = M / BM; nN = N / BM; nwg = nM * nN; G = G_; c = c_; }
    __host__ __device__ bool next(int i, Unit& u) const {
        const long L = (long)i * G + c; if (L >= nwg) return false;
        int wgid = (int)L; { const int q = nwg / NXCD, r = nwg % NXCD, xcd = wgid % NXCD, off = wgid / NXCD; wgid = (xcd < r ? xcd * (q + 1) : r * (q + 1) + (xcd - r) * q) + off; }
        const int nig = WGM * nN, gid = wgid / nig, fm = gid * WGM, gsz = (nM - fm) < WGM ? (nM - fm) : WGM;
        u.pm = fm + ((wgid % nig) % gsz); u.pn = (wgid % nig) / gsz; return true;
    }
    __device__ __forceinline__ void a_ready(const Unit&) const {}
    __device__ __forceinline__ void done(const Unit&) const {}
};

__device__ __forceinline__ unsigned cvt_pk_bf16(float lo, float hi) { unsigned r; asm volatile("v_cvt_pk_bf16_f32 %0, %1, %2" : "=v"(r) : "v"(lo), "v"(hi)); return r; }
typedef float f32x2 __attribute__((ext_vector_type(2)));
struct EpiInProj {
    static constexpr bool PERM = true, AFTER_DRAIN = false;
    bf16_t *QKV, *CQ, *CKV, *KR, *GATE; const float* ropec; const float* ropes; float* ssq_q; float* ssq_kv;
    __device__ __forceinline__ void operator()(const f32x4 (&acc)[2][2][4][2], const Unit& u, int wr, int wc, int fr, int fq) const {
        const int row0 = u.pm * BM + wr * 64 + fr; const int pn = u.pn;
        if (pn == 15) {
            if (wc < 2) {
                const int a = wc * 4 + fq;
#pragma unroll
                for (int ai = 0; ai < 2; ++ai)
#pragma unroll
                    for (int m = 0; m < 4; ++m) { const int row = row0 + ai * HALF + m * 16, s = row & (SEQ - 1);
                        const f32x4 c = *(const f32x4*)(ropec + s * 32 + 4 * a), sn = *(const f32x4*)(ropes + s * 32 + 4 * a);
                        const f32x4 x1 = acc[ai][0][m][0], x2 = acc[ai][0][m][1];
                        const f32x4 y1 = x1 * c - x2 * sn, y2 = x1 * sn + x2 * c;
                        u32x4 w; w.x = cvt_pk_bf16(y1[0], y1[1]); w.y = cvt_pk_bf16(y1[2], y1[3]); w.z = cvt_pk_bf16(y2[0], y2[1]); w.w = cvt_pk_bf16(y2[2], y2[3]);
                        *(u32x4*)(KR + (size_t)row * 64 + 8 * a) = w; }
            }
            return;
        }
        bf16_t* base; int ldc, colt;
        if (pn < 12) { base = QKV; ldc = 3072; colt = pn * 256; }
        else if (pn < 14) { base = CQ; ldc = 512; colt = (pn - 12) * 256; }
        else if (pn == 14) { base = CKV; ldc = 256; colt = 0; }
        else { base = GATE; ldc = 2048; colt = (pn - 16) * 256; }
        const int col0 = colt + wc * 32 + 8 * fq;
        const float sc = (pn < 4) ? 0.125f * 1.4426950408889634f : 1.0f;
#pragma unroll
        for (int ai = 0; ai < 2; ++ai)
#pragma unroll
            for (int m = 0; m < 4; ++m) { bf16_t* rowp = base + (size_t)(row0 + ai * HALF + m * 16) * ldc + col0;
#pragma unroll
                for (int bj = 0; bj < 2; ++bj) { const f32x4 v0 = acc[ai][bj][m][0] * sc, v1 = acc[ai][bj][m][1] * sc;
                    u32x4 w; w.x = cvt_pk_bf16(v0[0], v0[1]); w.y = cvt_pk_bf16(v0[2], v0[3]); w.z = cvt_pk_bf16(v1[0], v1[1]); w.w = cvt_pk_bf16(v1[2], v1[3]);
                    *(u32x4*)(rowp + bj * HALF) = w; } }
        if (pn >= 12 && pn <= 14) {
            float* ssq = (pn == 14) ? ssq_kv : ssq_q;
#pragma unroll
            for (int ai = 0; ai < 2; ++ai)
#pragma unroll
                for (int m = 0; m < 4; ++m) { float s = 0.f;
#pragma unroll
                    for (int bj = 0; bj < 2; ++bj)
#pragma unroll
                        for (int n = 0; n < 2; ++n) { const f32x4 v = acc[ai][bj][m][n]; s += (v[0] * v[0] + v[1] * v[1]) + (v[2] * v[2] + v[3] * v[3]); }
                    s += __shfl_xor(s, 16); s += __shfl_xor(s, 32);
                    if (fq == 0) __hip_atomic_fetch_add(ssq + row0 + ai * HALF + m * 16, s, __ATOMIC_RELAXED, __HIP_MEMORY_SCOPE_AGENT); }
        }
    }
};
template <bool ROPE> struct EpiRowScale {
    static constexpr bool PERM = true, AFTER_DRAIN = false;
    bf16_t* O; int ldc; const float* ssq; float inv_n; const float* ropec; const float* ropes; float qscale;
    __device__ __forceinline__ void operator()(const f32x4 (&acc)[2][2][4][2], const Unit& u, int wr, int wc, int fr, int fq) const {
        const int row0 = u.pm * BM + wr * 64 + fr; const int col0 = u.pn * BM + wc * 32 + 8 * fq;
        bool isr[2]; int ra[2];
#pragma unroll
        for (int bj = 0; bj < 2; ++bj) { const int c0 = col0 + bj * HALF, off = c0 % 192; isr[bj] = ROPE && (off >= 128); ra[bj] = (off - 128) >> 3; }
#pragma unroll
        for (int ai = 0; ai < 2; ++ai)
#pragma unroll
            for (int m = 0; m < 4; ++m) { const int row = row0 + ai * HALF + m * 16, s = row & (SEQ - 1); const float r = qscale / sqrtf(ssq[row] * inv_n + 1e-6f);
                bf16_t* rowp = O + (size_t)row * ldc + col0;
#pragma unroll
                for (int bj = 0; bj < 2; ++bj) { f32x4 v0 = acc[ai][bj][m][0] * r, v1 = acc[ai][bj][m][1] * r;
                    if (ROPE) { if (isr[bj]) { const f32x4 c = *(const f32x4*)(ropec + s * 32 + 4 * ra[bj]), sn = *(const f32x4*)(ropes + s * 32 + 4 * ra[bj]);
                        const f32x4 y1 = v0 * c - v1 * sn, y2 = v0 * sn + v1 * c; v0 = y1; v1 = y2; } }
                    u32x4 w; w.x = cvt_pk_bf16(v0[0], v0[1]); w.y = cvt_pk_bf16(v0[2], v0[3]); w.z = cvt_pk_bf16(v1[0], v1[1]); w.w = cvt_pk_bf16(v1[2], v1[3]);
                    *(u32x4*)(rowp + bj * HALF) = w; } }
    }
};
struct EpiResF32 {
    static constexpr bool PERM = false, AFTER_DRAIN = false;
    const float* base; float* out; int ldc;
    __device__ __forceinline__ void operator()(const f32x4 (&acc)[2][2][4][2], const Unit& u, int wr, int wc, int fr, int fq) const {
        const int row0 = u.pm * BM + wr * 64 + fr, col0 = u.pn * BM + wc * 32 + 4 * fq;
#pragma unroll
        for (int ai = 0; ai < 2; ++ai)
#pragma unroll
            for (int m = 0; m < 4; ++m) { const size_t off = (size_t)(row0 + ai * HALF + m * 16) * ldc + col0;
#pragma unroll
                for (int bj = 0; bj < 2; ++bj)
#pragma unroll
                    for (int n = 0; n < 2; ++n) { const f32x4 bs = *(const f32x4*)(base + off + bj * HALF + n * 16); *(f32x4*)(out + off + bj * HALF + n * 16) = bs + acc[ai][bj][m][n]; } }
    }
};
struct KvOrder : StaticOrder {
    __host__ __device__ bool next(int i, Unit& u) const {
        long L; if (G != 256) { L = (long)i * G + c; if (L >= nwg) return false; }
        else if (c < 128) { if (i > 0) return false; L = c; }
        else { if (i > 2) return false; L = 128 + 3 * (c - 128) + i; }
        int wgid = (int)L; { const int q = nwg / NXCD, r = nwg % NXCD, xcd = wgid % NXCD, off = wgid / NXCD; wgid = (xcd < r ? xcd * (q + 1) : r * (q + 1) + (xcd - r) * q) + off; }
        const int nig = WGM * nN, gid = wgid / nig, fm = gid * WGM, gsz = (nM - fm) < WGM ? (nM - fm) : WGM;
        u.pm = fm + ((wgid % nig) % gsz); u.pn = (wgid % nig) / gsz; return true;
    }
};
template <class Epi, class Sched, bool ALIGN_EPI = false, bool SP2 = false>
__device__ __forceinline__ void gemm_phase(PG8_LAS unsigned char* lds, const Gemm g, const Sched& S, const Epi& E) {
    int tid_ = threadIdx.x; asm volatile("" : "+v"(tid_));
    const int tid = tid_, wid = __builtin_amdgcn_readfirstlane(tid >> 6), lane = tid & 63, wr = wid >> 2, wc = wid & 3, fr = lane & 15, fq = lane >> 4;
    const int K = g.K, nt = K / BK;
    unsigned voffA[2], voffB[2];
#pragma unroll
    for (int i = 0; i < 2; ++i) { int R, C; stage_rc(tid * 16 + i * 8192, R, C); const int Rb = Epi::PERM ? ((R & ~31) + perm32(R & 31)) : R;
        voffA[i] = (unsigned)(R * K + C) * 2u; voffB[i] = (unsigned)(Rb * K + C) * 2u; }
    const size_t kstep = (size_t)(BK * 2);
    const size_t hstep = (size_t)HALF * K * 2;
    const size_t tstep = 2 * hstep;
    const unsigned ldsw = (unsigned)wid * 1024u;
    const int aoff = lds_byte(wr * 64 + fr, fq * 8), boff = lds_byte(wc * 32 + fr, fq * 8);
#define PG8_SA(b, h) (((b) * 2 + (h)) * HTB)
#define PG8_SB(b, h) ((4 + (b) * 2 + (h)) * HTB)
#define PG8_STAGE(bufoff, gbase, voff) do { _Pragma("unroll") for (int _i = 0; _i < 2; ++_i) \
        __builtin_amdgcn_global_load_lds((const unsigned*)((const char*)(gbase) + (voff)[_i]), (PG8_LAS unsigned*)(lds + (bufoff) + ldsw + _i * 8192), 16, 0, 0); } while (0)
#define PG8_LDA(dst, b, h) do { _Pragma("unroll") for (int m = 0; m < 4; ++m) _Pragma("unroll") for (int k = 0; k < 2; ++k) dst[m][k] = *(const PG8_LAS bf16x8*)(lds + PG8_SA(b, h) + aoff + m * 2048 + k * 1024); } while (0)
#define PG8_LDB(dst, b, h) do { _Pragma("unroll") for (int n = 0; n < 2; ++n) _Pragma("unroll") for (int k = 0; k < 2; ++k) dst[n][k] = *(const PG8_LAS bf16x8*)(lds + PG8_SB(b, h) + boff + n * 2048 + k * 1024); } while (0)
#define PG8_MMA(ai, bj, At, Bt) do { __builtin_amdgcn_s_setprio(1); _Pragma("unroll") for (int m = 0; m < 4; ++m) _Pragma("unroll") for (int n = 0; n < 2; ++n) _Pragma("unroll") for (int k = 0; k < 2; ++k) \
        acc[ai][bj][m][n] = __builtin_amdgcn_mfma_f32_16x16x32_bf16(Bt[n][k], At[m][k], acc[ai][bj][m][n], 0, 0, 0); __builtin_amdgcn_s_setprio(0); } while (0)
#define PG8_WAIT_V(n) asm volatile("s_waitcnt vmcnt(" #n ")" ::: "memory")
#define PG8_WAIT_L(n) asm volatile("s_waitcnt lgkmcnt(" #n ")" ::: "memory")
#define PG8_BAR __builtin_amdgcn_s_barrier()
#define PG8_SCHED __builtin_amdgcn_sched_barrier(0)
    Unit cur, nxt; int ui = 0;
    if (!S.next(0, cur)) return;
    f32x4 acc[2][2][4][2];
#pragma unroll
    for (int a = 0; a < 2; ++a)
#pragma unroll
        for (int b = 0; b < 2; ++b)
#pragma unroll
            for (int m = 0; m < 4; ++m)
#pragma unroll
                for (int n = 0; n < 2; ++n) acc[a][b][m][n] = (f32x4){0.f, 0.f, 0.f, 0.f};
    bf16x8 At[4][2], B0[2][2], B1[2][2];
    const char* cA = (const char*)g.A + (size_t)cur.pm * tstep; const char* cB = (const char*)g.Bt + (size_t)cur.pn * tstep;
    S.a_ready(cur);
    if constexpr (SP2) {
        PG8_STAGE(PG8_SB(0, 0), cB, voffB); PG8_STAGE(PG8_SB(0, 1), cB + hstep, voffB); PG8_STAGE(PG8_SA(0, 0), cA, voffA); PG8_STAGE(PG8_SA(0, 1), cA + hstep, voffA);
        if (wr == 1) PG8_BAR;
        PG8_WAIT_V(2); PG8_BAR;
        PG8_STAGE(PG8_SB(1, 0), cB + kstep, voffB); PG8_STAGE(PG8_SA(1, 0), cA + kstep, voffA); PG8_STAGE(PG8_SB(1, 1), cB + hstep + kstep, voffB);
        PG8_WAIT_V(6); PG8_BAR;
    } else {
        PG8_STAGE(PG8_SB(0, 0), cB, voffB); PG8_STAGE(PG8_SA(0, 0), cA, voffA); PG8_STAGE(PG8_SB(0, 1), cB + hstep, voffB); PG8_STAGE(PG8_SA(0, 1), cA + hstep, voffA);
        if (wr == 1) PG8_BAR;
        PG8_WAIT_V(4); PG8_BAR;
        PG8_STAGE(PG8_SB(1, 0), cB + kstep, voffB); PG8_STAGE(PG8_SA(1, 0), cA + kstep, voffA); PG8_STAGE(PG8_SB(1, 1), cB + hstep + kstep, voffB);
        PG8_WAIT_V(6); PG8_BAR;
    }
    for (;;) {
        const bool has_next = S.next(ui + 1, nxt);
        const char* nA = has_next ? (const char*)g.A + (size_t)nxt.pm * tstep : cA; const char* nB = has_next ? (const char*)g.Bt + (size_t)nxt.pn * tstep : cB;
        for (int t = 0; t < nt; t += 2) {
            const bool last = (t == nt - 2);
            const char* a1 = cA + (size_t)(t + 1) * kstep;
            const char* a2 = last ? nA : cA + (size_t)(t + 2) * kstep; const char* b2 = last ? nB : cB + (size_t)(t + 2) * kstep;
            const char* a3 = a2 + kstep; const char* b3 = b2 + kstep;
            if (last && has_next) S.a_ready(nxt);
            if constexpr (SP2) {
            PG8_LDB(B0, 0, 0); PG8_LDB(B1, 0, 1); PG8_SCHED; PG8_LDA(At, 0, 0); PG8_STAGE(PG8_SA(1, 1), a1 + hstep, voffA);
            PG8_WAIT_V(8); PG8_WAIT_L(0); PG8_BAR; PG8_MMA(0, 0, At, B0); PG8_MMA(0, 1, At, B1); PG8_BAR; PG8_SCHED;
            PG8_LDA(At, 0, 1); PG8_STAGE(PG8_SB(0, 0), b2, voffB); PG8_STAGE(PG8_SB(0, 1), b2 + hstep, voffB); PG8_STAGE(PG8_SA(0, 0), a2, voffA);
            PG8_WAIT_V(8); PG8_WAIT_L(0); PG8_BAR; PG8_MMA(1, 0, At, B0); PG8_MMA(1, 1, At, B1); PG8_BAR; PG8_SCHED;
            PG8_LDB(B0, 1, 0); PG8_LDB(B1, 1, 1); PG8_SCHED; PG8_LDA(At, 1, 0); PG8_STAGE(PG8_SA(0, 1), a2 + hstep, voffA);
            PG8_WAIT_V(8); PG8_WAIT_L(0); PG8_BAR; PG8_MMA(0, 0, At, B0); PG8_MMA(0, 1, At, B1); PG8_BAR; PG8_SCHED;
            PG8_LDA(At, 1, 1); PG8_STAGE(PG8_SB(1, 0), b3, voffB); PG8_STAGE(PG8_SB(1, 1), b3 + hstep, voffB); PG8_STAGE(PG8_SA(1, 0), a3, voffA);
            PG8_WAIT_V(8); PG8_WAIT_L(0); PG8_BAR; PG8_MMA(1, 0, At, B0); PG8_MMA(1, 1, At, B1); PG8_BAR; PG8_SCHED;
            } else {
            PG8_LDB(B0, 0, 0); PG8_SCHED; PG8_LDA(At, 0, 0); PG8_STAGE(PG8_SA(1, 1), a1 + hstep, voffA);
            PG8_WAIT_L(8); PG8_BAR; PG8_WAIT_L(0); PG8_MMA(0, 0, At, B0); PG8_BAR; PG8_SCHED;
            PG8_LDB(B1, 0, 1); PG8_STAGE(PG8_SB(0, 0), b2, voffB);
            PG8_BAR; PG8_WAIT_L(0); PG8_MMA(0, 1, At, B1); PG8_BAR;
            PG8_LDA(At, 0, 1); PG8_STAGE(PG8_SA(0, 0), a2, voffA);
            PG8_BAR; PG8_WAIT_L(0); PG8_MMA(1, 0, At, B0); PG8_BAR; PG8_SCHED;
            PG8_STAGE(PG8_SB(0, 1), b2 + hstep, voffB);
            PG8_WAIT_V(6); PG8_BAR; PG8_MMA(1, 1, At, B1); PG8_BAR;
            PG8_LDB(B0, 1, 0); PG8_SCHED; PG8_LDA(At, 1, 0); PG8_STAGE(PG8_SA(0, 1), a2 + hstep, voffA);
            PG8_WAIT_L(8); PG8_BAR; PG8_WAIT_L(0); PG8_MMA(0, 0, At, B0); PG8_BAR; PG8_SCHED;
            PG8_LDB(B1, 1, 1); PG8_STAGE(PG8_SB(1, 0), b3, voffB);
            PG8_BAR; PG8_WAIT_L(0); PG8_MMA(0, 1, At, B1); PG8_BAR;
            PG8_LDA(At, 1, 1); PG8_STAGE(PG8_SA(1, 0), a3, voffA);
            PG8_BAR; PG8_WAIT_L(0); PG8_MMA(1, 0, At, B0); PG8_BAR; PG8_SCHED;
            PG8_STAGE(PG8_SB(1, 1), b3 + hstep, voffB);
            PG8_WAIT_V(6); PG8_BAR; PG8_MMA(1, 1, At, B1); PG8_BAR;
            }
        }
        if constexpr (ALIGN_EPI) { if (wr == 0) PG8_BAR; }
        if constexpr (!Epi::AFTER_DRAIN) { E(acc, cur, wr, wc, fr, fq); S.done(cur); }
        if (!has_next) break;
#pragma unroll
        for (int a = 0; a < 2; ++a)
#pragma unroll
            for (int b = 0; b < 2; ++b)
#pragma unroll
                for (int m = 0; m < 4; ++m)
#pragma unroll
                    for (int n = 0; n < 2; ++n) acc[a][b][m][n] = (f32x4){0.f, 0.f, 0.f, 0.f};
        cur = nxt; cA = nA; cB = nB; ++ui;
        if constexpr (ALIGN_EPI) { if (wr == 1) PG8_BAR; }
    }
    PG8_WAIT_V(0);
    if constexpr (!ALIGN_EPI) { if (wr == 0) PG8_BAR; }
    PG8_BAR;
    if constexpr (Epi::AFTER_DRAIN) { E.fused(acc, cur, wr, wc, fr, fq, lds, wid, lane); S.done(cur); }
#undef PG8_SA
#undef PG8_SB
#undef PG8_STAGE
#undef PG8_LDA
#undef PG8_LDB
#undef PG8_MMA
#undef PG8_WAIT_V
#undef PG8_WAIT_L
#undef PG8_BAR
#undef PG8_SCHED
}
}
#define GAS __attribute__((address_space(1)))
#define LAS __attribute__((address_space(3)))
typedef unsigned short bf16;
typedef unsigned v4u __attribute__((ext_vector_type(4)));
typedef float f32x4 __attribute__((ext_vector_type(4)));
typedef short bf16x8 __attribute__((ext_vector_type(8)));
typedef GAS unsigned gu32;
typedef GAS unsigned long long gu64;
#define RLX_AGENT __ATOMIC_RELAXED, __HIP_MEMORY_SCOPE_AGENT
#define LDS_WAIT() asm volatile("s_waitcnt lgkmcnt(0)" ::: "memory")
#define VM_WAIT() asm volatile("s_waitcnt vmcnt(0)" ::: "memory")
__device__ __forceinline__ unsigned long long rt() { return __builtin_amdgcn_s_memrealtime(); }
__device__ __forceinline__ unsigned f2bf(float f) { unsigned u = __builtin_bit_cast(unsigned, f); return (u + 0x7fffu + ((u >> 16) & 1u)) >> 16; }
__device__ __forceinline__ unsigned pk2(float lo, float hi) { return f2bf(lo) | (f2bf(hi) << 16); }

#define XB_TMO      128
#define XB_XCNT(j)  (256  + 64 * (j))
#define XB_XSUB(j)  (1280 + 64 * (j))
#define XB_XGEN(j)  (2304 + 64 * (j))
#define XB_TOP      3328
#define XB_TOPGEN   3392
#define XCD_BAR_WORDS 3456
#define XB_SPIN_CAP (1u << 18)

__device__ __forceinline__ unsigned xb_ld(unsigned* p)              { return __hip_atomic_load(p, __ATOMIC_RELAXED, __HIP_MEMORY_SCOPE_AGENT); }
__device__ __forceinline__ unsigned xb_add(unsigned* p, unsigned v) { return __hip_atomic_fetch_add(p, v, __ATOMIC_RELAXED, __HIP_MEMORY_SCOPE_AGENT); }
__device__ __forceinline__ unsigned xb_xcc_id() { return (unsigned)__builtin_amdgcn_s_getreg((3 << 11) | 20) & 0xFu; }
#define XB_SPIN(cond, bar) do { unsigned _sp = 0; while (cond) { __builtin_amdgcn_s_sleep(1); \
    if ((++_sp & 255u) == 0u) { if (xb_ld(&(bar)[XB_TMO])) break; if (_sp > XB_SPIN_CAP) { atomicAdd(&(bar)[XB_TMO], 1u); break; } } } } while (0)

struct XcdBarrier {
    unsigned* bar; unsigned x;
    volatile LAS unsigned* st;
};

__device__ __forceinline__ XcdBarrier xcd_barrier_post(unsigned* bar, volatile LAS unsigned* st) {
    XcdBarrier b; b.bar = bar; b.x = xb_xcc_id(); b.st = st;
    if (threadIdx.x == 0) (void)xb_add(&bar[XB_XCNT(b.x)], 1u);
    return b;
}
__device__ __forceinline__ void xcd_barrier_complete(unsigned* bar, unsigned x, unsigned& nloc, unsigned& nx) {
    const unsigned G = gridDim.x * gridDim.y * gridDim.z;
    unsigned sum, cnt, mine, sp = 0u;
    for (;;) {
        sum = 0u; cnt = 0u; mine = 0u;
#pragma unroll
        for (unsigned j = 0; j < 16; ++j) { const unsigned c = xb_ld(&bar[XB_XCNT(j)]); sum += c; cnt += (c > 0u) ? 1u : 0u; mine = (j == x) ? c : mine; }
        if (sum == G) break;
        __builtin_amdgcn_s_sleep(1);
        if ((++sp & 255u) == 0u) { if (xb_ld(&bar[XB_TMO])) break; if (sp > XB_SPIN_CAP) { atomicAdd(&bar[XB_TMO], 1u); break; } }
    }
    nloc = mine > 0u ? mine : 1u; nx = cnt > 0u ? cnt : 1u;
}

__device__ __forceinline__ void xcd_barrier(const XcdBarrier& b) {
    asm volatile("s_waitcnt vmcnt(0)" ::: "memory");
    __syncthreads();
    if (threadIdx.x == 0) {
        unsigned* bar = b.bar;
        __builtin_amdgcn_s_waitcnt(0);
        unsigned nloc = b.st[0], nx = b.st[1];
        if (nloc == 0u) { xcd_barrier_complete(bar, b.x, nloc, nx); b.st[0] = nloc; b.st[1] = nx; }
        const unsigned old = xb_add(&bar[XB_XSUB(b.x)], 1u);
        const unsigned gen = old / nloc;
        if (old + 1u == (gen + 1u) * nloc) {
            __builtin_amdgcn_fence(__ATOMIC_RELEASE, "agent");
            asm volatile("s_waitcnt vmcnt(0)" ::: "memory");
            const unsigned og = xb_add(&bar[XB_TOP], 1u);
            const unsigned tg = og / nx;
            if (og + 1u == (tg + 1u) * nx) xb_add(&bar[XB_TOPGEN], 1u);
            else XB_SPIN(xb_ld(&bar[XB_TOPGEN]) == tg, bar);
            __builtin_amdgcn_fence(__ATOMIC_ACQUIRE, "agent");
            xb_add(&bar[XB_XGEN(b.x)], 1u);
            asm volatile("s_waitcnt vmcnt(0)" ::: "memory");
        } else {
            XB_SPIN(xb_ld(&bar[XB_XGEN(b.x)]) == gen, bar);
            __builtin_amdgcn_fence(__ATOMIC_ACQUIRE, "agent");
            asm volatile("s_waitcnt vmcnt(0)" ::: "memory");
        }
    }
    __syncthreads();
}
namespace att {
typedef unsigned short bf16;
typedef short bf16x8 __attribute__((ext_vector_type(8)));
typedef short s16x4 __attribute__((ext_vector_type(4)));
typedef short v4i16_t __attribute__((ext_vector_type(4)));
typedef float f32x16 __attribute__((ext_vector_type(16)));
typedef unsigned u32x4 __attribute__((ext_vector_type(4)));
typedef float f32x2_t __attribute__((ext_vector_type(2)));
typedef __bf16 bf16x2_t __attribute__((ext_vector_type(2)));
#define ALDS __attribute__((address_space(3)))
#define ASBAR() __builtin_amdgcn_sched_barrier(0)
constexpr int WS_OFF = 135168;
constexpr int TAB_OFF = WS_OFF + 2048;
constexpr int QR_OFF = 81920;
constexpr int NQL = 6;
constexpr int ATT_LDS_BYTES = TAB_OFF + 2048;
static_assert(QR_OFF + 8 * NQL * 1024 <= WS_OFF, "MLA query park fits below the scratch");
#ifndef ATT_STAGGER
#define ATT_STAGGER 0
#endif
constexpr float THR2 = 8.0f;
__device__ __forceinline__ int crow(int r, int hi) { return (r & 3) + 8 * (r >> 2) + 4 * hi; }
__device__ __forceinline__ void glds16(const void* gsrc, unsigned lds_dst) { unsigned keep;
    asm volatile("s_mov_b32 %0, m0\n\ts_mov_b32 m0, %2\n\ts_nop 0\n\tglobal_load_lds_dwordx4 %1, off\n\ts_mov_b32 m0, %0" : "=&s"(keep) : "v"(gsrc), "s"(lds_dst) : "memory"); }
template <int IMM> __device__ __forceinline__ void glds16s(const void* sbase, unsigned voff, unsigned lds_dst_) { unsigned keep; const unsigned lds_dst = lds_dst_ - (unsigned)IMM;
    asm volatile("s_mov_b32 %0, m0\n\ts_mov_b32 m0, %3\n\ts_nop 3\n\tglobal_load_lds_dwordx4 %1, %2 offset:%c4\n\ts_mov_b32 m0, %0" : "=&s"(keep) : "v"(voff), "s"(sbase), "s"(lds_dst), "i"(IMM) : "memory"); }
__device__ __forceinline__ const unsigned char* uni_ptr(const void* p) { const unsigned long long v = (unsigned long long)p;
    const unsigned lo = __builtin_amdgcn_readfirstlane((unsigned)v), hi = __builtin_amdgcn_readfirstlane((unsigned)(v >> 32)); return (const unsigned char*)(((unsigned long long)hi << 32) | lo); }
__device__ __forceinline__ unsigned cvtpk_s(float lo, float hi) { f32x2_t v = {lo, hi}; bf16x2_t b = __builtin_convertvector(v, bf16x2_t); return __builtin_bit_cast(unsigned, b); }
__device__ __forceinline__ float swapmax(float v) { auto rr = __builtin_amdgcn_permlane32_swap(__float_as_uint(v), __float_as_uint(v), false, false); return fmaxf(__uint_as_float(rr[0]), __uint_as_float(rr[1])); }
__device__ __forceinline__ float swapsum(float v) { auto rr = __builtin_amdgcn_permlane32_swap(__float_as_uint(v), __float_as_uint(v), false, false); return __uint_as_float(rr[0]) + __uint_as_float(rr[1]); }
#define ATT_WAIT_BAR() asm volatile("s_waitcnt vmcnt(0) lgkmcnt(0)\n\ts_barrier" ::: "memory")
#define ATT_WAIT_BAR_N(N) asm volatile("s_waitcnt vmcnt(" #N ") lgkmcnt(0)\n\ts_barrier" ::: "memory")

__device__ __forceinline__ s16x4 vtr(ALDS const unsigned char* p) { return __builtin_bit_cast(s16x4, __builtin_amdgcn_ds_read_tr16_b64_v4i16((ALDS v4i16_t*)p)); }

struct AttnArgs { void* prof; const bf16* QKV; const bf16* QM; const bf16* KVM; const bf16* KR; const bf16* GATE; bf16* Y; const float* biastab; const float* subg; float lam; float oml; };

__device__ __forceinline__ void pv4(f32x16* o, int vb, bf16x8 pa0, bf16x8 pa1, bf16x8 pa2, bf16x8 pa3) {
#pragma unroll
    for (int d0 = 0; d0 < 4; ++d0) { s16x4 lo[4], hh[4];
#pragma unroll
        for (int ks = 0; ks < 4; ++ks) {
            asm volatile("ds_read_b64_tr_b16 %0, %1 offset:%c2" : "=&v"(lo[ks]) : "v"(vb), "i"(d0 * 4096 + ks * 1024) : "memory");
            asm volatile("ds_read_b64_tr_b16 %0, %1 offset:%c2" : "=&v"(hh[ks]) : "v"(vb), "i"(d0 * 4096 + ks * 1024 + 512) : "memory"); }
        asm volatile("s_waitcnt lgkmcnt(0)" ::: "memory"); ASBAR();
#define ATT_PK(k) (bf16x8){lo[k][0], lo[k][1], lo[k][2], lo[k][3], hh[k][0], hh[k][1], hh[k][2], hh[k][3]}
        o[d0] = __builtin_amdgcn_mfma_f32_32x32x16_bf16(pa0, ATT_PK(0), o[d0], 0, 0, 0);
        o[d0] = __builtin_amdgcn_mfma_f32_32x32x16_bf16(pa1, ATT_PK(1), o[d0], 0, 0, 0);
        o[d0] = __builtin_amdgcn_mfma_f32_32x32x16_bf16(pa2, ATT_PK(2), o[d0], 0, 0, 0);
        o[d0] = __builtin_amdgcn_mfma_f32_32x32x16_bf16(pa3, ATT_PK(3), o[d0], 0, 0, 0);
#undef ATT_PK
    }
}

template <bool DIFF, int MODE = 0>
__device__ __forceinline__ void attn_unit(const AttnArgs& A, int b, int h, int qb, unsigned char* shm) {
    constexpr int ND0 = DIFF ? 4 : 12;
    constexpr int QROWS = DIFF ? 128 : 256;
    constexpr int KSLOT = DIFF ? 16384 : 24576;
    constexpr int LEAD = DIFF ? 2 : 1;
    constexpr int NSLOT = LEAD + 1;
    constexpr int V_OFF = NSLOT * KSLOT;
    int tid_ = threadIdx.x; asm volatile("" : "+v"(tid_));
    const int tid = tid_, lane = tid & 63, r32 = lane & 31, hi = lane >> 5; const int wid = __builtin_amdgcn_readfirstlane(tid >> 6);
    const int map = DIFF ? (wid >> 2) : 0, wrow = DIFF ? (wid & 3) : wid;
    const int q0 = qb * QROWS + wrow * 32;
    const int cw = q0 >> 6;
    const int NT = (qb * QROWS + QROWS) >> 6;
    const long rowbase = (long)b * SEQ;
    const unsigned lds0 = (unsigned)(uintptr_t)shm;
    ALDS unsigned char* shm3 = (ALDS unsigned char*)shm;
    ALDS float* wsf = (ALDS float*)(shm3 + WS_OFF) + wid * 64;
    ALDS float* tabl = (ALDS float*)(shm3 + TAB_OFF) + map * 256;
    const int vrow = 16 * (wid & 3) + (lane >> 2), vcol = (wid >> 2) * 32 + (lane & 3) * 8;
    constexpr int PITCHB = DIFF ? 6144 : 4096;
    const int krow = 8 * wid + (lane >> 3), kchk = (lane & 7) ^ ((krow >> 1) & 7);
    const unsigned voffK = (unsigned)(krow * PITCHB + kchk * 16), voffV = (unsigned)(vrow * PITCHB + vcol * 2), voffR = (unsigned)(krow * 128 + kchk * 16);
    const unsigned char* kvbase = DIFF ? (const unsigned char*)(A.QKV + rowbase * 3072 + 1024 + h * 128) : (const unsigned char*)(A.KVM + rowbase * 2048 + h * 256);
    const unsigned char* krbase = (const unsigned char*)(A.KR + rowbase * 64);
    const unsigned kd0 = lds0 + wid * 1024, vd0 = lds0 + V_OFF + wid * 1024;
    constexpr int VIMM = DIFF ? 2048 : 256;
#define ATT_DMA_K(t, sl) do { const long _t = (t); const unsigned _so = (unsigned)((sl) * KSLOT); const unsigned char* _b = uni_ptr(kvbase + _t * (64L * PITCHB)); \
        glds16s<0>(_b, voffK, (unsigned)__builtin_amdgcn_readfirstlane(kd0 + _so)); \
        glds16s<128>(_b, voffK, (unsigned)__builtin_amdgcn_readfirstlane(kd0 + 8192 + _so)); \
        if (!DIFF) glds16s<0>(uni_ptr(krbase + _t * (64L * 128)), voffR, (unsigned)__builtin_amdgcn_readfirstlane(kd0 + 16384 + _so)); } while (0)
#define ATT_DMA_V(t, sl) do { const long _t = (t); const unsigned _so = (unsigned)((sl) * 16384); const unsigned char* _b = uni_ptr(kvbase + _t * (64L * PITCHB)); \
        glds16s<VIMM>(_b, voffV, (unsigned)__builtin_amdgcn_readfirstlane(vd0 + _so)); \
        glds16s<VIMM + 128>(_b, voffV, (unsigned)__builtin_amdgcn_readfirstlane(vd0 + 8192 + _so)); } while (0)
    if (MODE < 2) { ATT_DMA_K(0, 0); if (LEAD == 2) { if (1 < NT) ATT_DMA_K(1, 1); ATT_DMA_V(0, 0); } }
    if (DIFF) { ((ALDS float*)(shm3 + TAB_OFF))[tid] = A.biastab[(h * 2 + (tid >> 8)) * 256 + (tid & 255)]; }
    constexpr int NQREG = DIFF ? ND0 : ND0 - NQL;
    bf16x8 qr[NQREG];
    ALDS unsigned char* qlds = shm3 + QR_OFF + wid * (NQL * 1024) + lane * 16;
    { const bf16* Qw = DIFF ? A.QKV + (rowbase + q0 + r32) * 3072 + h * 128 + map * 64 + hi * 8 : A.QM + (rowbase + q0 + r32) * 1536 + h * 192 + hi * 8;
#pragma unroll
      for (int d0 = 0; d0 < NQREG; ++d0) qr[d0] = *reinterpret_cast<const bf16x8*>(Qw + d0 * 16);
      if (!DIFF) {
#pragma unroll
          for (int d0 = NQREG; d0 < ND0; ++d0) *(ALDS bf16x8*)(qlds + (d0 - NQREG) * 1024) = *reinterpret_cast<const bf16x8*>(Qw + d0 * 16); } }
    float boff = 0.f; if (DIFF) boff = A.biastab[(h * 2 + map) * 256];
    float m_ref = 0.f, l_reg = 0.f; f32x16 o[4];
#pragma unroll
    for (int d = 0; d < 4; ++d) o[d] = f32x16{};
    const int kfo = (DIFF ? map * 8192 : 0) + r32 * 128;
    int ko[4];
#pragma unroll
    for (int i = 0; i < 4; ++i) ko[i] = 16 * ((2 * i + hi) ^ ((r32 >> 1) & 7));
    const int vbo = V_OFF + ((lane >> 4) & 1) * 32 + (lane & 3) * 8 + (4 * hi + ((lane & 15) >> 2)) * 64;
    f32x16 pA0, pA1, pB0, pB1; float alA = 1.f, alB = 1.f, alS = 1.f; (void)alA; (void)alB;
    u32x4 pw0, pw1, pw2, pw3;
    s16x4 vAl[4], vAh[4], vBl[4], vBh[4]; bf16x8 kf[8]; f32x16 negm; float negv = 3e38f;
#pragma unroll
    for (int r = 0; r < 16; ++r) negm[r] = 0.f;
#define ATT_MF(acc, a, b) acc = __builtin_amdgcn_mfma_f32_32x32x16_bf16(a, b, acc, 0, 0, 0)
#define ATT_QK(P0, P1, T) do { ALDS const unsigned char* kp_ = shm3 + sj * KSLOT + kfo; \
        const float nb_ = ((DIFF && ((T) + 2 < cw)) ? boff : 0.f) - m_ref; \
        _Pragma("unroll") for (int r = 0; r < 16; ++r) { P0[r] = nb_; P1[r] = nb_; } \
        _Pragma("unroll") for (int d0 = 0; d0 < ND0; ++d0) { \
            const bf16x8 b0_ = *(ALDS const bf16x8*)(kp_ + (d0 >> 2) * 8192 + ko[d0 & 3]); const bf16x8 b1_ = *(ALDS const bf16x8*)(kp_ + (d0 >> 2) * 8192 + ko[d0 & 3] + 4096); \
            bf16x8 q_; if (d0 < NQREG) q_ = qr[d0 < NQREG ? d0 : 0]; else q_ = *(ALDS const bf16x8*)(qlds + (d0 - NQREG) * 1024); \
            ATT_MF(P0, b0_, q_); ATT_MF(P1, b1_, q_); } } while (0)
#define ATT_FIN(P0, P1, AL) do { float ps_;   \
        { float s0_ = P0[0] + P1[0], s1_ = P0[1] + P1[1], s2_ = P0[2] + P1[2], s3_ = P0[3] + P1[3]; \
          _Pragma("unroll") for (int r = 4; r < 16; r += 4) { s0_ += P0[r] + P1[r]; s1_ += P0[r + 1] + P1[r + 1]; s2_ += P0[r + 2] + P1[r + 2]; s3_ += P0[r + 3] + P1[r + 3]; } \
          ps_ = (s0_ + s1_) + (s2_ + s3_); } \
        l_reg += ps_; psum_ = ps_; \
        pw0 = (u32x4){cvtpk_s(P0[0], P0[1]), cvtpk_s(P0[2], P0[3]), cvtpk_s(P0[4], P0[5]), cvtpk_s(P0[6], P0[7])}; \
        pw1 = (u32x4){cvtpk_s(P0[8], P0[9]), cvtpk_s(P0[10], P0[11]), cvtpk_s(P0[12], P0[13]), cvtpk_s(P0[14], P0[15])}; \
        pw2 = (u32x4){cvtpk_s(P1[0], P1[1]), cvtpk_s(P1[2], P1[3]), cvtpk_s(P1[4], P1[5]), cvtpk_s(P1[6], P1[7])}; \
        pw3 = (u32x4){cvtpk_s(P1[8], P1[9]), cvtpk_s(P1[10], P1[11]), cvtpk_s(P1[12], P1[13]), cvtpk_s(P1[14], P1[15])}; } while (0)
#define ATT_VRD(VL, VH, d0) do { if (MODE == 5) break; _Pragma("unroll") for (int ks = 0; ks < 4; ++ks) { VL[ks] = vtr(vp_ + (d0) * 4096 + ks * 1024); VH[ks] = vtr(vp_ + (d0) * 4096 + ks * 1024 + 512); } } while (0)
#define ATT_VF(VL, VH, k) (bf16x8){VL[k][0], VL[k][1], VL[k][2], VL[k][3], VH[k][0], VH[k][1], VH[k][2], VH[k][3]}
#define ATT_MF4(od, VL, VH) do { if (MODE == 6 || MODE == 8) break; ATT_MF(od, __builtin_bit_cast(bf16x8, pw0), ATT_VF(VL, VH, 0)); ATT_MF(od, __builtin_bit_cast(bf16x8, pw1), ATT_VF(VL, VH, 1)); \
        ATT_MF(od, __builtin_bit_cast(bf16x8, pw2), ATT_VF(VL, VH, 2)); ATT_MF(od, __builtin_bit_cast(bf16x8, pw3), ATT_VF(VL, VH, 3)); } while (0)
#define ATT_SM_BIAS(P0, P1, T) do { if (MODE == 3) break; if (DIFF && ((T) + 2 >= cw) && ((T) <= cw)) { ALDS const float* tb_ = tabl + (64 * (T) - q0 - r32 + 192); \
        _Pragma("unroll") for (int r = 0; r < 16; ++r) { const int kk_ = crow(r, hi); P0[r] += tb_[kk_]; P1[r] += tb_[kk_ + 32]; } } } while (0)
#define ATT_SM_MAX0(P0) do { if (MODE == 3) break; rma_ = fmaxf(fmaxf(P0[0], P0[1]), P0[2]); rmb_ = fmaxf(fmaxf(P0[3], P0[4]), P0[5]); rmc_ = fmaxf(fmaxf(P0[6], P0[7]), P0[8]); rmd_ = fmaxf(fmaxf(P0[9], P0[10]), P0[11]); \
        rma_ = fmaxf(fmaxf(rma_, P0[12]), P0[13]); rmb_ = fmaxf(fmaxf(rmb_, P0[14]), P0[15]); } while (0)
#define ATT_SM_MAX1(P1) do { if (MODE == 3) break; rmc_ = fmaxf(fmaxf(rmc_, P1[0]), P1[1]); rmd_ = fmaxf(fmaxf(rmd_, P1[2]), P1[3]); rma_ = fmaxf(fmaxf(rma_, P1[4]), P1[5]); rmb_ = fmaxf(fmaxf(rmb_, P1[6]), P1[7]); \
        rmc_ = fmaxf(fmaxf(rmc_, P1[8]), P1[9]); rmd_ = fmaxf(fmaxf(rmd_, P1[10]), P1[11]); rma_ = fmaxf(fmaxf(rma_, P1[12]), P1[13]); rmb_ = fmaxf(fmaxf(rmb_, P1[14]), P1[15]); \
        rma_ = swapmax(fmaxf(fmaxf(rma_, rmb_), fmaxf(rmc_, rmd_))); } while (0)
#define ATT_SM_DEC(P0, P1) do { alS = 1.f; if (__any(psum_ > 65536.f)) { const float pr_ = swapsum(psum_); const float dl_ = pr_ > 65536.f ? __builtin_amdgcn_logf(pr_) : 0.f; m_ref += dl_; \
        _Pragma("unroll") for (int r = 0; r < 16; ++r) { P0[r] -= dl_; P1[r] -= dl_; } \
        alS = __builtin_amdgcn_exp2f(-dl_); } } while (0)
#define ATT_SM_EXP8(P, B) do { _Pragma("unroll") for (int r = (B); r < (B) + 8; ++r) P[r] = __builtin_amdgcn_exp2f(P[r]); } while (0)
#define ATT_RESC(AL) do { if (__any((AL) < 1.f)) { l_reg *= (AL); if (hi == 0) wsf[r32] = (AL); asm volatile("s_waitcnt lgkmcnt(0)" ::: "memory"); \
        _Pragma("unroll") for (int r = 0; r < 16; ++r) { const float al_ = wsf[crow(r, hi)]; _Pragma("unroll") for (int d = 0; d < 4; ++d) o[d][r] *= al_; } } } while (0)
#define ATT_STEP(PQ0, PQ1, ALQ, PF0, PF1, ALF, J) do { const int j_ = (J); \
        const int sm1_ = (sj == 0) ? NSLOT - 1 : sj - 1, sm2_ = (sm1_ == 0) ? NSLOT - 1 : sm1_ - 1;     \
        int nd_ = 0; if (MODE < 2) { if (j_ + LEAD < NT) { ATT_DMA_K(j_ + LEAD, sm1_); nd_ += DIFF ? 2 : 3; } if (j_ + LEAD - 1 < NT) { ATT_DMA_V(j_ + LEAD - 1, sm2_); nd_ += 2; } } \
        if (MODE != 1 && MODE != 9 && j_ <= cw + 1) { \
            ALDS const unsigned char* vp_ = shm3 + vbo + sm1_ * 16384; float psum_ = 0.f; \
            if (DIFF) {   \
                const int sp1_ = (sj + 1 == NSLOT) ? 0 : sj + 1; \
                ASBAR(); \
                { const float nb_ = ((j_ + 2 < cw) ? boff : 0.f) - m_ref;     \
                  if (__any(nb_ != negv)) { negv = nb_; _Pragma("unroll") for (int r = 0; r < 16; ++r) negm[r] = nb_; asm volatile("" : "+v"(negm)); } \
                  PQ0 = __builtin_amdgcn_mfma_f32_32x32x16_bf16(kf[0], qr[0], negm, 0, 0, 0); PQ1 = __builtin_amdgcn_mfma_f32_32x32x16_bf16(kf[1], qr[0], negm, 0, 0, 0); \
                  _Pragma("unroll") for (int d0 = 1; d0 < 4; ++d0) { ATT_MF(PQ0, kf[2 * d0], qr[d0]); ATT_MF(PQ1, kf[2 * d0 + 1], qr[d0]); } } \
                ATT_FIN(PF0, PF1, 1.f); ASBAR(); \
                { ALDS const unsigned char* kpn_ = shm3 + sp1_ * KSLOT + kfo;     \
                  _Pragma("unroll") for (int d0 = 0; d0 < 4; ++d0) { kf[2 * d0] = *(ALDS const bf16x8*)(kpn_ + ko[d0]); kf[2 * d0 + 1] = *(ALDS const bf16x8*)(kpn_ + ko[d0] + 4096); } } \
                ASBAR(); \
                ATT_SM_BIAS(PQ0, PQ1, j_); ASBAR(); \
                ATT_SM_DEC(PQ0, PQ1); ASBAR(); \
                ATT_VRD(vAl, vAh, 0); ATT_MF4(o[0], vAl, vAh); ATT_SM_EXP8(PQ0, 0); ASBAR(); \
                ATT_VRD(vAl, vAh, 1); ATT_MF4(o[1], vAl, vAh); ATT_SM_EXP8(PQ0, 8); ASBAR(); \
                ATT_VRD(vAl, vAh, 2); ATT_MF4(o[2], vAl, vAh); ATT_SM_EXP8(PQ1, 0); ASBAR(); \
                ATT_VRD(vAl, vAh, 3); ATT_MF4(o[3], vAl, vAh); ATT_SM_EXP8(PQ1, 8); ASBAR(); \
            } else { \
            ASBAR(); ATT_QK(PQ0, PQ1, j_); ATT_FIN(PF0, PF1, 1.f); ASBAR(); \
            ATT_SM_BIAS(PQ0, PQ1, j_); ASBAR(); \
            ATT_SM_DEC(PQ0, PQ1); ASBAR(); \
                ATT_VRD(vAl, vAh, 0); ATT_MF4(o[0], vAl, vAh); ATT_SM_EXP8(PQ0, 0); ASBAR(); \
            ATT_VRD(vAl, vAh, 1); ATT_MF4(o[1], vAl, vAh); ATT_SM_EXP8(PQ0, 8); ASBAR(); \
            ATT_VRD(vAl, vAh, 2); ATT_MF4(o[2], vAl, vAh); ATT_SM_EXP8(PQ1, 0); ASBAR(); \
            ATT_VRD(vAl, vAh, 3); ATT_MF4(o[3], vAl, vAh); ATT_SM_EXP8(PQ1, 8); ASBAR(); \
            } \
        } \
        if (MODE != 4) ATT_WAIT_BAR();     \
        if (ATT_STAGGER > 0 && wid >= 4) __builtin_amdgcn_s_sleep(ATT_STAGGER);     \
        if (j_ <= cw + 1) ATT_RESC(alS); \
        sj = (sj + 1 == NSLOT) ? 0 : sj + 1; } while (0)
    { const u32x4 z_ = {0u, 0u, 0u, 0u}; ALDS u32x4* vz_ = (ALDS u32x4*)(shm3 + V_OFF + (NSLOT - 1) * 16384) + tid * 2; vz_[0] = z_; vz_[1] = z_; }
#pragma unroll
    for (int r = 0; r < 16; ++r) { pB0[r] = 0.f; pB1[r] = 0.f; }
    ATT_WAIT_BAR();
    int sj = 0;
    if (DIFF && MODE != 1) { ALDS const unsigned char* kp0_ = shm3 + kfo; ALDS const unsigned char* vp0_ = shm3 + vbo + (NSLOT - 1) * 16384;
#pragma unroll
        for (int d0 = 0; d0 < 4; ++d0) { kf[2 * d0] = *(ALDS const bf16x8*)(kp0_ + ko[d0]); kf[2 * d0 + 1] = *(ALDS const bf16x8*)(kp0_ + ko[d0] + 4096); }
 }
    for (int j = 0; j <= NT; j += 2) {
        ATT_STEP(pA0, pA1, alA, pB0, pB1, alB, j);
        if (j + 1 <= NT) ATT_STEP(pB0, pB1, alB, pA0, pA1, alA, j + 1);
    }
#undef ATT_DMA_K
#undef ATT_DMA_V
#undef ATT_QK
#undef ATT_FIN
#undef ATT_VRD
#undef ATT_VF
#undef ATT_MF4
#undef ATT_MF
#undef ATT_SM_BIAS
#undef ATT_SM_MAX0
#undef ATT_SM_MAX1
#undef ATT_SM_DEC
#undef ATT_SM_EXP8
#undef ATT_RESC
#undef ATT_STEP
    if (MODE == 1) { ATT_WAIT_BAR(); return; }
    if (MODE >= 2) { ATT_WAIT_BAR(); if (l_reg == 123456.f) A.Y[tid] = (bf16)(int)(o[0][0] + o[1][1] + o[2][2] + o[3][3] + m_ref); ATT_WAIT_BAR(); return; }
    {
    int tid2_ = threadIdx.x; asm volatile("" : "+v"(tid2_));
    const int lane = tid2_ & 63, r32 = lane & 31, hi = lane >> 5; const int wid = __builtin_amdgcn_readfirstlane(tid2_ >> 6);
    const int map = DIFF ? (wid >> 2) : 0, wrow = DIFF ? (wid & 3) : wid;
    const int q0 = qb * QROWS + wrow * 32;
    ALDS float* wsf = (ALDS float*)(shm3 + WS_OFF) + wid * 64;
    ATT_WAIT_BAR();
    l_reg = swapsum(l_reg);
    if (hi == 0) wsf[32 + r32] = __builtin_amdgcn_rcpf(l_reg);
    asm volatile("s_waitcnt lgkmcnt(0)" ::: "memory");
    float rli[16];
#pragma unroll
    for (int r = 0; r < 16; ++r) rli[r] = wsf[32 + crow(r, hi)];
    ALDS bf16* stg;
    bool writer = true;
    if (DIFF) {
        ALDS float* X = (ALDS float*)(shm3 + (wid & 3) * 16384);
        if (map == 1) {
            const float lam = A.lam;
#pragma unroll
            for (int r = 0; r < 16; ++r) { const float f = rli[r] * lam; const int orow = crow(r, hi);
#pragma unroll
                for (int d = 0; d < 4; ++d) X[orow * 128 + d * 32 + r32] = o[d][r] * f; }
        }
        ATT_WAIT_BAR();
        stg = (ALDS bf16*)(shm3 + (wid & 3) * 16384);
        if (map == 0) {
            float g4[4];
#pragma unroll
            for (int d = 0; d < 4; ++d) g4[d] = A.subg[d * 32 + r32] * A.oml;
            float ss[16];
#pragma unroll
            for (int r = 0; r < 16; ++r) { const int orow = crow(r, hi); float s = 0.f;
#pragma unroll
                for (int d = 0; d < 4; ++d) { const float v = o[d][r] * rli[r] - X[orow * 128 + d * 32 + r32]; o[d][r] = v; s += v * v; }
                ss[r] = s; }
#pragma unroll
            for (int r = 0; r < 16; ++r) { float s = ss[r];
                s += __shfl_xor(s, 1); s += __shfl_xor(s, 2); s += __shfl_xor(s, 4); s += __shfl_xor(s, 8); s += __shfl_xor(s, 16);
                ss[r] = 1.0f / sqrtf(s * (1.0f / 128.0f) + EPS); }
            asm volatile("s_waitcnt lgkmcnt(0)" ::: "memory");
#pragma unroll
            for (int r = 0; r < 16; ++r) { const int orow = crow(r, hi);
#pragma unroll
                for (int d = 0; d < 4; ++d) stg[orow * 128 + d * 32 + r32] = (bf16)(cvtpk_s(o[d][r] * ss[r] * g4[d], 0.f) & 0xffffu); }
        } else writer = false;
    } else {
        stg = (ALDS bf16*)(shm3 + wid * 8192);
#pragma unroll
        for (int r = 0; r < 16; ++r) { const int orow = crow(r, hi);
#pragma unroll
            for (int d = 0; d < 4; ++d) stg[orow * 128 + d * 32 + r32] = (bf16)(cvtpk_s(o[d][r] * rli[r], 0.f) & 0xffffu); }
    }
    if (writer) {
        asm volatile("s_waitcnt lgkmcnt(0)" ::: "memory");
        const int gcol = (DIFF ? 0 : 1024) + h * 128;
#pragma unroll
        for (int i = 0; i < 8; ++i) { const int row = i * 4 + (lane >> 4), ch = lane & 15;
            const u32x4 ov = *(ALDS const u32x4*)(stg + row * 128 + ch * 8);
            const size_t gi = (size_t)(rowbase + q0 + row) * 2048 + gcol + ch * 8;
            const u32x4 gv = *(const u32x4*)(A.GATE + gi);
            u32x4 yv;
#pragma unroll
            for (int e = 0; e < 4; ++e) {
                const float o_lo = __uint_as_float(ov[e] << 16), o_hi = __uint_as_float(ov[e] & 0xffff0000u);
                const float g_lo = __uint_as_float(gv[e] << 16), g_hi = __uint_as_float(gv[e] & 0xffff0000u);
                const float s_lo = g_lo * __builtin_amdgcn_rcpf(1.0f + __builtin_amdgcn_exp2f(-g_lo * LOG2E));
                const float s_hi = g_hi * __builtin_amdgcn_rcpf(1.0f + __builtin_amdgcn_exp2f(-g_hi * LOG2E));
                yv[e] = cvtpk_s(o_lo * s_lo, o_hi * s_hi); }
            *(u32x4*)(A.Y + gi) = yv; }
    }
    ATT_WAIT_BAR();
    }
}
#undef ASBAR
}
constexpr size_t MiB = 1u << 20;
constexpr size_t WS_CTL = 0, CTL_ZERO_BYTES = 1 * MiB;
constexpr size_t WS_ROPEC = 1 * MiB, WS_ROPES = WS_ROPEC + 512 * 1024;
constexpr size_t WS_SMALL = 2 * MiB;
constexpr size_t SM_BIAS = 1024, SM_RSQ = 128 * 1024, SM_RSKV = 256 * 1024;
constexpr size_t WS_WIN = 4 * MiB;
constexpr size_t WS_WQB = 52 * MiB;
constexpr size_t WS_WKVB = 55 * MiB;
constexpr size_t WS_WOUT = 57 * MiB;
constexpr size_t WS_H = 80 * MiB;
constexpr size_t WS_Y = WS_H;
constexpr size_t WS_QKV = 144 * MiB;
constexpr size_t WS_CQ = 240 * MiB;
constexpr size_t WS_CKV = 256 * MiB;
constexpr size_t WS_KR = 264 * MiB;
constexpr size_t WS_GATE = 272 * MiB;
constexpr size_t WS_QM = 336 * MiB;
constexpr size_t WS_KVM = 384 * MiB;
constexpr size_t WS_END = 448 * MiB;
constexpr int CW_BAR = 4096;
constexpr size_t CTL_SSQ = 65536;

constexpr int RING_OFF = 0, RING_BYTES = 139264;
constexpr int LDSCTL_OFF = RING_BYTES, MISC_OFF = LDSCTL_OFF + 320;
constexpr int LDS_BYTES = 147456;
constexpr int NWAVES = 8;
static_assert(att::ATT_LDS_BYTES <= RING_BYTES, "attention scratch fits the ring region");

__device__ __forceinline__ float wave_sum(float v) {
#pragma unroll
    for (int o = 1; o < 64; o <<= 1) v += __shfl_xor(v, o);
    return v;
}
__device__ __forceinline__ int in_srccol(int n) {
    if (n < 3840) return n;
    if (n < 3904) { const int p = n - 3840, a = p >> 3, j = p & 7; return 3840 + (j < 4 ? 4 * a + j : 32 + 4 * a + (j - 4)); }
    if (n < 4096) return -1;
    return n - 192;
}
__device__ __forceinline__ int qb_srccol(int n) {
    const int hh = n / 192, off = n - hh * 192; if (off < 128) return n;
    const int p = off - 128, a = p >> 3, j = p & 7; return hh * 192 + 128 + (j < 4 ? 4 * a + j : 32 + 4 * a + (j - 4));
}
template <int MODE>
__device__ __forceinline__ void transpose_item(const float* W, int K, int Nsrc, int Ndst, bf16* WT, const float* gk, LAS float* scr, int item, int lane) {
    const int nblk = Ndst / 32, kb = item / nblk, nb = item - kb * nblk, k0 = 64 * kb, n0 = 32 * nb;
    const int nd = n0 + (lane & 31);
    const int src = (MODE == 1) ? in_srccol(nd) : (MODE == 2) ? qb_srccol(nd) : nd;
    float v[32];
#pragma unroll
    for (int i = 0; i < 32; ++i) { const int kk = 2 * i + (lane >> 5); v[i] = 0.f;
        if (src >= 0) { v[i] = W[(size_t)(k0 + kk) * Nsrc + src]; if (gk) v[i] *= gk[k0 + kk]; } }
#pragma unroll
    for (int i = 0; i < 32; ++i) { const int kk = 2 * i + (lane >> 5); scr[kk * 33 + (lane & 31)] = v[i]; }
    LDS_WAIT(); asm volatile("" ::: "memory");
    const int c = lane & 7;
#pragma unroll
    for (int j = 0; j < 4; ++j) { const int n = (lane >> 3) + 8 * j; const LAS float* s = scr + (8 * c) * 33 + n;
        v4u o; o.x = pk2(s[0 * 33], s[1 * 33]); o.y = pk2(s[2 * 33], s[3 * 33]); o.z = pk2(s[4 * 33], s[5 * 33]); o.w = pk2(s[6 * 33], s[7 * 33]);
        *(GAS v4u*)(WT + (size_t)(n0 + n) * K + k0 + 8 * c) = o; }
    LDS_WAIT(); asm volatile("" ::: "memory");
}
__device__ __forceinline__ void rms_row_to_bf16(const float* xrow, const float* g, bf16* orow, int lane) {
    const GAS f32x4* xr = (const GAS f32x4*)xrow + lane; const GAS f32x4* gr = (const GAS f32x4*)g + lane;
    f32x4 v[8]; float s = 0.f;
#pragma unroll
    for (int j = 0; j < 8; ++j) { v[j] = xr[64 * j]; s += (v[j].x * v[j].x + v[j].y * v[j].y) + (v[j].z * v[j].z + v[j].w * v[j].w); }
    const float rstd = 1.0f / sqrtf(wave_sum(s) * (1.0f / DM) + EPS);
    GAS unsigned long long* o8 = (GAS unsigned long long*)orow + lane;
#pragma unroll
    for (int j = 0; j < 8; ++j) { const f32x4 gg = gr[64 * j];
        o8[64 * j] = (unsigned long long)pk2(v[j].x * rstd * gg.x, v[j].y * rstd * gg.y) | ((unsigned long long)pk2(v[j].z * rstd * gg.z, v[j].w * rstd * gg.w) << 32); }
}
__device__ __forceinline__ void rms_row_f32(const float* xrow, const float* g, float* orow, int lane) {
    const GAS f32x4* xr = (const GAS f32x4*)xrow + lane; const GAS f32x4* gr = (const GAS f32x4*)g + lane;
    f32x4 v[8]; float s = 0.f;
#pragma unroll
    for (int j = 0; j < 8; ++j) { v[j] = xr[64 * j]; s += (v[j].x * v[j].x + v[j].y * v[j].y) + (v[j].z * v[j].z + v[j].w * v[j].w); }
    const float rstd = 1.0f / sqrtf(wave_sum(s) * (1.0f / DM) + EPS);
    GAS f32x4* o4 = (GAS f32x4*)orow + lane;
#pragma unroll
    for (int j = 0; j < 8; ++j) { const f32x4 gg = gr[64 * j]; o4[64 * j] = v[j] * rstd * gg; }
}
__device__ __forceinline__ int rel_bucket(int rel) {
    const int n = rel < 0 ? -rel : rel; int bk;
    if (n < 8) bk = n; else if (n < 12) bk = 8; else if (n < 16) bk = 9; else if (n < 23) bk = 10; else if (n < 32) bk = 11;
    else if (n < 46) bk = 12; else if (n < 64) bk = 13; else if (n < 91) bk = 14; else bk = 15;
    return (rel > 0 ? 16 : 0) + bk;
}

struct Args { const float* in[12]; float* out; unsigned char* ws; int ph_lo, ph_hi; };
constexpr int N_PHASES = 11;

#define IN(k) (lo <= (k) && (k) < hi)
#ifndef MK_REP_G23
#define MK_REP_G23 1
#endif
#ifndef MK_REP_G4
#define MK_REP_G4 1
#endif
#ifndef MK_REP_NORM
#define MK_REP_NORM 1
#endif
#ifndef MK_REP_RS
#define MK_REP_RS 1
#endif
#ifndef MK_ATT_MIX
#define MK_ATT_MIX 1
#endif
#ifndef MK_ATT_PROBE
#define MK_ATT_PROBE 0
#endif
#ifndef MK_REP_G1
#define MK_REP_G1 1
#endif
#ifndef MK_REP_P0
#define MK_REP_P0 1
#endif
#ifndef MK_CG_ONLY
#define MK_CG_ONLY 0
#endif
#ifdef MK_STAMP
#define STAMP(k) do { if (blockIdx.x == 0 && threadIdx.x == 0) WSP(unsigned long long, WS_SMALL + 64)[(k)] = __builtin_amdgcn_s_memrealtime(); } while (0)
#else
#define STAMP(k) do { } while (0)
#endif
#define SEAM(k) do { if (IN(k) && IN((k) + 1)) { if (MK_CG_ONLY || (k) == 0) grid.sync(); else xcd_barrier(bar); } STAMP((k) + 1); } while (0)
#define WSP(T, off) ((T*)(args.ws + (off)))

__device__ __forceinline__ void prologue_phase(const Args& args, unsigned char* lds, int G, int vcu) {
    int tid_ = threadIdx.x; asm volatile("" : "+v"(tid_));
    const int tid = tid_, lane = tid & 63, wave = __builtin_amdgcn_readfirstlane(tid >> 6);
    const int gw = vcu * NWAVES + wave, NGW = G * NWAVES;
    const float* x = args.in[0]; const float* norm_g = args.in[1]; const float* w_in = args.in[2]; const float* diff_lambda = args.in[3];
    const float* qnorm_g = args.in[5]; const float* w_qb = args.in[6]; const float* kvnorm_g = args.in[7];
    const float* w_kvb = args.in[8]; const float* w_out = args.in[9]; const float* rel_bias = args.in[10];
    float* ropec = WSP(float, WS_ROPEC); float* ropes = WSP(float, WS_ROPES); float* smallf = WSP(float, WS_SMALL); float* biastab = WSP(float, WS_SMALL + SM_BIAS);
    bf16* Win_t = WSP(bf16, WS_WIN); bf16* Wqb_t = WSP(bf16, WS_WQB); bf16* Wkvb_t = WSP(bf16, WS_WKVB); bf16* Wout_t = WSP(bf16, WS_WOUT); bf16* Hb = WSP(bf16, WS_H);
    LAS float* scr = (LAS float*)((LAS unsigned char*)lds + RING_OFF + wave * 16384);
    constexpr int I_IN = (DM / 64) * (NINP / 32), I_QB = (QLORA / 64) * (NQB / 32), I_KVB = (KVLORA / 64) * (NKVB / 32), I_OUT = (DM / 64) * (DM / 32);
    constexpr int PER_L = I_IN + I_QB + I_KVB + I_OUT;
    for (int it = gw; it < DEPTH * PER_L; it += NGW) {
        const int l = it / PER_L; int r = it - l * PER_L;
        if (r < I_IN) { transpose_item<1>(w_in + (size_t)l * DM * NIN, DM, NIN, NINP, Win_t + (size_t)l * NINP * DM, nullptr, scr, r, lane); continue; } r -= I_IN;
        if (r < I_QB) { transpose_item<2>(w_qb + (size_t)l * QLORA * NQB, QLORA, NQB, NQB, Wqb_t + (size_t)l * NQB * QLORA, qnorm_g + l * QLORA, scr, r, lane); continue; } r -= I_QB;
        if (r < I_KVB) { transpose_item<0>(w_kvb + (size_t)l * KVLORA * NKVB, KVLORA, NKVB, NKVB, Wkvb_t + (size_t)l * NKVB * KVLORA, kvnorm_g + l * KVLORA, scr, r, lane); continue; } r -= I_KVB;
        transpose_item<0>(w_out + (size_t)l * DM * DM, DM, DM, DM, Wout_t + (size_t)l * DM * DM, nullptr, scr, r, lane);
    }
    const int gt = vcu * (NWAVES * 64) + tid, NGT = G * NWAVES * 64;
    for (int e = gt; e < SEQ * 32; e += NGT) { const int s = e >> 5, i = e & 31;
        const float inv = powf(10000.0f, -(float)i * (1.0f / 32.0f)); const float ang = (float)s * inv;
        ropec[e] = cosf(ang); ropes[e] = sinf(ang); }
    for (int e = gt; e < 16 * 256; e += NGT) { const int mh = e >> 8, idx = e & 255; biastab[e] = rel_bias[rel_bucket(idx - 192) * 16 + mh] * LOG2E; }
    if (gt < DEPTH) { const float* lp = diff_lambda + gt * 256; float s01 = 0.f, s23 = 0.f;
        for (int i = 0; i < 64; ++i) { s01 += lp[i] * lp[64 + i]; s23 += lp[128 + i] * lp[192 + i]; }
        const float lam_init = 0.8f - 0.6f * expf(-0.3f * (float)gt);
        smallf[gt] = expf(s01) - expf(s23) + lam_init; smallf[8 + gt] = 1.0f - lam_init; }
    for (int m = gw; m < MROWS; m += NGW) rms_row_to_bf16(x + (size_t)m * DM, norm_g, Hb + (size_t)m * DM, lane);
}

template <int L>
__device__ __forceinline__ void layer_phases(const Args& args, unsigned char* lds, cg::grid_group& grid, const XcdBarrier& bar, int lo, int hi, int G, int bx, int vcu) {
    constexpr int pb = 1 + 5 * L;
    LAS unsigned char* ldsl = (LAS unsigned char*)lds;
#ifdef MK_CLK
    if (L == 0 && blockIdx.x == 0 && threadIdx.x == 0) { unsigned long long* ts = WSP(unsigned long long, WS_SMALL + 64); ts[10] = __builtin_amdgcn_s_memtime(); ts[11] = __builtin_amdgcn_s_memrealtime(); }
#endif
    if (IN(pb)) {
        pg8::Gemm g{WSP(bf16, WS_H), WSP(bf16, WS_WIN) + (size_t)L * NINP * DM, MROWS, NINP, DM}; pg8::StaticOrder S; S.init(MROWS, NINP, G, bx);
        pg8::EpiInProj E{WSP(bf16, WS_QKV), WSP(bf16, WS_CQ), WSP(bf16, WS_CKV), WSP(bf16, WS_KR), WSP(bf16, WS_GATE), WSP(float, WS_ROPEC), WSP(float, WS_ROPES), WSP(float, WS_CTL + CTL_SSQ + (size_t)(2 * L) * 65536), WSP(float, WS_CTL + CTL_SSQ + (size_t)(2 * L + 1) * 65536)};
        for (int rep_ = 0; rep_ < MK_REP_G1; ++rep_)
        pg8::gemm_phase<pg8::EpiInProj, pg8::StaticOrder, true, true>(ldsl + RING_OFF, g, S, E);
    }
#ifdef MK_CLK
    if (L == 0 && blockIdx.x == 0 && threadIdx.x == 0) { unsigned long long* ts = WSP(unsigned long long, WS_SMALL + 64); ts[12] = __builtin_amdgcn_s_memtime(); ts[13] = __builtin_amdgcn_s_memrealtime(); }
#endif
    SEAM(pb);
    if (IN(pb + 1)) for (int rep_ = 0; rep_ < MK_REP_G23; ++rep_) {
        { pg8::Gemm g{WSP(bf16, WS_CQ), WSP(bf16, WS_WQB) + (size_t)L * NQB * QLORA, MROWS, NQB, QLORA}; pg8::StaticOrder S; S.init(MROWS, NQB, G, bx);
          pg8::EpiRowScale<true> E{WSP(bf16, WS_QM), NQB, WSP(float, WS_CTL + CTL_SSQ + (size_t)(2 * L) * 65536), 1.0f / QLORA, WSP(float, WS_ROPEC), WSP(float, WS_ROPES), 0.07216878364870323f * LOG2E};
#ifndef NO_G2
          pg8::gemm_phase<pg8::EpiRowScale<true>, pg8::StaticOrder, true, true>(ldsl + RING_OFF, g, S, E);
#endif
        }
        { pg8::Gemm g{WSP(bf16, WS_CKV), WSP(bf16, WS_WKVB) + (size_t)L * NKVB * KVLORA, MROWS, NKVB, KVLORA}; pg8::KvOrder S; S.init(MROWS, NKVB, G, bx);
          pg8::EpiRowScale<false> E{WSP(bf16, WS_KVM), NKVB, WSP(float, WS_CTL + CTL_SSQ + (size_t)(2 * L + 1) * 65536), 1.0f / KVLORA, nullptr, nullptr, 1.0f};
#ifndef NO_G3
          pg8::gemm_phase<pg8::EpiRowScale<false>, pg8::KvOrder, true, true>(ldsl + RING_OFF, g, S, E);
#endif
        }
    }
    SEAM(pb + 1);
#ifdef MK_CLK
    if (L == 0 && blockIdx.x == 0 && threadIdx.x == 0) { unsigned long long* ts = WSP(unsigned long long, WS_SMALL + 64); ts[2] = __builtin_amdgcn_s_memtime(); ts[3] = __builtin_amdgcn_s_memrealtime(); }
#endif
    if (IN(pb + 2)) {
        const float* smallf = WSP(float, WS_SMALL);
        att::AttnArgs A{WSP(void, WS_CTL + 524288), WSP(bf16, WS_QKV), WSP(bf16, WS_QM), WSP(bf16, WS_KVM), WSP(bf16, WS_KR), WSP(bf16, WS_GATE), WSP(bf16, WS_Y), WSP(float, WS_SMALL + SM_BIAS), args.in[4] + L * 128, smallf[L], smallf[8 + L]};
        for (int p = vcu; p < 256; p += G) {
            const int bh = p >> 3, s = p & 7, b = bh >> 3, h = bh & 7;
            for (int pass_ = 0; pass_ < 2; ++pass_) {
                const bool mla_ = ((pass_ == 0) == ((s & 1) == 0)) || !MK_ATT_MIX;
                if (MK_ATT_MIX ? mla_ : pass_ == 0) { for (int i = 0; i < 2; ++i) att::attn_unit<false>(A, b, h, i == 0 ? 15 - s : s, lds + RING_OFF); }
                else { for (int i = 0; i < 4; ++i) att::attn_unit<true>(A, b, h, i == 0 ? 31 - 2 * s : i == 1 ? 30 - 2 * s : i == 2 ? 2 * s + 1 : 2 * s, lds + RING_OFF); }
            }
#if MK_ATT_PROBE
#ifndef MK_ATT_PROBE_KIND
#define MK_ATT_PROBE_KIND 3
#endif
            if (MK_ATT_PROBE_KIND & 1) for (int i = 0; i < 2; ++i) att::attn_unit<false, MK_ATT_PROBE>(A, b, h, i == 0 ? 15 - s : s, lds + RING_OFF);
            if (MK_ATT_PROBE_KIND & 2) for (int i = 0; i < 4; ++i) att::attn_unit<true, MK_ATT_PROBE>(A, b, h, i == 0 ? 31 - 2 * s : i == 1 ? 30 - 2 * s : i == 2 ? 2 * s + 1 : 2 * s, lds + RING_OFF);
#endif
        }
    }
#ifdef MK_CLK
    if (L == 0 && blockIdx.x == 0 && threadIdx.x == 0) { unsigned long long* ts = WSP(unsigned long long, WS_SMALL + 64); ts[4] = __builtin_amdgcn_s_memtime(); ts[5] = __builtin_amdgcn_s_memrealtime(); }
#endif
    SEAM(pb + 2);
    if (IN(pb + 3)) {
        pg8::Gemm g{WSP(bf16, WS_Y), WSP(bf16, WS_WOUT) + (size_t)L * DM * DM, MROWS, DM, DM}; pg8::StaticOrder S; S.init(MROWS, DM, G, bx);
        pg8::EpiResF32 E{L == 0 ? args.in[0] : (const float*)args.out, args.out, DM};
        for (int rep_ = 0; rep_ < (L == 0 ? MK_REP_G4 : 1); ++rep_)
        pg8::gemm_phase<pg8::EpiResF32, pg8::StaticOrder, true, true>(ldsl + RING_OFF, g, S, E);
    }
    SEAM(pb + 3);
    if (IN(pb + 4)) {
        int tid_ = threadIdx.x; asm volatile("" : "+v"(tid_));
        const int lane = tid_ & 63, wave = __builtin_amdgcn_readfirstlane(tid_ >> 6); const int gw = vcu * NWAVES + wave, NGW = G * NWAVES;
        if (L == 0) { const float* X1 = args.out; bf16* Hb = WSP(bf16, WS_H); const float* g = args.in[1] + DM;
            for (int rep_ = 0; rep_ < MK_REP_NORM; ++rep_) for (int m = gw; m < MROWS; m += NGW) rms_row_to_bf16(X1 + (size_t)m * DM, g, Hb + (size_t)m * DM, lane); }
        else { const float* g = args.in[11]; float* out = args.out;
            for (int m = gw; m < MROWS; m += NGW) rms_row_f32(out + (size_t)m * DM, g, out + (size_t)m * DM, lane); }
    }
    SEAM(pb + 4);
}

__global__ void __launch_bounds__(NWAVES * 64, 2) mk_fwd(Args args) {
    extern __shared__ __attribute__((aligned(16))) unsigned char lds[];
    cg::grid_group grid = cg::this_grid();
    const int G = gridDim.x; const int bx = blockIdx.x; const int vcu = (G % 8 == 0) ? (bx % 8) * (G / 8) + bx / 8 : bx;
    const int lo = args.ph_lo, hi = args.ph_hi;
    volatile LAS unsigned* MISC = (volatile LAS unsigned*)((LAS unsigned char*)lds + MISC_OFF);
    if (threadIdx.x < 32) MISC[threadIdx.x] = 0u;
    __syncthreads();
    const XcdBarrier bar = xcd_barrier_post(WSP(unsigned, WS_CTL) + CW_BAR, MISC + 8);
    STAMP(0);
#ifdef MK_UB
    {
        typedef short ub8 __attribute__((ext_vector_type(8))); typedef float uf16 __attribute__((ext_vector_type(16))); typedef short us4 __attribute__((ext_vector_type(4)));
        LAS unsigned char* lb_ = (LAS unsigned char*)lds + (threadIdx.x & 63) * 16 + (threadIdx.x >> 6) * 8192;
        ub8 a_, b_; for (int i = 0; i < 8; ++i) { a_[i] = (short)(0x3c00 + threadIdx.x + i); b_[i] = (short)(0x3a00 + i); }
        for (int i = 0; i < 8; ++i) *(LAS ub8*)(lb_ + i * 1024) = a_;
        __syncthreads();
        uf16 acc_; for (int i = 0; i < 16; ++i) acc_[i] = 0.f;
        float x_[12]; for (int i = 0; i < 12; ++i) x_[i] = 0.001f * (float)(threadIdx.x + i);
        ub8 nx_ = *(LAS const ub8*)(lb_);
        for (int it = 0; it < MK_UB_IT; ++it) {
            ub8 cur_ = a_;
            if (MK_UB_LDS == 1) cur_ = *(LAS const ub8*)(lb_ + (it & 7) * 1024);
            if (MK_UB_LDS == 2) { cur_ = nx_; nx_ = *(LAS const ub8*)(lb_ + ((it + 1) & 7) * 1024); }
            if (MK_UB_LDS == 3) { cur_ = nx_; const us4 l_ = __builtin_bit_cast(us4, __builtin_amdgcn_ds_read_tr16_b64_v4i16((LAS us4*)(lb_ - (threadIdx.x & 63) * 8 + ((it + 1) & 7) * 1024))), h_ = __builtin_bit_cast(us4, __builtin_amdgcn_ds_read_tr16_b64_v4i16((LAS us4*)(lb_ - (threadIdx.x & 63) * 8 + ((it + 1) & 7) * 1024 + 512))); nx_ = (ub8){l_[0], l_[1], l_[2], l_[3], h_[0], h_[1], h_[2], h_[3]}; }
#if MK_UB_ACC == 1
            asm volatile("v_mfma_f32_32x32x16_bf16 %0, %1, %2, %0" : "+a"(acc_) : "v"(cur_), "v"(b_));
#elif MK_UB_ACC == 2
            asm volatile("v_mfma_f32_32x32x16_bf16 %0, %1, %2, %0" : "+v"(acc_) : "v"(cur_), "v"(b_));
#else
            acc_ = __builtin_amdgcn_mfma_f32_32x32x16_bf16(cur_, b_, acc_, 0, 0, 0);
#endif
#pragma unroll
            for (int i = 0; i < MK_UB_N; ++i) { if (MK_UB_EXP) x_[i] = __builtin_amdgcn_exp2f(x_[i]); else x_[i] = fmaf(x_[i], 0.999f, 0.001f); asm volatile("" : "+v"(x_[i])); }
            __builtin_amdgcn_sched_barrier(0);
        }
        float sum_ = acc_[0] + acc_[5]; for (int i = 0; i < 12; ++i) sum_ += x_[i];
        if (sum_ == 123456.789f) args.out[threadIdx.x] = sum_;
        __syncthreads();
    }
#endif
    if (IN(0)) { for (int rep_ = 0; rep_ < MK_REP_P0; ++rep_) prologue_phase(args, lds, G, vcu); }
    SEAM(0);
    layer_phases<0>(args, lds, grid, bar, lo, hi, G, bx, vcu);
    layer_phases<1>(args, lds, grid, bar, lo, hi, G, bx, vcu);
#ifdef MK_TPROF
    xcd_barrier(bar);
    { const unsigned long long* a_ = WSP(unsigned long long, WS_CTL + 524288); const float n_ = (float)a_[3];
      const float qa = floorf((float)a_[MK_TPROF_A] / n_ * (1.0f / MK_TPROF_Q) + 0.5f), qb = floorf((float)a_[MK_TPROF_B] / n_ * (1.0f / MK_TPROF_Q) + 0.5f);
      float* o = args.out; const int gt = blockIdx.x * 512 + threadIdx.x;
      for (int i = gt; i < MROWS * DM; i += gridDim.x * 512) o[i] = (i == 0) ? 16.f * qb : qa; }
#endif
#ifdef MK_CLK
    xcd_barrier(bar);
    { const unsigned long long* ts = WSP(unsigned long long, WS_SMALL + 64);
      const float ca = (float)(ts[4] - ts[2]) / (float)(ts[5] - ts[3]), cg = (float)(ts[12] - ts[10]) / (float)(ts[13] - ts[11]);
      const float qa = floorf(ca + 0.5f), qg = floorf(cg + 0.5f);
      float* o = args.out; const int gt = blockIdx.x * 512 + threadIdx.x;
      for (int i = gt; i < MROWS * DM; i += gridDim.x * 512) o[i] = (i == 0) ? 16.f * qg : qa; }
#endif
#ifdef MK_STAMP
    xcd_barrier(bar);
    { const unsigned long long* ts = WSP(unsigned long long, WS_SMALL + 64);
      float da = 0.f, db = 0.f;
      for (int p = 0; p < N_PHASES; ++p) { const int kind = p == 0 ? 0 : 1 + (p - 1) % 6; const float d = (float)(ts[p + 1] - ts[p]) * 0.01f; if (kind == MK_STAMP_A) da += d; if (kind == MK_STAMP_B) db += d; }
      float* o = args.out; const int gt = blockIdx.x * 512 + threadIdx.x;
      for (int i = gt; i < MROWS * DM; i += gridDim.x * 512) o[i] = (i == 0) ? 16.f * db : da; }
#endif
}
#undef IN
#undef SEAM
#undef WSP

#ifndef MK_PH_MAX
#define MK_PH_MAX N_PHASES
#endif
#ifndef MK_PH_MIN
#define MK_PH_MIN 0
#endif
#ifndef MK_LAUNCH_PER_PHASE
#define MK_LAUNCH_PER_PHASE 0
#endif
__global__ void diag_fill(float* o, int n, float c) { for (int i = blockIdx.x * 256 + threadIdx.x; i < n; i += gridDim.x * 256) o[i] = c; }
#ifdef MK_UBK
__global__ void __launch_bounds__(512, 2) ub_kernel(float* out) {
    typedef short ub8 __attribute__((ext_vector_type(8))); typedef float uf16 __attribute__((ext_vector_type(16)));
    ub8 a_, b_; for (int i = 0; i < 8; ++i) { a_[i] = (short)(0x3c00 + threadIdx.x + i); b_[i] = (short)(0x3a00 + i); }
    uf16 acc_; for (int i = 0; i < 16; ++i) acc_[i] = 0.f;
    float x_[12]; for (int i = 0; i < 12; ++i) x_[i] = 0.001f * (float)(threadIdx.x + i);
    for (int it = 0; it < MK_UBK_IT; ++it) {
#if MK_UBK_ACC == 1
        asm volatile("v_mfma_f32_32x32x16_bf16 %0, %1, %2, %0" : "+a"(acc_) : "v"(a_), "v"(b_));
#else
        asm volatile("v_mfma_f32_32x32x16_bf16 %0, %1, %2, %0" : "+v"(acc_) : "v"(a_), "v"(b_));
#endif
#pragma unroll
        for (int i = 0; i < MK_UBK_N; ++i) { x_[i] = fmaf(x_[i], 0.999f, 0.001f); asm volatile("" : "+v"(x_[i])); }
        __builtin_amdgcn_sched_barrier(0);
    }
    float sum_ = acc_[0] + acc_[5]; for (int i = 0; i < 12; ++i) sum_ += x_[i];
    if (sum_ == 123456.789f) out[threadIdx.x] = sum_;
}
#endif
extern "C" void kernel_launch(void* const* d_in, const int* in_sizes, int n_in, void* d_out, int out_size, void* d_ws, size_t ws_size, hipStream_t stream) {
    static int grid = 0;
    if (grid == 0) {
        if (n_in != 12 || in_sizes[0] != MROWS * DM || out_size != MROWS * DM || ws_size < WS_END) {
            fprintf(stderr, "kernel_launch: unexpected shapes: n_in %d in0 %d out %d ws %zu (need >= %zu)\n", n_in, n_in > 0 ? in_sizes[0] : -1, out_size, ws_size, (size_t)WS_END);
            const float code = (n_in != 12) ? 30.f : (in_sizes[0] != MROWS * DM) ? 40.f : (out_size != MROWS * DM) ? 50.f : (float)(ws_size >> 26);
            hipLaunchKernelGGL(diag_fill, dim3(1024), dim3(256), 0, stream, (float*)d_out, out_size, code); return; }
        int dev = 0, cus = 0, per_cu = 0;
        if (hipGetDevice(&dev) != hipSuccess || hipDeviceGetAttribute(&cus, hipDeviceAttributeMultiprocessorCount, dev) != hipSuccess) { fprintf(stderr, "kernel_launch: device query failed\n"); grid = -1; return; }
        if (hipFuncSetAttribute((const void*)mk_fwd, hipFuncAttributeMaxDynamicSharedMemorySize, LDS_BYTES) != hipSuccess) { fprintf(stderr, "kernel_launch: hipFuncSetAttribute failed\n"); grid = -1; return; }
        if (hipOccupancyMaxActiveBlocksPerMultiprocessor(&per_cu, (const void*)mk_fwd, NWAVES * 64, LDS_BYTES) != hipSuccess || per_cu < 1) {
            fprintf(stderr, "kernel_launch: occupancy query reports %d workgroups per CU\n", per_cu); (void)hipGetLastError(); per_cu = 1; }
        grid = cus;
        if (grid > 256) grid = 256;
    }
    if (grid < 0) return;
    (void)hipMemsetAsync((char*)d_ws + WS_CTL, 0, CTL_ZERO_BYTES, stream);
#ifdef MK_UBK
    hipLaunchKernelGGL(ub_kernel, dim3(256), dim3(512), 0, stream, (float*)d_ws + (WS_END >> 2) - 4096);
#endif
    Args a{};
    for (int i = 0; i < 12; ++i) a.in[i] = (const float*)d_in[i];
    a.out = (float*)d_out; a.ws = (unsigned char*)d_ws;
#if MK_LAUNCH_PER_PHASE
    for (int p = MK_PH_MIN; p < MK_PH_MAX; ++p) { a.ph_lo = p; a.ph_hi = p + 1; hipLaunchKernelGGL(mk_fwd, dim3(grid), dim3(NWAVES * 64), LDS_BYTES, stream, a); }
    { const hipError_t le = hipPeekAtLastError(); if (le != hipSuccess) fprintf(stderr, "kernel_launch: launch failed: %s\n", hipGetErrorName(le)); }
#else
    a.ph_lo = 0; a.ph_hi = N_PHASES;
    void* kargs[] = {&a};
    const hipError_t e = hipLaunchCooperativeKernel((const void*)mk_fwd, dim3(grid), dim3(NWAVES * 64), kargs, LDS_BYTES, stream);
    if (e != hipSuccess) fprintf(stderr, "kernel_launch: cooperative launch failed: %s (grid %d)\n", hipGetErrorString(e), grid);
#endif
}
```

```cpp
#include <hip/hip_runtime.h>
#include <hip/hip_cooperative_groups.h>
#include <cstdio>
#include <cstdint>
namespace cg = cooperative_groups;

constexpr int BATCH = 4, SEQ = 4096, DM = 2048, MROWS = BATCH * SEQ, DEPTH = 2;
constexpr int NIN = 5952, NINP = 6144;
constexpr int QLORA = 512, KVLORA = 256, NQB = 1536, NKVB = 2048;
constexpr float EPS = 1e-6f;
constexpr float LOG2E = 1.4426950408889634f;
namespace pg8 {
#define PG8_LAS __attribute__((address_space(3)))
typedef unsigned short bf16_t;
typedef short bf16x8 __attribute__((ext_vector_type(8)));
typedef float f32x4 __attribute__((ext_vector_type(4)));
typedef unsigned u32x4 __attribute__((ext_vector_type(4)));
constexpr int BM = 256, BK = 64, HALF = 128, HTB = HALF * BK * 2  , STAGE_BYTES = 8 * HTB, NXCD = 8, WGM = 8;

__host__ __device__ __forceinline__ int lds_byte(int r, int c) { const int st = (r >> 4) * 2 + (c >> 5), rr = r & 15, cc = c & 31, ob = rr * 64 + cc * 2; return st * 1024 + (ob ^ (((ob >> 9) & 1) << 5)); }
__host__ __device__ __forceinline__ void stage_rc(int b, int& R, int& C) { const int st = b / 1024, sb = b % 1024, swz = sb ^ (((sb >> 9) & 1) << 5); R = (st >> 1) * 16 + swz / 64; C = (st & 1) * 32 + (swz % 64) / 2; }
__host__ __device__ __forceinline__ int perm32(int rho) { const int n = rho >> 4, i = rho & 15; return 8 * (i >> 2) + 4 * n + (i & 3); }

struct Unit { int pm, pn; };
struct Gemm { const bf16_t* A; const bf16_t* Bt; int M, N, K; };

struct StaticOrder {
    int nM, nN, nwg, G, c;
    __host__ __device__ void init(int M, int N, int G_, int c_) { nM = M / BM; nN = N / BM; nwg = nM * nN; G = G_; c = c_; }
    __host__ __device__ bool next(int i, Unit& u) const {
        const long L = (long)i * G + c; if (L >= nwg) return false;
        int wgid = (int)L; { const int q = nwg / NXCD, r = nwg % NXCD, xcd = wgid % NXCD, off = wgid / NXCD; wgid = (xcd < r ? xcd * (q + 1) : r * (q + 1) + (xcd - r) * q) + off; }
        const int nig = WGM * nN, gid = wgid / nig, fm = gid * WGM, gsz = (nM - fm) < WGM ? (nM - fm) : WGM;
        u.pm = fm + ((wgid % nig) % gsz); u.pn = (wgid % nig) / gsz; return true;
    }
    __device__ __forceinline__ void a_ready(const Unit&) const {}
    __device__ __forceinline__ void done(const Unit&) const {}
};

__device__ __forceinline__ unsigned cvt_pk_bf16(float lo, float hi) { unsigned r; asm volatile("v_cvt_pk_bf16_f32 %0, %1, %2" : "=v"(r) : "v"(lo), "v"(hi)); return r; }
typedef float f32x2 __attribute__((ext_vector_type(2)));
struct EpiInProj {
    static constexpr bool PERM = true, AFTER_DRAIN = false;
    bf16_t *QKV, *CQ, *CKV, *KR, *GATE; const float* ropec; const float* ropes; float* ssq_q; float* ssq_kv;
    __device__ __forceinline__ void operator()(const f32x4 (&acc)[2][2][4][2], const Unit& u, int wr, int wc, int fr, int fq) const {
        const int row0 = u.pm * BM + wr * 64 + fr; const int pn = u.pn;
        if (pn == 15) {
            if (wc < 2) {
                const int a = wc * 4 + fq;
#pragma unroll
                for (int ai = 0; ai < 2; ++ai)
#pragma unroll
                    for (int m = 0; m < 4; ++m) { const int row = row0 + ai * HALF + m * 16, s = row & (SEQ - 1);
                        const f32x4 c = *(const f32x4*)(ropec + s * 32 + 4 * a), sn = *(const f32x4*)(ropes + s * 32 + 4 * a);
                        const f32x4 x1 = acc[ai][0][m][0], x2 = acc[ai][0][m][1];
                        const f32x4 y1 = x1 * c - x2 * sn, y2 = x1 * sn + x2 * c;
                        u32x4 w; w.x = cvt_pk_bf16(y1[0], y1[1]); w.y = cvt_pk_bf16(y1[2], y1[3]); w.z = cvt_pk_bf16(y2[0], y2[1]); w.w = cvt_pk_bf16(y2[2], y2[3]);
                        *(u32x4*)(KR + (size_t)row * 64 + 8 * a) = w; }
            }
            return;
        }
        bf16_t* base; int ldc, colt;
        if (pn < 12) { base = QKV; ldc = 3072; colt = pn * 256; }
        else if (pn < 14) { base = CQ; ldc = 512; colt = (pn - 12) * 256; }
        else if (pn == 14) { base = CKV; ldc = 256; colt = 0; }
        else { base = GATE; ldc = 2048; colt = (pn - 16) * 256; }
        const int col0 = colt + wc * 32 + 8 * fq;
        const float sc = (pn < 4) ? 0.125f * 1.4426950408889634f : 1.0f;
#pragma unroll
        for (int ai = 0; ai < 2; ++ai)
#pragma unroll
            for (int m = 0; m < 4; ++m) { bf16_t* rowp = base + (size_t)(row0 + ai * HALF + m * 16) * ldc + col0;
#pragma unroll
                for (int bj = 0; bj < 2; ++bj) { const f32x4 v0 = acc[ai][bj][m][0] * sc, v1 = acc[ai][bj][m][1] * sc;
                    u32x4 w; w.x = cvt_pk_bf16(v0[0], v0[1]); w.y = cvt_pk_bf16(v0[2], v0[3]); w.z = cvt_pk_bf16(v1[0], v1[1]); w.w = cvt_pk_bf16(v1[2], v1[3]);
                    *(u32x4*)(rowp + bj * HALF) = w; } }
        if (pn >= 12 && pn <= 14) {
            float* ssq = (pn == 14) ? ssq_kv : ssq_q;
#pragma unroll
            for (int ai = 0; ai < 2; ++ai)
#pragma unroll
                for (int m = 0; m < 4; ++m) { float s = 0.f;
#pragma unroll
                    for (int bj = 0; bj < 2; ++bj)
#pragma unroll
                        for (int n = 0; n < 2; ++n) { const f32x4 v = acc[ai][bj][m][n]; s += (v[0] * v[0] + v[1] * v[1]) + (v[2] * v[2] + v[3] * v[3]); }
                    s += __shfl_xor(s, 16); s += __shfl_xor(s, 32);
                    if (fq == 0) __hip_atomic_fetch_add(ssq + row0 + ai * HALF + m * 16, s, __ATOMIC_RELAXED, __HIP_MEMORY_SCOPE_AGENT); }
        }
    }
};
template <bool ROPE> struct EpiRowScale {
    static constexpr bool PERM = true, AFTER_DRAIN = false;
    bf16_t* O; int ldc; const float* ssq; float inv_n; const float* ropec; const float* ropes; float qscale;
    __device__ __forceinline__ void operator()(const f32x4 (&acc)[2][2][4][2], const Unit& u, int wr, int wc, int fr, int fq) const {
        const int row0 = u.pm * BM + wr * 64 + fr; const int col0 = u.pn * BM + wc * 32 + 8 * fq;
        bool isr[2]; int ra[2];
#pragma unroll
        for (int bj = 0; bj < 2; ++bj) { const int c0 = col0 + bj * HALF, off = c0 % 192; isr[bj] = ROPE && (off >= 128); ra[bj] = (off - 128) >> 3; }
#pragma unroll
        for (int ai = 0; ai < 2; ++ai)
#pragma unroll
            for (int m = 0; m < 4; ++m) { const int row = row0 + ai * HALF + m * 16, s = row & (SEQ - 1); const float r = qscale / sqrtf(ssq[row] * inv_n + 1e-6f);
                bf16_t* rowp = O + (size_t)row * ldc + col0;
#pragma unroll
                for (int bj = 0; bj < 2; ++bj) { f32x4 v0 = acc[ai][bj][m][0] * r, v1 = acc[ai][bj][m][1] * r;
                    if (ROPE) { if (isr[bj]) { const f32x4 c = *(const f32x4*)(ropec + s * 32 + 4 * ra[bj]), sn = *(const f32x4*)(ropes + s * 32 + 4 * ra[bj]);
                        const f32x4 y1 = v0 * c - v1 * sn, y2 = v0 * sn + v1 * c; v0 = y1; v1 = y2; } }
                    u32x4 w; w.x = cvt_pk_bf16(v0[0], v0[1]); w.y = cvt_pk_bf16(v0[2], v0[3]); w.z = cvt_pk_bf16(v1[0], v1[1]); w.w = cvt_pk_bf16(v1[2], v1[3]);
                    *(u32x4*)(rowp + bj * HALF) = w; } }
    }
};
struct EpiResF32 {
    static constexpr bool PERM = false, AFTER_DRAIN = false;
    const float* base; float* out; int ldc;
    __device__ __forceinline__ void operator()(const f32x4 (&acc)[2][2][4][2], const Unit& u, int wr, int wc, int fr, int fq) const {
        const int row0 = u.pm * BM + wr * 64 + fr, col0 = u.pn * BM + wc * 32 + 4 * fq;
#pragma unroll
        for (int ai = 0; ai < 2; ++ai)
#pragma unroll
            for (int m = 0; m < 4; ++m) { const size_t off = (size_t)(row0 + ai * HALF + m * 16) * ldc + col0;
#pragma unroll
                for (int bj = 0; bj < 2; ++bj)
#pragma unroll
                    for (int n = 0; n < 2; ++n) { const f32x4 bs = *(const f32x4*)(base + off + bj * HALF + n * 16); *(f32x4*)(out + off + bj * HALF + n * 16) = bs + acc[ai][bj][m][n]; } }
    }
};
struct KvOrder : StaticOrder {
    __host__ __device__ bool next(int i, Unit& u) const {
        long L; if (G != 256) { L = (long)i * G + c; if (L >= nwg) return false; }
        else if (c < 128) { if (i > 0) return false; L = c; }
        else { if (i > 2) return false; L = 128 + 3 * (c - 128) + i; }
        int wgid = (int)L; { const int q = nwg / NXCD, r = nwg % NXCD, xcd = wgid % NXCD, off = wgid / NXCD; wgid = (xcd < r ? xcd * (q + 1) : r * (q + 1) + (xcd - r) * q) + off; }
        const int nig = WGM * nN, gid = wgid / nig, fm = gid * WGM, gsz = (nM - fm) < WGM ? (nM - fm) : WGM;
        u.pm = fm + ((wgid % nig) % gsz); u.pn = (wgid % nig) / gsz; return true;
    }
};
template <class Epi, class Sched, bool ALIGN_EPI = false, bool SP2 = false>
__device__ __forceinline__ void gemm_phase(PG8_LAS unsigned char* lds, const Gemm g, const Sched& S, const Epi& E) {
    int tid_ = threadIdx.x; asm volatile("" : "+v"(tid_));
    const int tid = tid_, wid = __builtin_amdgcn_readfirstlane(tid >> 6), lane = tid & 63, wr = wid >> 2, wc = wid & 3, fr = lane & 15, fq = lane >> 4;
    const int K = g.K, nt = K / BK;
    unsigned voffA[2], voffB[2];
#pragma unroll
    for (int i = 0; i < 2; ++i) { int R, C; stage_rc(tid * 16 + i * 8192, R, C); const int Rb = Epi::PERM ? ((R & ~31) + perm32(R & 31)) : R;
        voffA[i] = (unsigned)(R * K + C) * 2u; voffB[i] = (unsigned)(Rb * K + C) * 2u; }
    const size_t kstep = (size_t)(BK * 2);
    const size_t hstep = (size_t)HALF * K * 2;
    const size_t tstep = 2 * hstep;
    const unsigned ldsw = (unsigned)wid * 1024u;
    const int aoff = lds_byte(wr * 64 + fr, fq * 8), boff = lds_byte(wc * 32 + fr, fq * 8);
#define PG8_SA(b, h) (((b) * 2 + (h)) * HTB)
#define PG8_SB(b, h) ((4 + (b) * 2 + (h)) * HTB)
#define PG8_STAGE(bufoff, gbase, voff) do { _Pragma("unroll") for (int _i = 0; _i < 2; ++_i) \
        __builtin_amdgcn_global_load_lds((const unsigned*)((const char*)(gbase) + (voff)[_i]), (PG8_LAS unsigned*)(lds + (bufoff) + ldsw + _i * 8192), 16, 0, 0); } while (0)
#define PG8_LDA(dst, b, h) do { _Pragma("unroll") for (int m = 0; m < 4; ++m) _Pragma("unroll") for (int k = 0; k < 2; ++k) dst[m][k] = *(const PG8_LAS bf16x8*)(lds + PG8_SA(b, h) + aoff + m * 2048 + k * 1024); } while (0)
#define PG8_LDB(dst, b, h) do { _Pragma("unroll") for (int n = 0; n < 2; ++n) _Pragma("unroll") for (int k = 0; k < 2; ++k) dst[n][k] = *(const PG8_LAS bf16x8*)(lds + PG8_SB(b, h) + boff + n * 2048 + k * 1024); } while (0)
#define PG8_MMA(ai, bj, At, Bt) do { __builtin_amdgcn_s_setprio(1); _Pragma("unroll") for (int m = 0; m < 4; ++m) _Pragma("unroll") for (int n = 0; n < 2; ++n) _Pragma("unroll") for (int k = 0; k < 2; ++k) \
        acc[ai][bj][m][n] = __builtin_amdgcn_mfma_f32_16x16x32_bf16(Bt[n][k], At[m][k], acc[ai][bj][m][n], 0, 0, 0); __builtin_amdgcn_s_setprio(0); } while (0)
#define PG8_WAIT_V(n) asm volatile("s_waitcnt vmcnt(" #n ")" ::: "memory")
#define PG8_WAIT_L(n) asm volatile("s_waitcnt lgkmcnt(" #n ")" ::: "memory")
#define PG8_BAR __builtin_amdgcn_s_barrier()
#define PG8_SCHED __builtin_amdgcn_sched_barrier(0)
    Unit cur, nxt; int ui = 0;
    if (!S.next(0, cur)) return;
    f32x4 acc[2][2][4][2];
#pragma unroll
    for (int a = 0; a < 2; ++a)
#pragma unroll
        for (int b = 0; b < 2; ++b)
#pragma unroll
            for (int m = 0; m < 4; ++m)
#pragma unroll
                for (int n = 0; n < 2; ++n) acc[a][b][m][n] = (f32x4){0.f, 0.f, 0.f, 0.f};
    bf16x8 At[4][2], B0[2][2], B1[2][2];
    const char* cA = (const char*)g.A + (size_t)cur.pm * tstep; const char* cB = (const char*)g.Bt + (size_t)cur.pn * tstep;
    S.a_ready(cur);
    if constexpr (SP2) {
        PG8_STAGE(PG8_SB(0, 0), cB, voffB); PG8_STAGE(PG8_SB(0, 1), cB + hstep, voffB); PG8_STAGE(PG8_SA(0, 0), cA, voffA); PG8_STAGE(PG8_SA(0, 1), cA + hstep, voffA);
        if (wr == 1) PG8_BAR;
        PG8_WAIT_V(2); PG8_BAR;
        PG8_STAGE(PG8_SB(1, 0), cB + kstep, voffB); PG8_STAGE(PG8_SA(1, 0), cA + kstep, voffA); PG8_STAGE(PG8_SB(1, 1), cB + hstep + kstep, voffB);
        PG8_WAIT_V(6); PG8_BAR;
    } else {
        PG8_STAGE(PG8_SB(0, 0), cB, voffB); PG8_STAGE(PG8_SA(0, 0), cA, voffA); PG8_STAGE(PG8_SB(0, 1), cB + hstep, voffB); PG8_STAGE(PG8_SA(0, 1), cA + hstep, voffA);
        if (wr == 1) PG8_BAR;
        PG8_WAIT_V(4); PG8_BAR;
        PG8_STAGE(PG8_SB(1, 0), cB + kstep, voffB); PG8_STAGE(PG8_SA(1, 0), cA + kstep, voffA); PG8_STAGE(PG8_SB(1, 1), cB + hstep + kstep, voffB);
        PG8_WAIT_V(6); PG8_BAR;
    }
    for (;;) {
        const bool has_next = S.next(ui + 1, nxt);
        const char* nA = has_next ? (const char*)g.A + (size_t)nxt.pm * tstep : cA; const char* nB = has_next ? (const char*)g.Bt + (size_t)nxt.pn * tstep : cB;
        for (int t = 0; t < nt; t += 2) {
            const bool last = (t == nt - 2);
            const char* a1 = cA + (size_t)(t + 1) * kstep;
            const char* a2 = last ? nA : cA + (size_t)(t + 2) * kstep; const char* b2 = last ? nB : cB + (size_t)(t + 2) * kstep;
            const char* a3 = a2 + kstep; const char* b3 = b2 + kstep;
            if (last && has_next) S.a_ready(nxt);
            if constexpr (SP2) {
            PG8_LDB(B0, 0, 0); PG8_LDB(B1, 0, 1); PG8_SCHED; PG8_LDA(At, 0, 0); PG8_STAGE(PG8_SA(1, 1), a1 + hstep, voffA);
            PG8_WAIT_V(8); PG8_WAIT_L(0); PG8_BAR; PG8_MMA(0, 0, At, B0); PG8_MMA(0, 1, At, B1); PG8_BAR; PG8_SCHED;
            PG8_LDA(At, 0, 1); PG8_STAGE(PG8_SB(0, 0), b2, voffB); PG8_STAGE(PG8_SB(0, 1), b2 + hstep, voffB); PG8_STAGE(PG8_SA(0, 0), a2, voffA);
            PG8_WAIT_V(8); PG8_WAIT_L(0); PG8_BAR; PG8_MMA(1, 0, At, B0); PG8_MMA(1, 1, At, B1); PG8_BAR; PG8_SCHED;
            PG8_LDB(B0, 1, 0); PG8_LDB(B1, 1, 1); PG8_SCHED; PG8_LDA(At, 1, 0); PG8_STAGE(PG8_SA(0, 1), a2 + hstep, voffA);
            PG8_WAIT_V(8); PG8_WAIT_L(0); PG8_BAR; PG8_MMA(0, 0, At, B0); PG8_MMA(0, 1, At, B1); PG8_BAR; PG8_SCHED;
            PG8_LDA(At, 1, 1); PG8_STAGE(PG8_SB(1, 0), b3, voffB); PG8_STAGE(PG8_SB(1, 1), b3 + hstep, voffB); PG8_STAGE(PG8_SA(1, 0), a3, voffA);
            PG8_WAIT_V(8); PG8_WAIT_L(0); PG8_BAR; PG8_MMA(1, 0, At, B0); PG8_MMA(1, 1, At, B1); PG8_BAR; PG8_SCHED;
            } else {
            PG8_LDB(B0, 0, 0); PG8_SCHED; PG8_LDA(At, 0, 0); PG8_STAGE(PG8_SA(1, 1), a1 + hstep, voffA);
            PG8_WAIT_L(8); PG8_BAR; PG8_WAIT_L(0); PG8_MMA(0, 0, At, B0); PG8_BAR; PG8_SCHED;
            PG8_LDB(B1, 0, 1); PG8_STAGE(PG8_SB(0, 0), b2, voffB);
            PG8_BAR; PG8_WAIT_L(0); PG8_MMA(0, 1, At, B1); PG8_BAR;
            PG8_LDA(At, 0, 1); PG8_STAGE(PG8_SA(0, 0), a2, voffA);
            PG8_BAR; PG8_WAIT_L(0); PG8_MMA(1, 0, At, B0); PG8_BAR; PG8_SCHED;
            PG8_STAGE(PG8_SB(0, 1), b2 + hstep, voffB);
            PG8_WAIT_V(6); PG8_BAR; PG8_MMA(1, 1, At, B1); PG8_BAR;
            PG8_LDB(B0, 1, 0); PG8_SCHED; PG8_LDA(At, 1, 0); PG8_STAGE(PG8_SA(0, 1), a2 + hstep, voffA);
            PG8_WAIT_L(8); PG8_BAR; PG8_WAIT_L(0); PG8_MMA(0, 0, At, B0); PG8_BAR; PG8_SCHED;
            PG8_LDB(B1, 1, 1); PG8_STAGE(PG8_SB(1, 0), b3, voffB);
            PG8_BAR; PG8_WAIT_L(0); PG8_MMA(0, 1, At, B1); PG8_BAR;
            PG8_LDA(At, 1, 1); PG8_STAGE(PG8_SA(1, 0), a3, voffA);
            PG8_BAR; PG8_WAIT_L(0); PG8_MMA(1, 0, At, B0); PG8_BAR; PG8_SCHED;
            PG8_STAGE(PG8_SB(1, 1), b3 + hstep, voffB);
            PG8_WAIT_V(6); PG8_BAR; PG8_MMA(1, 1, At, B1); PG8_BAR;
            }
        }
        if constexpr (ALIGN_EPI) { if (wr == 0) PG8_BAR; }
        if constexpr (!Epi::AFTER_DRAIN) { E(acc, cur, wr, wc, fr, fq); S.done(cur); }
        if (!has_next) break;
#pragma unroll
        for (int a = 0; a < 2; ++a)
#pragma unroll
            for (int b = 0; b < 2; ++b)
#pragma unroll
                for (int m = 0; m < 4; ++m)
#pragma unroll
                    for (int n = 0; n < 2; ++n) acc[a][b][m][n] = (f32x4){0.f, 0.f, 0.f, 0.f};
        cur = nxt; cA = nA; cB = nB; ++ui;
        if constexpr (ALIGN_EPI) { if (wr == 1) PG8_BAR; }
    }
    PG8_WAIT_V(0);
    if constexpr (!ALIGN_EPI) { if (wr == 0) PG8_BAR; }
    PG8_BAR;
    if constexpr (Epi::AFTER_DRAIN) { E.fused(acc, cur, wr, wc, fr, fq, lds, wid, lane); S.done(cur); }
#undef PG8_SA
#undef PG8_SB
#undef PG8_STAGE
#undef PG8_LDA
#undef PG8_LDB
#undef PG8_MMA
#undef PG8_WAIT_V
#undef PG8_WAIT_L
#undef PG8_BAR
#undef PG8_SCHED
}
}
#define GAS __attribute__((address_space(1)))
#define LAS __attribute__((address_space(3)))
typedef unsigned short bf16;
typedef unsigned v4u __attribute__((ext_vector_type(4)));
typedef float f32x4 __attribute__((ext_vector_type(4)));
typedef short bf16x8 __attribute__((ext_vector_type(8)));
typedef GAS unsigned gu32;
typedef GAS unsigned long long gu64;
#define RLX_AGENT __ATOMIC_RELAXED, __HIP_MEMORY_SCOPE_AGENT
#define LDS_WAIT() asm volatile("s_waitcnt lgkmcnt(0)" ::: "memory")
#define VM_WAIT() asm volatile("s_waitcnt vmcnt(0)" ::: "memory")
__device__ __forceinline__ unsigned long long rt() { return __builtin_amdgcn_s_memrealtime(); }
__device__ __forceinline__ unsigned f2bf(float f) { unsigned u = __builtin_bit_cast(unsigned, f); return (u + 0x7fffu + ((u >> 16) & 1u)) >> 16; }
__device__ __forceinline__ unsigned pk2(float lo, float hi) { return f2bf(lo) | (f2bf(hi) << 16); }

#define XB_TMO      128
#define XB_XCNT(j)  (256  + 64 * (j))
#define XB_XSUB(j)  (1280 + 64 * (j))
#define XB_XGEN(j)  (2304 + 64 * (j))
#define XB_TOP      3328
#define XB_TOPGEN   3392
#define XCD_BAR_WORDS 3456
#define XB_SPIN_CAP (1u << 18)

__device__ __forceinline__ unsigned xb_ld(unsigned* p)              { return __hip_atomic_load(p, __ATOMIC_RELAXED, __HIP_MEMORY_SCOPE_AGENT); }
__device__ __forceinline__ unsigned xb_add(unsigned* p, unsigned v) { return __hip_atomic_fetch_add(p, v, __ATOMIC_RELAXED, __HIP_MEMORY_SCOPE_AGENT); }
__device__ __forceinline__ unsigned xb_xcc_id() { return (unsigned)__builtin_amdgcn_s_getreg((3 << 11) | 20) & 0xFu; }
#define XB_SPIN(cond, bar) do { unsigned _sp = 0; while (cond) { __builtin_amdgcn_s_sleep(1); \
    if ((++_sp & 255u) == 0u) { if (xb_ld(&(bar)[XB_TMO])) break; if (_sp > XB_SPIN_CAP) { atomicAdd(&(bar)[XB_TMO], 1u); break; } } } } while (0)

struct XcdBarrier {
    unsigned* bar; unsigned x;
    volatile LAS unsigned* st;
};

__device__ __forceinline__ XcdBarrier xcd_barrier_post(unsigned* bar, volatile LAS unsigned* st) {
    XcdBarrier b; b.bar = bar; b.x = xb_xcc_id(); b.st = st;
    if (threadIdx.x == 0) (void)xb_add(&bar[XB_XCNT(b.x)], 1u);
    return b;
}
__device__ __forceinline__ void xcd_barrier_complete(unsigned* bar, unsigned x, unsigned& nloc, unsigned& nx) {
    const unsigned G = gridDim.x * gridDim.y * gridDim.z;
    unsigned sum, cnt, mine, sp = 0u;
    for (;;) {
        sum = 0u; cnt = 0u; mine = 0u;
#pragma unroll
        for (unsigned j = 0; j < 16; ++j) { const unsigned c = xb_ld(&bar[XB_XCNT(j)]); sum += c; cnt += (c > 0u) ? 1u : 0u; mine = (j == x) ? c : mine; }
        if (sum == G) break;
        __builtin_amdgcn_s_sleep(1);
        if ((++sp & 255u) == 0u) { if (xb_ld(&bar[XB_TMO])) break; if (sp > XB_SPIN_CAP) { atomicAdd(&bar[XB_TMO], 1u); break; } }
    }
    nloc = mine > 0u ? mine : 1u; nx = cnt > 0u ? cnt : 1u;
}

__device__ __forceinline__ void xcd_barrier(const XcdBarrier& b) {
    asm volatile("s_waitcnt vmcnt(0)" ::: "memory");
    __syncthreads();
    if (threadIdx.x == 0) {
        unsigned* bar = b.bar;
        __builtin_amdgcn_s_waitcnt(0);
        unsigned nloc = b.st[0], nx = b.st[1];
        if (nloc == 0u) { xcd_barrier_complete(bar, b.x, nloc, nx); b.st[0] = nloc; b.st[1] = nx; }
        const unsigned old = xb_add(&bar[XB_XSUB(b.x)], 1u);
        const unsigned gen = old / nloc;
        if (old + 1u == (gen + 1u) * nloc) {
            __builtin_amdgcn_fence(__ATOMIC_RELEASE, "agent");
            asm volatile("s_waitcnt vmcnt(0)" ::: "memory");
            const unsigned og = xb_add(&bar[XB_TOP], 1u);
            const unsigned tg = og / nx;
            if (og + 1u == (tg + 1u) * nx) xb_add(&bar[XB_TOPGEN], 1u);
            else XB_SPIN(xb_ld(&bar[XB_TOPGEN]) == tg, bar);
            __builtin_amdgcn_fence(__ATOMIC_ACQUIRE, "agent");
            xb_add(&bar[XB_XGEN(b.x)], 1u);
            asm volatile("s_waitcnt vmcnt(0)" ::: "memory");
        } else {
            XB_SPIN(xb_ld(&bar[XB_XGEN(b.x)]) == gen, bar);
            __builtin_amdgcn_fence(__ATOMIC_ACQUIRE, "agent");
            asm volatile("s_waitcnt vmcnt(0)" ::: "memory");
        }
    }
    __syncthreads();
}
namespace att {
typedef unsigned short bf16;
typedef short bf16x8 __attribute__((ext_vector_type(8)));
typedef short s16x4 __attribute__((ext_vector_type(4)));
typedef short v4i16_t __attribute__((ext_vector_type(4)));
typedef float f32x16 __attribute__((ext_vector_type(16)));
typedef unsigned u32x4 __attribute__((ext_vector_type(4)));
typedef float f32x2_t __attribute__((ext_vector_type(2)));
typedef __bf16 bf16x2_t __attribute__((ext_vector_type(2)));
#define ALDS __attribute__((address_space(3)))
#define ASBAR() __builtin_amdgcn_sched_barrier(0)
constexpr int WS_OFF = 135168;
constexpr int TAB_OFF = WS_OFF + 2048;
constexpr int QR_OFF = 81920;
constexpr int NQL = 6;
constexpr int ATT_LDS_BYTES = TAB_OFF + 2048;
static_assert(QR_OFF + 8 * NQL * 1024 <= WS_OFF, "MLA query park fits below the scratch");
#ifndef ATT_STAGGER
#define ATT_STAGGER 0
#endif
constexpr float THR2 = 8.0f;
__device__ __forceinline__ int crow(int r, int hi) { return (r & 3) + 8 * (r >> 2) + 4 * hi; }
__device__ __forceinline__ void glds16(const void* gsrc, unsigned lds_dst) { unsigned keep;
    asm volatile("s_mov_b32 %0, m0\n\ts_mov_b32 m0, %2\n\ts_nop 0\n\tglobal_load_lds_dwordx4 %1, off\n\ts_mov_b32 m0, %0" : "=&s"(keep) : "v"(gsrc), "s"(lds_dst) : "memory"); }
template <int IMM> __device__ __forceinline__ void glds16s(const void* sbase, unsigned voff, unsigned lds_dst_) { unsigned keep; const unsigned lds_dst = lds_dst_ - (unsigned)IMM;
    asm volatile("s_mov_b32 %0, m0\n\ts_mov_b32 m0, %3\n\ts_nop 3\n\tglobal_load_lds_dwordx4 %1, %2 offset:%c4\n\ts_mov_b32 m0, %0" : "=&s"(keep) : "v"(voff), "s"(sbase), "s"(lds_dst), "i"(IMM) : "memory"); }
__device__ __forceinline__ const unsigned char* uni_ptr(const void* p) { const unsigned long long v = (unsigned long long)p;
    const unsigned lo = __builtin_amdgcn_readfirstlane((unsigned)v), hi = __builtin_amdgcn_readfirstlane((unsigned)(v >> 32)); return (const unsigned char*)(((unsigned long long)hi << 32) | lo); }
__device__ __forceinline__ unsigned cvtpk_s(float lo, float hi) { f32x2_t v = {lo, hi}; bf16x2_t b = __builtin_convertvector(v, bf16x2_t); return __builtin_bit_cast(unsigned, b); }
__device__ __forceinline__ float swapmax(float v) { auto rr = __builtin_amdgcn_permlane32_swap(__float_as_uint(v), __float_as_uint(v), false, false); return fmaxf(__uint_as_float(rr[0]), __uint_as_float(rr[1])); }
__device__ __forceinline__ float swapsum(float v) { auto rr = __builtin_amdgcn_permlane32_swap(__float_as_uint(v), __float_as_uint(v), false, false); return __uint_as_float(rr[0]) + __uint_as_float(rr[1]); }
#define ATT_WAIT_BAR() asm volatile("s_waitcnt vmcnt(0) lgkmcnt(0)\n\ts_barrier" ::: "memory")
#define ATT_WAIT_BAR_N(N) asm volatile("s_waitcnt vmcnt(" #N ") lgkmcnt(0)\n\ts_barrier" ::: "memory")

__device__ __forceinline__ s16x4 vtr(ALDS const unsigned char* p) { return __builtin_bit_cast(s16x4, __builtin_amdgcn_ds_read_tr16_b64_v4i16((ALDS v4i16_t*)p)); }

struct AttnArgs { void* prof; const bf16* QKV; const bf16* QM; const bf16* KVM; const bf16* KR; const bf16* GATE; bf16* Y; const float* biastab; const float* subg; float lam; float oml; };

__device__ __forceinline__ void pv4(f32x16* o, int vb, bf16x8 pa0, bf16x8 pa1, bf16x8 pa2, bf16x8 pa3) {
#pragma unroll
    for (int d0 = 0; d0 < 4; ++d0) { s16x4 lo[4], hh[4];
#pragma unroll
        for (int ks = 0; ks < 4; ++ks) {
            asm volatile("ds_read_b64_tr_b16 %0, %1 offset:%c2" : "=&v"(lo[ks]) : "v"(vb), "i"(d0 * 4096 + ks * 1024) : "memory");
            asm volatile("ds_read_b64_tr_b16 %0, %1 offset:%c2" : "=&v"(hh[ks]) : "v"(vb), "i"(d0 * 4096 + ks * 1024 + 512) : "memory"); }
        asm volatile("s_waitcnt lgkmcnt(0)" ::: "memory"); ASBAR();
#define ATT_PK(k) (bf16x8){lo[k][0], lo[k][1], lo[k][2], lo[k][3], hh[k][0], hh[k][1], hh[k][2], hh[k][3]}
        o[d0] = __builtin_amdgcn_mfma_f32_32x32x16_bf16(pa0, ATT_PK(0), o[d0], 0, 0, 0);
        o[d0] = __builtin_amdgcn_mfma_f32_32x32x16_bf16(pa1, ATT_PK(1), o[d0], 0, 0, 0);
        o[d0] = __builtin_amdgcn_mfma_f32_32x32x16_bf16(pa2, ATT_PK(2), o[d0], 0, 0, 0);
        o[d0] = __builtin_amdgcn_mfma_f32_32x32x16_bf16(pa3, ATT_PK(3), o[d0], 0, 0, 0);
#undef ATT_PK
    }
}

template <bool DIFF, int MODE = 0>
__device__ __forceinline__ void attn_unit(const AttnArgs& A, int b, int h, int qb, unsigned char* shm) {
    constexpr int ND0 = DIFF ? 4 : 12;
    constexpr int QROWS = DIFF ? 128 : 256;
    constexpr int KSLOT = DIFF ? 16384 : 24576;
    constexpr int LEAD = DIFF ? 2 : 1;
    constexpr int NSLOT = LEAD + 1;
    constexpr int V_OFF = NSLOT * KSLOT;
    int tid_ = threadIdx.x; asm volatile("" : "+v"(tid_));
    const int tid = tid_, lane = tid & 63, r32 = lane & 31, hi = lane >> 5; const int wid = __builtin_amdgcn_readfirstlane(tid >> 6);
    const int map = DIFF ? (wid >> 2) : 0, wrow = DIFF ? (wid & 3) : wid;
    const int q0 = qb * QROWS + wrow * 32;
    const int cw = q0 >> 6;
    const int NT = (qb * QROWS + QROWS) >> 6;
    const long rowbase = (long)b * SEQ;
    const unsigned lds0 = (unsigned)(uintptr_t)shm;
    ALDS unsigned char* shm3 = (ALDS unsigned char*)shm;
    ALDS float* wsf = (ALDS float*)(shm3 + WS_OFF) + wid * 64;
    ALDS float* tabl = (ALDS float*)(shm3 + TAB_OFF) + map * 256;
    const int vrow = 16 * (wid & 3) + (lane >> 2), vcol = (wid >> 2) * 32 + (lane & 3) * 8;
    constexpr int PITCHB = DIFF ? 6144 : 4096;
    const int krow = 8 * wid + (lane >> 3), kchk = (lane & 7) ^ ((krow >> 1) & 7);
    const unsigned voffK = (unsigned)(krow * PITCHB + kchk * 16), voffV = (unsigned)(vrow * PITCHB + vcol * 2), voffR = (unsigned)(krow * 128 + kchk * 16);
    const unsigned char* kvbase = DIFF ? (const unsigned char*)(A.QKV + rowbase * 3072 + 1024 + h * 128) : (const unsigned char*)(A.KVM + rowbase * 2048 + h * 256);
    const unsigned char* krbase = (const unsigned char*)(A.KR + rowbase * 64);
    const unsigned kd0 = lds0 + wid * 1024, vd0 = lds0 + V_OFF + wid * 1024;
    constexpr int VIMM = DIFF ? 2048 : 256;
#define ATT_DMA_K(t, sl) do { const long _t = (t); const unsigned _so = (unsigned)((sl) * KSLOT); const unsigned char* _b = uni_ptr(kvbase + _t * (64L * PITCHB)); \
        glds16s<0>(_b, voffK, (unsigned)__builtin_amdgcn_readfirstlane(kd0 + _so)); \
        glds16s<128>(_b, voffK, (unsigned)__builtin_amdgcn_readfirstlane(kd0 + 8192 + _so)); \
        if (!DIFF) glds16s<0>(uni_ptr(krbase + _t * (64L * 128)), voffR, (unsigned)__builtin_amdgcn_readfirstlane(kd0 + 16384 + _so)); } while (0)
#define ATT_DMA_V(t, sl) do { const long _t = (t); const unsigned _so = (unsigned)((sl) * 16384); const unsigned char* _b = uni_ptr(kvbase + _t * (64L * PITCHB)); \
        glds16s<VIMM>(_b, voffV, (unsigned)__builtin_amdgcn_readfirstlane(vd0 + _so)); \
        glds16s<VIMM + 128>(_b, voffV, (unsigned)__builtin_amdgcn_readfirstlane(vd0 + 8192 + _so)); } while (0)
    if (MODE < 2) { ATT_DMA_K(0, 0); if (LEAD == 2) { if (1 < NT) ATT_DMA_K(1, 1); ATT_DMA_V(0, 0); } }
    if (DIFF) { ((ALDS float*)(shm3 + TAB_OFF))[tid] = A.biastab[(h * 2 + (tid >> 8)) * 256 + (tid & 255)]; }
    constexpr int NQREG = DIFF ? ND0 : ND0 - NQL;
    bf16x8 qr[NQREG];
    ALDS unsigned char* qlds = shm3 + QR_OFF + wid * (NQL * 1024) + lane * 16;
    { const bf16* Qw = DIFF ? A.QKV + (rowbase + q0 + r32) * 3072 + h * 128 + map * 64 + hi * 8 : A.QM + (rowbase + q0 + r32) * 1536 + h * 192 + hi * 8;
#pragma unroll
      for (int d0 = 0; d0 < NQREG; ++d0) qr[d0] = *reinterpret_cast<const bf16x8*>(Qw + d0 * 16);
      if (!DIFF) {
#pragma unroll
          for (int d0 = NQREG; d0 < ND0; ++d0) *(ALDS bf16x8*)(qlds + (d0 - NQREG) * 1024) = *reinterpret_cast<const bf16x8*>(Qw + d0 * 16); } }
    float boff = 0.f; if (DIFF) boff = A.biastab[(h * 2 + map) * 256];
    float m_ref = 0.f, l_reg = 0.f; f32x16 o[4];
#pragma unroll
    for (int d = 0; d < 4; ++d) o[d] = f32x16{};
    const int kfo = (DIFF ? map * 8192 : 0) + r32 * 128;
    int ko[4];
#pragma unroll
    for (int i = 0; i < 4; ++i) ko[i] = 16 * ((2 * i + hi) ^ ((r32 >> 1) & 7));
    const int vbo = V_OFF + ((lane >> 4) & 1) * 32 + (lane & 3) * 8 + (4 * hi + ((lane & 15) >> 2)) * 64;
    f32x16 pA0, pA1, pB0, pB1; float alA = 1.f, alB = 1.f, alS = 1.f; (void)alA; (void)alB;
    u32x4 pw0, pw1, pw2, pw3;
    s16x4 vAl[4], vAh[4], vBl[4], vBh[4]; bf16x8 kf[8]; f32x16 negm; float negv = 3e38f;
#pragma unroll
    for (int r = 0; r < 16; ++r) negm[r] = 0.f;
#define ATT_MF(acc, a, b) acc = __builtin_amdgcn_mfma_f32_32x32x16_bf16(a, b, acc, 0, 0, 0)
#define ATT_QK(P0, P1, T) do { ALDS const unsigned char* kp_ = shm3 + sj * KSLOT + kfo; \
        const float nb_ = ((DIFF && ((T) + 2 < cw)) ? boff : 0.f) - m_ref; \
        if (__all(nb_ == 0.f)) { const f32x16 z16_ = f32x16{};     \
            const bf16x8 b0_ = *(ALDS const bf16x8*)(kp_ + ko[0]); const bf16x8 b1_ = *(ALDS const bf16x8*)(kp_ + ko[0] + 4096); const bf16x8 q_ = qr[0]; \
            P0 = __builtin_amdgcn_mfma_f32_32x32x16_bf16(b0_, q_, z16_, 0, 0, 0); P1 = __builtin_amdgcn_mfma_f32_32x32x16_bf16(b1_, q_, z16_, 0, 0, 0); } \
        else { _Pragma("unroll") for (int r = 0; r < 16; ++r) { P0[r] = nb_; P1[r] = nb_; } \
            const bf16x8 b0_ = *(ALDS const bf16x8*)(kp_ + ko[0]); const bf16x8 b1_ = *(ALDS const bf16x8*)(kp_ + ko[0] + 4096); const bf16x8 q_ = qr[0]; \
            ATT_MF(P0, b0_, q_); ATT_MF(P1, b1_, q_); } \
        _Pragma("unroll") for (int d0 = 1; d0 < ND0; ++d0) { \
            const bf16x8 b0_ = *(ALDS const bf16x8*)(kp_ + (d0 >> 2) * 8192 + ko[d0 & 3]); const bf16x8 b1_ = *(ALDS const bf16x8*)(kp_ + (d0 >> 2) * 8192 + ko[d0 & 3] + 4096); \
            bf16x8 q_; if (d0 < NQREG) q_ = qr[d0 < NQREG ? d0 : 0]; else q_ = *(ALDS const bf16x8*)(qlds + (d0 - NQREG) * 1024); \
            ATT_MF(P0, b0_, q_); ATT_MF(P1, b1_, q_); } } while (0)
#define ATT_FIN(P0, P1, AL) do { float ps_;   \
        { float s0_ = P0[0] + P1[0], s1_ = P0[1] + P1[1], s2_ = P0[2] + P1[2], s3_ = P0[3] + P1[3]; \
          _Pragma("unroll") for (int r = 4; r < 16; r += 4) { s0_ += P0[r] + P1[r]; s1_ += P0[r + 1] + P1[r + 1]; s2_ += P0[r + 2] + P1[r + 2]; s3_ += P0[r + 3] + P1[r + 3]; } \
          ps_ = (s0_ + s1_) + (s2_ + s3_); } \
        l_reg += ps_; psum_ = ps_; \
        pw0 = (u32x4){cvtpk_s(P0[0], P0[1]), cvtpk_s(P0[2], P0[3]), cvtpk_s(P0[4], P0[5]), cvtpk_s(P0[6], P0[7])}; \
        pw1 = (u32x4){cvtpk_s(P0[8], P0[9]), cvtpk_s(P0[10], P0[11]), cvtpk_s(P0[12], P0[13]), cvtpk_s(P0[14], P0[15])}; \
        pw2 = (u32x4){cvtpk_s(P1[0], P1[1]), cvtpk_s(P1[2], P1[3]), cvtpk_s(P1[4], P1[5]), cvtpk_s(P1[6], P1[7])}; \
        pw3 = (u32x4){cvtpk_s(P1[8], P1[9]), cvtpk_s(P1[10], P1[11]), cvtpk_s(P1[12], P1[13]), cvtpk_s(P1[14], P1[15])}; } while (0)
#define ATT_VRD(VL, VH, d0) do { if (MODE == 5) break; _Pragma("unroll") for (int ks = 0; ks < 4; ++ks) { VL[ks] = vtr(vp_ + (d0) * 4096 + ks * 1024); VH[ks] = vtr(vp_ + (d0) * 4096 + ks * 1024 + 512); } } while (0)
#define ATT_VF(VL, VH, k) (bf16x8){VL[k][0], VL[k][1], VL[k][2], VL[k][3], VH[k][0], VH[k][1], VH[k][2], VH[k][3]}
#define ATT_MF4(od, VL, VH) do { if (MODE == 6 || MODE == 8) break; ATT_MF(od, __builtin_bit_cast(bf16x8, pw0), ATT_VF(VL, VH, 0)); ATT_MF(od, __builtin_bit_cast(bf16x8, pw1), ATT_VF(VL, VH, 1)); \
        ATT_MF(od, __builtin_bit_cast(bf16x8, pw2), ATT_VF(VL, VH, 2)); ATT_MF(od, __builtin_bit_cast(bf16x8, pw3), ATT_VF(VL, VH, 3)); } while (0)
#define ATT_SM_BIAS(P0, P1, T) do { if (MODE == 3) break; if (DIFF && ((T) + 2 >= cw) && ((T) <= cw)) { ALDS const float* tb_ = tabl + (64 * (T) - q0 - r32 + 192); \
        _Pragma("unroll") for (int r = 0; r < 16; ++r) { const int kk_ = crow(r, hi); P0[r] += tb_[kk_]; P1[r] += tb_[kk_ + 32]; } } } while (0)
#define ATT_SM_MAX0(P0) do { if (MODE == 3) break; rma_ = fmaxf(fmaxf(P0[0], P0[1]), P0[2]); rmb_ = fmaxf(fmaxf(P0[3], P0[4]), P0[5]); rmc_ = fmaxf(fmaxf(P0[6], P0[7]), P0[8]); rmd_ = fmaxf(fmaxf(P0[9], P0[10]), P0[11]); \
        rma_ = fmaxf(fmaxf(rma_, P0[12]), P0[13]); rmb_ = fmaxf(fmaxf(rmb_, P0[14]), P0[15]); } while (0)
#define ATT_SM_MAX1(P1) do { if (MODE == 3) break; rmc_ = fmaxf(fmaxf(rmc_, P1[0]), P1[1]); rmd_ = fmaxf(fmaxf(rmd_, P1[2]), P1[3]); rma_ = fmaxf(fmaxf(rma_, P1[4]), P1[5]); rmb_ = fmaxf(fmaxf(rmb_, P1[6]), P1[7]); \
        rmc_ = fmaxf(fmaxf(rmc_, P1[8]), P1[9]); rmd_ = fmaxf(fmaxf(rmd_, P1[10]), P1[11]); rma_ = fmaxf(fmaxf(rma_, P1[12]), P1[13]); rmb_ = fmaxf(fmaxf(rmb_, P1[14]), P1[15]); \
        rma_ = swapmax(fmaxf(fmaxf(rma_, rmb_), fmaxf(rmc_, rmd_))); } while (0)
#define ATT_SM_DEC(P0, P1) do { alS = 1.f; if (__any(psum_ > 65536.f)) { const float pr_ = swapsum(psum_); const float dl_ = pr_ > 65536.f ? __builtin_amdgcn_logf(pr_) : 0.f; m_ref += dl_; \
        _Pragma("unroll") for (int r = 0; r < 16; ++r) { P0[r] -= dl_; P1[r] -= dl_; } \
        alS = __builtin_amdgcn_exp2f(-dl_); } } while (0)
#define ATT_SM_EXP8(P, B) do { _Pragma("unroll") for (int r = (B); r < (B) + 8; ++r) P[r] = __builtin_amdgcn_exp2f(P[r]); } while (0)
#define ATT_RESC(AL) do { if (__any((AL) < 1.f)) { l_reg *= (AL); if (hi == 0) wsf[r32] = (AL); asm volatile("s_waitcnt lgkmcnt(0)" ::: "memory"); \
        _Pragma("unroll") for (int r = 0; r < 16; ++r) { const float al_ = wsf[crow(r, hi)]; _Pragma("unroll") for (int d = 0; d < 4; ++d) o[d][r] *= al_; } } } while (0)
#define ATT_STEP(PQ0, PQ1, ALQ, PF0, PF1, ALF, J) do { const int j_ = (J); \
        const int sm1_ = (sj == 0) ? NSLOT - 1 : sj - 1, sm2_ = (sm1_ == 0) ? NSLOT - 1 : sm1_ - 1;     \
        int nd_ = 0; if (MODE < 2) { if (j_ + LEAD < NT) { ATT_DMA_K(j_ + LEAD, sm1_); nd_ += DIFF ? 2 : 3; } if (j_ + LEAD - 1 < NT) { ATT_DMA_V(j_ + LEAD - 1, sm2_); nd_ += 2; } } \
        if (MODE != 1 && MODE != 9 && j_ <= cw + 1) { \
            ALDS const unsigned char* vp_ = shm3 + vbo + sm1_ * 16384; float psum_ = 0.f; \
            if (DIFF) {   \
                const int sp1_ = (sj + 1 == NSLOT) ? 0 : sj + 1; \
                ASBAR(); \
                { const float nb_ = ((j_ + 2 < cw) ? boff : 0.f) - m_ref;     \
                  if (__any(nb_ != negv)) { negv = nb_; _Pragma("unroll") for (int r = 0; r < 16; ++r) negm[r] = nb_; asm volatile("" : "+v"(negm)); } \
                  PQ0 = __builtin_amdgcn_mfma_f32_32x32x16_bf16(kf[0], qr[0], negm, 0, 0, 0); PQ1 = __builtin_amdgcn_mfma_f32_32x32x16_bf16(kf[1], qr[0], negm, 0, 0, 0); \
                  _Pragma("unroll") for (int d0 = 1; d0 < 4; ++d0) { ATT_MF(PQ0, kf[2 * d0], qr[d0]); ATT_MF(PQ1, kf[2 * d0 + 1], qr[d0]); } } \
                ATT_FIN(PF0, PF1, 1.f); ASBAR(); \
                { ALDS const unsigned char* kpn_ = shm3 + sp1_ * KSLOT + kfo;     \
                  _Pragma("unroll") for (int d0 = 0; d0 < 4; ++d0) { kf[2 * d0] = *(ALDS const bf16x8*)(kpn_ + ko[d0]); kf[2 * d0 + 1] = *(ALDS const bf16x8*)(kpn_ + ko[d0] + 4096); } } \
                ASBAR(); \
                ATT_SM_BIAS(PQ0, PQ1, j_); ASBAR(); \
                ATT_SM_DEC(PQ0, PQ1); ASBAR(); \
                ATT_VRD(vAl, vAh, 0); ATT_MF4(o[0], vAl, vAh); ATT_SM_EXP8(PQ0, 0); ASBAR(); \
                ATT_VRD(vAl, vAh, 1); ATT_MF4(o[1], vAl, vAh); ATT_SM_EXP8(PQ0, 8); ASBAR(); \
                ATT_VRD(vAl, vAh, 2); ATT_MF4(o[2], vAl, vAh); ATT_SM_EXP8(PQ1, 0); ASBAR(); \
                ATT_VRD(vAl, vAh, 3); ATT_MF4(o[3], vAl, vAh); ATT_SM_EXP8(PQ1, 8); ASBAR(); \
            } else { \
            ASBAR(); ATT_QK(PQ0, PQ1, j_); ATT_FIN(PF0, PF1, 1.f); ASBAR(); \
            ATT_SM_BIAS(PQ0, PQ1, j_); ASBAR(); \
            ATT_SM_DEC(PQ0, PQ1); ASBAR(); \
                ATT_VRD(vAl, vAh, 0); ATT_MF4(o[0], vAl, vAh); ATT_SM_EXP8(PQ0, 0); ASBAR(); \
            ATT_VRD(vAl, vAh, 1); ATT_MF4(o[1], vAl, vAh); ATT_SM_EXP8(PQ0, 8); ASBAR(); \
            ATT_VRD(vAl, vAh, 2); ATT_MF4(o[2], vAl, vAh); ATT_SM_EXP8(PQ1, 0); ASBAR(); \
            ATT_VRD(vAl, vAh, 3); ATT_MF4(o[3], vAl, vAh); ATT_SM_EXP8(PQ1, 8); ASBAR(); \
            } \
        } \
        if (MODE != 4) ATT_WAIT_BAR();     \
        if (ATT_STAGGER > 0 && wid >= 4) __builtin_amdgcn_s_sleep(ATT_STAGGER);     \
        if (j_ <= cw + 1) ATT_RESC(alS); \
        sj = (sj + 1 == NSLOT) ? 0 : sj + 1; } while (0)
    { const u32x4 z_ = {0u, 0u, 0u, 0u}; ALDS u32x4* vz_ = (ALDS u32x4*)(shm3 + V_OFF + (NSLOT - 1) * 16384) + tid * 2; vz_[0] = z_; vz_[1] = z_; }
#pragma unroll
    for (int r = 0; r < 16; ++r) { pB0[r] = 0.f; pB1[r] = 0.f; }
    ATT_WAIT_BAR();
    int sj = 0;
    if (DIFF && MODE != 1) { ALDS const unsigned char* kp0_ = shm3 + kfo; ALDS const unsigned char* vp0_ = shm3 + vbo + (NSLOT - 1) * 16384;
#pragma unroll
        for (int d0 = 0; d0 < 4; ++d0) { kf[2 * d0] = *(ALDS const bf16x8*)(kp0_ + ko[d0]); kf[2 * d0 + 1] = *(ALDS const bf16x8*)(kp0_ + ko[d0] + 4096); }
 }
    for (int j = 0; j <= NT; j += 2) {
        ATT_STEP(pA0, pA1, alA, pB0, pB1, alB, j);
        if (j + 1 <= NT) ATT_STEP(pB0, pB1, alB, pA0, pA1, alA, j + 1);
    }
#undef ATT_DMA_K
#undef ATT_DMA_V
#undef ATT_QK
#undef ATT_FIN
#undef ATT_VRD
#undef ATT_VF
#undef ATT_MF4
#undef ATT_MF
#undef ATT_SM_BIAS
#undef ATT_SM_MAX0
#undef ATT_SM_MAX1
#undef ATT_SM_DEC
#undef ATT_SM_EXP8
#undef ATT_RESC
#undef ATT_STEP
    if (MODE == 1) { ATT_WAIT_BAR(); return; }
    if (MODE >= 2) { ATT_WAIT_BAR(); if (l_reg == 123456.f) A.Y[tid] = (bf16)(int)(o[0][0] + o[1][1] + o[2][2] + o[3][3] + m_ref); ATT_WAIT_BAR(); return; }
    {
    int tid2_ = threadIdx.x; asm volatile("" : "+v"(tid2_));
    const int lane = tid2_ & 63, r32 = lane & 31, hi = lane >> 5; const int wid = __builtin_amdgcn_readfirstlane(tid2_ >> 6);
    const int map = DIFF ? (wid >> 2) : 0, wrow = DIFF ? (wid & 3) : wid;
    const int q0 = qb * QROWS + wrow * 32;
    ALDS float* wsf = (ALDS float*)(shm3 + WS_OFF) + wid * 64;
    ATT_WAIT_BAR();
    l_reg = swapsum(l_reg);
    if (hi == 0) wsf[32 + r32] = __builtin_amdgcn_rcpf(l_reg);
    asm volatile("s_waitcnt lgkmcnt(0)" ::: "memory");
    float rli[16];
#pragma unroll
    for (int r = 0; r < 16; ++r) rli[r] = wsf[32 + crow(r, hi)];
    ALDS bf16* stg;
    bool writer = true;
    if (DIFF) {
        ALDS float* X = (ALDS float*)(shm3 + (wid & 3) * 16384);
        if (map == 1) {
            const float lam = A.lam;
#pragma unroll
            for (int r = 0; r < 16; ++r) { const float f = rli[r] * lam; const int orow = crow(r, hi);
#pragma unroll
                for (int d = 0; d < 4; ++d) X[orow * 128 + d * 32 + r32] = o[d][r] * f; }
        }
        ATT_WAIT_BAR();
        stg = (ALDS bf16*)(shm3 + (wid & 3) * 16384);
        if (map == 0) {
            float g4[4];
#pragma unroll
            for (int d = 0; d < 4; ++d) g4[d] = A.subg[d * 32 + r32] * A.oml;
            float ss[16];
#pragma unroll
            for (int r = 0; r < 16; ++r) { const int orow = crow(r, hi); float s = 0.f;
#pragma unroll
                for (int d = 0; d < 4; ++d) { const float v = o[d][r] * rli[r] - X[orow * 128 + d * 32 + r32]; o[d][r] = v; s += v * v; }
                ss[r] = s; }
#pragma unroll
            for (int r = 0; r < 16; ++r) { float s = ss[r];
                s += __shfl_xor(s, 1); s += __shfl_xor(s, 2); s += __shfl_xor(s, 4); s += __shfl_xor(s, 8); s += __shfl_xor(s, 16);
                ss[r] = 1.0f / sqrtf(s * (1.0f / 128.0f) + EPS); }
            asm volatile("s_waitcnt lgkmcnt(0)" ::: "memory");
#pragma unroll
            for (int r = 0; r < 16; ++r) { const int orow = crow(r, hi);
#pragma unroll
                for (int d = 0; d < 4; ++d) stg[orow * 128 + d * 32 + r32] = (bf16)(cvtpk_s(o[d][r] * ss[r] * g4[d], 0.f) & 0xffffu); }
        } else writer = false;
    } else {
        stg = (ALDS bf16*)(shm3 + wid * 8192);
#pragma unroll
        for (int r = 0; r < 16; ++r) { const int orow = crow(r, hi);
#pragma unroll
            for (int d = 0; d < 4; ++d) stg[orow * 128 + d * 32 + r32] = (bf16)(cvtpk_s(o[d][r] * rli[r], 0.f) & 0xffffu); }
    }
    if (writer) {
        asm volatile("s_waitcnt lgkmcnt(0)" ::: "memory");
        const int gcol = (DIFF ? 0 : 1024) + h * 128;
#pragma unroll
        for (int i = 0; i < 8; ++i) { const int row = i * 4 + (lane >> 4), ch = lane & 15;
            const u32x4 ov = *(ALDS const u32x4*)(stg + row * 128 + ch * 8);
            const size_t gi = (size_t)(rowbase + q0 + row) * 2048 + gcol + ch * 8;
            const u32x4 gv = *(const u32x4*)(A.GATE + gi);
            u32x4 yv;
#pragma unroll
            for (int e = 0; e < 4; ++e) {
                const float o_lo = __uint_as_float(ov[e] << 16), o_hi = __uint_as_float(ov[e] & 0xffff0000u);
                const float g_lo = __uint_as_float(gv[e] << 16), g_hi = __uint_as_float(gv[e] & 0xffff0000u);
                const float s_lo = g_lo * __builtin_amdgcn_rcpf(1.0f + __builtin_amdgcn_exp2f(-g_lo * LOG2E));
                const float s_hi = g_hi * __builtin_amdgcn_rcpf(1.0f + __builtin_amdgcn_exp2f(-g_hi * LOG2E));
                yv[e] = cvtpk_s(o_lo * s_lo, o_hi * s_hi); }
            *(u32x4*)(A.Y + gi) = yv; }
    }
    ATT_WAIT_BAR();
    }
}
#undef ASBAR
}
constexpr size_t MiB = 1u << 20;
constexpr size_t WS_CTL = 0, CTL_ZERO_BYTES = 1 * MiB;
constexpr size_t WS_ROPEC = 1 * MiB, WS_ROPES = WS_ROPEC + 512 * 1024;
constexpr size_t WS_SMALL = 2 * MiB;
constexpr size_t SM_BIAS = 1024, SM_RSQ = 128 * 1024, SM_RSKV = 256 * 1024;
constexpr size_t WS_WIN = 4 * MiB;
constexpr size_t WS_WQB = 52 * MiB;
constexpr size_t WS_WKVB = 55 * MiB;
constexpr size_t WS_WOUT = 57 * MiB;
constexpr size_t WS_H = 80 * MiB;
constexpr size_t WS_Y = WS_H;
constexpr size_t WS_QKV = 144 * MiB;
constexpr size_t WS_CQ = 240 * MiB;
constexpr size_t WS_CKV = 256 * MiB;
constexpr size_t WS_KR = 264 * MiB;
constexpr size_t WS_GATE = 272 * MiB;
constexpr size_t WS_QM = 336 * MiB;
constexpr size_t WS_KVM = 384 * MiB;
constexpr size_t WS_END = 448 * MiB;
constexpr int CW_BAR = 4096;
constexpr size_t CTL_SSQ = 65536;

constexpr int RING_OFF = 0, RING_BYTES = 139264;
constexpr int LDSCTL_OFF = RING_BYTES, MISC_OFF = LDSCTL_OFF + 320;
constexpr int LDS_BYTES = 147456;
constexpr int NWAVES = 8;
static_assert(att::ATT_LDS_BYTES <= RING_BYTES, "attention scratch fits the ring region");

__device__ __forceinline__ float wave_sum(float v) {
#pragma unroll
    for (int o = 1; o < 64; o <<= 1) v += __shfl_xor(v, o);
    return v;
}
__device__ __forceinline__ int in_srccol(int n) {
    if (n < 3840) return n;
    if (n < 3904) { const int p = n - 3840, a = p >> 3, j = p & 7; return 3840 + (j < 4 ? 4 * a + j : 32 + 4 * a + (j - 4)); }
    if (n < 4096) return -1;
    return n - 192;
}
__device__ __forceinline__ int qb_srccol(int n) {
    const int hh = n / 192, off = n - hh * 192; if (off < 128) return n;
    const int p = off - 128, a = p >> 3, j = p & 7; return hh * 192 + 128 + (j < 4 ? 4 * a + j : 32 + 4 * a + (j - 4));
}
template <int MODE>
__device__ __forceinline__ void transpose_item(const float* W, int K, int Nsrc, int Ndst, bf16* WT, const float* gk, LAS float* scr, int item, int lane) {
    const int nblk = Ndst / 32, kb = item / nblk, nb = item - kb * nblk, k0 = 64 * kb, n0 = 32 * nb;
    const int nd = n0 + (lane & 31);
    const int src = (MODE == 1) ? in_srccol(nd) : (MODE == 2) ? qb_srccol(nd) : nd;
    float v[32];
#pragma unroll
    for (int i = 0; i < 32; ++i) { const int kk = 2 * i + (lane >> 5); v[i] = 0.f;
        if (src >= 0) { v[i] = W[(size_t)(k0 + kk) * Nsrc + src]; if (gk) v[i] *= gk[k0 + kk]; } }
#pragma unroll
    for (int i = 0; i < 32; ++i) { const int kk = 2 * i + (lane >> 5); scr[kk * 33 + (lane & 31)] = v[i]; }
    LDS_WAIT(); asm volatile("" ::: "memory");
    const int c = lane & 7;
#pragma unroll
    for (int j = 0; j < 4; ++j) { const int n = (lane >> 3) + 8 * j; const LAS float* s = scr + (8 * c) * 33 + n;
        v4u o; o.x = pk2(s[0 * 33], s[1 * 33]); o.y = pk2(s[2 * 33], s[3 * 33]); o.z = pk2(s[4 * 33], s[5 * 33]); o.w = pk2(s[6 * 33], s[7 * 33]);
        *(GAS v4u*)(WT + (size_t)(n0 + n) * K + k0 + 8 * c) = o; }
    LDS_WAIT(); asm volatile("" ::: "memory");
}
__device__ __forceinline__ void rms_row_to_bf16(const float* xrow, const float* g, bf16* orow, int lane) {
    const GAS f32x4* xr = (const GAS f32x4*)xrow + lane; const GAS f32x4* gr = (const GAS f32x4*)g + lane;
    f32x4 v[8]; float s = 0.f;
#pragma unroll
    for (int j = 0; j < 8; ++j) { v[j] = xr[64 * j]; s += (v[j].x * v[j].x + v[j].y * v[j].y) + (v[j].z * v[j].z + v[j].w * v[j].w); }
    const float rstd = 1.0f / sqrtf(wave_sum(s) * (1.0f / DM) + EPS);
    GAS unsigned long long* o8 = (GAS unsigned long long*)orow + lane;
#pragma unroll
    for (int j = 0; j < 8; ++j) { const f32x4 gg = gr[64 * j];
        o8[64 * j] = (unsigned long long)pk2(v[j].x * rstd * gg.x, v[j].y * rstd * gg.y) | ((unsigned long long)pk2(v[j].z * rstd * gg.z, v[j].w * rstd * gg.w) << 32); }
}
__device__ __forceinline__ void rms_row_f32(const float* xrow, const float* g, float* orow, int lane) {
    const GAS f32x4* xr = (const GAS f32x4*)xrow + lane; const GAS f32x4* gr = (const GAS f32x4*)g + lane;
    f32x4 v[8]; float s = 0.f;
#pragma unroll
    for (int j = 0; j < 8; ++j) { v[j] = xr[64 * j]; s += (v[j].x * v[j].x + v[j].y * v[j].y) + (v[j].z * v[j].z + v[j].w * v[j].w); }
    const float rstd = 1.0f / sqrtf(wave_sum(s) * (1.0f / DM) + EPS);
    GAS f32x4* o4 = (GAS f32x4*)orow + lane;
#pragma unroll
    for (int j = 0; j < 8; ++j) { const f32x4 gg = gr[64 * j]; o4[64 * j] = v[j] * rstd * gg; }
}
__device__ __forceinline__ int rel_bucket(int rel) {
    const int n = rel < 0 ? -rel : rel; int bk;
    if (n < 8) bk = n; else if (n < 12) bk = 8; else if (n < 16) bk = 9; else if (n < 23) bk = 10; else if (n < 32) bk = 11;
    else if (n < 46) bk = 12; else if (n < 64) bk = 13; else if (n < 91) bk = 14; else bk = 15;
    return (rel > 0 ? 16 : 0) + bk;
}

struct Args { const float* in[12]; float* out; unsigned char* ws; int ph_lo, ph_hi; };
constexpr int N_PHASES = 11;

#define IN(k) (lo <= (k) && (k) < hi)
#ifndef MK_REP_G23
#define MK_REP_G23 1
#endif
#ifndef MK_REP_G4
#define MK_REP_G4 1
#endif
#ifndef MK_REP_NORM
#define MK_REP_NORM 1
#endif
#ifndef MK_REP_RS
#define MK_REP_RS 1
#endif
#ifndef MK_ATT_MIX
#define MK_ATT_MIX 1
#endif
#ifndef MK_ATT_PROBE
#define MK_ATT_PROBE 0
#endif
#ifndef MK_REP_G1
#define MK_REP_G1 1
#endif
#ifndef MK_REP_P0
#define MK_REP_P0 1
#endif
#ifndef MK_CG_ONLY
#define MK_CG_ONLY 0
#endif
#ifdef MK_STAMP
#define STAMP(k) do { if (blockIdx.x == 0 && threadIdx.x == 0) WSP(unsigned long long, WS_SMALL + 64)[(k)] = __builtin_amdgcn_s_memrealtime(); } while (0)
#else
#define STAMP(k) do { } while (0)
#endif
#define SEAM(k) do { if (IN(k) && IN((k) + 1)) { if (MK_CG_ONLY || (k) == 0) grid.sync(); else xcd_barrier(bar); } STAMP((k) + 1); } while (0)
#define WSP(T, off) ((T*)(args.ws + (off)))

__device__ __forceinline__ void prologue_phase(const Args& args, unsigned char* lds, int G, int vcu) {
    int tid_ = threadIdx.x; asm volatile("" : "+v"(tid_));
    const int tid = tid_, lane = tid & 63, wave = __builtin_amdgcn_readfirstlane(tid >> 6);
    const int gw = vcu * NWAVES + wave, NGW = G * NWAVES;
    const float* x = args.in[0]; const float* norm_g = args.in[1]; const float* w_in = args.in[2]; const float* diff_lambda = args.in[3];
    const float* qnorm_g = args.in[5]; const float* w_qb = args.in[6]; const float* kvnorm_g = args.in[7];
    const float* w_kvb = args.in[8]; const float* w_out = args.in[9]; const float* rel_bias = args.in[10];
    float* ropec = WSP(float, WS_ROPEC); float* ropes = WSP(float, WS_ROPES); float* smallf = WSP(float, WS_SMALL); float* biastab = WSP(float, WS_SMALL + SM_BIAS);
    bf16* Win_t = WSP(bf16, WS_WIN); bf16* Wqb_t = WSP(bf16, WS_WQB); bf16* Wkvb_t = WSP(bf16, WS_WKVB); bf16* Wout_t = WSP(bf16, WS_WOUT); bf16* Hb = WSP(bf16, WS_H);
    LAS float* scr = (LAS float*)((LAS unsigned char*)lds + RING_OFF + wave * 16384);
    constexpr int I_IN = (DM / 64) * (NINP / 32), I_QB = (QLORA / 64) * (NQB / 32), I_KVB = (KVLORA / 64) * (NKVB / 32), I_OUT = (DM / 64) * (DM / 32);
    constexpr int PER_L = I_IN + I_QB + I_KVB + I_OUT;
    for (int it = gw; it < DEPTH * PER_L; it += NGW) {
        const int l = it / PER_L; int r = it - l * PER_L;
        if (r < I_IN) { transpose_item<1>(w_in + (size_t)l * DM * NIN, DM, NIN, NINP, Win_t + (size_t)l * NINP * DM, nullptr, scr, r, lane); continue; } r -= I_IN;
        if (r < I_QB) { transpose_item<2>(w_qb + (size_t)l * QLORA * NQB, QLORA, NQB, NQB, Wqb_t + (size_t)l * NQB * QLORA, qnorm_g + l * QLORA, scr, r, lane); continue; } r -= I_QB;
        if (r < I_KVB) { transpose_item<0>(w_kvb + (size_t)l * KVLORA * NKVB, KVLORA, NKVB, NKVB, Wkvb_t + (size_t)l * NKVB * KVLORA, kvnorm_g + l * KVLORA, scr, r, lane); continue; } r -= I_KVB;
        transpose_item<0>(w_out + (size_t)l * DM * DM, DM, DM, DM, Wout_t + (size_t)l * DM * DM, nullptr, scr, r, lane);
    }
    const int gt = vcu * (NWAVES * 64) + tid, NGT = G * NWAVES * 64;
    for (int e = gt; e < SEQ * 32; e += NGT) { const int s = e >> 5, i = e & 31;
        const float inv = powf(10000.0f, -(float)i * (1.0f / 32.0f)); const float ang = (float)s * inv;
        ropec[e] = cosf(ang); ropes[e] = sinf(ang); }
    for (int e = gt; e < 16 * 256; e += NGT) { const int mh = e >> 8, idx = e & 255; biastab[e] = rel_bias[rel_bucket(idx - 192) * 16 + mh] * LOG2E; }
    if (gt < DEPTH) { const float* lp = diff_lambda + gt * 256; float s01 = 0.f, s23 = 0.f;
        for (int i = 0; i < 64; ++i) { s01 += lp[i] * lp[64 + i]; s23 += lp[128 + i] * lp[192 + i]; }
        const float lam_init = 0.8f - 0.6f * expf(-0.3f * (float)gt);
        smallf[gt] = expf(s01) - expf(s23) + lam_init; smallf[8 + gt] = 1.0f - lam_init; }
    for (int m = gw; m < MROWS; m += NGW) rms_row_to_bf16(x + (size_t)m * DM, norm_g, Hb + (size_t)m * DM, lane);
}

template <int L>
__device__ __forceinline__ void layer_phases(const Args& args, unsigned char* lds, cg::grid_group& grid, const XcdBarrier& bar, int lo, int hi, int G, int bx, int vcu) {
    constexpr int pb = 1 + 5 * L;
    LAS unsigned char* ldsl = (LAS unsigned char*)lds;
#ifdef MK_CLK
    if (L == 0 && blockIdx.x == 0 && threadIdx.x == 0) { unsigned long long* ts = WSP(unsigned long long, WS_SMALL + 64); ts[10] = __builtin_amdgcn_s_memtime(); ts[11] = __builtin_amdgcn_s_memrealtime(); }
#endif
    if (IN(pb)) {
        pg8::Gemm g{WSP(bf16, WS_H), WSP(bf16, WS_WIN) + (size_t)L * NINP * DM, MROWS, NINP, DM}; pg8::StaticOrder S; S.init(MROWS, NINP, G, bx);
        pg8::EpiInProj E{WSP(bf16, WS_QKV), WSP(bf16, WS_CQ), WSP(bf16, WS_CKV), WSP(bf16, WS_KR), WSP(bf16, WS_GATE), WSP(float, WS_ROPEC), WSP(float, WS_ROPES), WSP(float, WS_CTL + CTL_SSQ + (size_t)(2 * L) * 65536), WSP(float, WS_CTL + CTL_SSQ + (size_t)(2 * L + 1) * 65536)};
        for (int rep_ = 0; rep_ < MK_REP_G1; ++rep_)
        pg8::gemm_phase<pg8::EpiInProj, pg8::StaticOrder, true, true>(ldsl + RING_OFF, g, S, E);
    }
#ifdef MK_CLK
    if (L == 0 && blockIdx.x == 0 && threadIdx.x == 0) { unsigned long long* ts = WSP(unsigned long long, WS_SMALL + 64); ts[12] = __builtin_amdgcn_s_memtime(); ts[13] = __builtin_amdgcn_s_memrealtime(); }
#endif
    SEAM(pb);
    if (IN(pb + 1)) for (int rep_ = 0; rep_ < MK_REP_G23; ++rep_) {
        { pg8::Gemm g{WSP(bf16, WS_CQ), WSP(bf16, WS_WQB) + (size_t)L * NQB * QLORA, MROWS, NQB, QLORA}; pg8::StaticOrder S; S.init(MROWS, NQB, G, bx);
          pg8::EpiRowScale<true> E{WSP(bf16, WS_QM), NQB, WSP(float, WS_CTL + CTL_SSQ + (size_t)(2 * L) * 65536), 1.0f / QLORA, WSP(float, WS_ROPEC), WSP(float, WS_ROPES), 0.07216878364870323f * LOG2E};
#ifndef NO_G2
          pg8::gemm_phase<pg8::EpiRowScale<true>, pg8::StaticOrder, true, true>(ldsl + RING_OFF, g, S, E);
#endif
        }
        { pg8::Gemm g{WSP(bf16, WS_CKV), WSP(bf16, WS_WKVB) + (size_t)L * NKVB * KVLORA, MROWS, NKVB, KVLORA}; pg8::KvOrder S; S.init(MROWS, NKVB, G, bx);
          pg8::EpiRowScale<false> E{WSP(bf16, WS_KVM), NKVB, WSP(float, WS_CTL + CTL_SSQ + (size_t)(2 * L + 1) * 65536), 1.0f / KVLORA, nullptr, nullptr, 1.0f};
#ifndef NO_G3
          pg8::gemm_phase<pg8::EpiRowScale<false>, pg8::KvOrder, true, true>(ldsl + RING_OFF, g, S, E);
#endif
        }
    }
    SEAM(pb + 1);
#ifdef MK_CLK
    if (L == 0 && blockIdx.x == 0 && threadIdx.x == 0) { unsigned long long* ts = WSP(unsigned long long, WS_SMALL + 64); ts[2] = __builtin_amdgcn_s_memtime(); ts[3] = __builtin_amdgcn_s_memrealtime(); }
#endif
    if (IN(pb + 2)) {
        const float* smallf = WSP(float, WS_SMALL);
        att::AttnArgs A{WSP(void, WS_CTL + 524288), WSP(bf16, WS_QKV), WSP(bf16, WS_QM), WSP(bf16, WS_KVM), WSP(bf16, WS_KR), WSP(bf16, WS_GATE), WSP(bf16, WS_Y), WSP(float, WS_SMALL + SM_BIAS), args.in[4] + L * 128, smallf[L], smallf[8 + L]};
        for (int p = vcu; p < 256; p += G) {
            const int bh = p >> 3, s = p & 7, b = bh >> 3, h = bh & 7;
            for (int pass_ = 0; pass_ < 2; ++pass_) {
                const bool mla_ = ((pass_ == 0) == ((s & 1) == 0)) || !MK_ATT_MIX;
                if (MK_ATT_MIX ? mla_ : pass_ == 0) { for (int i = 0; i < 2; ++i) att::attn_unit<false>(A, b, h, i == 0 ? 15 - s : s, lds + RING_OFF); }
                else { for (int i = 0; i < 4; ++i) att::attn_unit<true>(A, b, h, i == 0 ? 31 - 2 * s : i == 1 ? 30 - 2 * s : i == 2 ? 2 * s + 1 : 2 * s, lds + RING_OFF); }
            }
#if MK_ATT_PROBE
#ifndef MK_ATT_PROBE_KIND
#define MK_ATT_PROBE_KIND 3
#endif
            if (MK_ATT_PROBE_KIND & 1) for (int i = 0; i < 2; ++i) att::attn_unit<false, MK_ATT_PROBE>(A, b, h, i == 0 ? 15 - s : s, lds + RING_OFF);
            if (MK_ATT_PROBE_KIND & 2) for (int i = 0; i < 4; ++i) att::attn_unit<true, MK_ATT_PROBE>(A, b, h, i == 0 ? 31 - 2 * s : i == 1 ? 30 - 2 * s : i == 2 ? 2 * s + 1 : 2 * s, lds + RING_OFF);
#endif
        }
    }
#ifdef MK_CLK
    if (L == 0 && blockIdx.x == 0 && threadIdx.x == 0) { unsigned long long* ts = WSP(unsigned long long, WS_SMALL + 64); ts[4] = __builtin_amdgcn_s_memtime(); ts[5] = __builtin_amdgcn_s_memrealtime(); }
#endif
    SEAM(pb + 2);
    if (IN(pb + 3)) {
        pg8::Gemm g{WSP(bf16, WS_Y), WSP(bf16, WS_WOUT) + (size_t)L * DM * DM, MROWS, DM, DM}; pg8::StaticOrder S; S.init(MROWS, DM, G, bx);
        pg8::EpiResF32 E{L == 0 ? args.in[0] : (const float*)args.out, args.out, DM};
        for (int rep_ = 0; rep_ < (L == 0 ? MK_REP_G4 : 1); ++rep_)
        pg8::gemm_phase<pg8::EpiResF32, pg8::StaticOrder, true, true>(ldsl + RING_OFF, g, S, E);
    }
    SEAM(pb + 3);
    if (IN(pb + 4)) {
        int tid_ = threadIdx.x; asm volatile("" : "+v"(tid_));
        const int lane = tid_ & 63, wave = __builtin_amdgcn_readfirstlane(tid_ >> 6); const int gw = vcu * NWAVES + wave, NGW = G * NWAVES;
        if (L == 0) { const float* X1 = args.out; bf16* Hb = WSP(bf16, WS_H); const float* g = args.in[1] + DM;
            for (int rep_ = 0; rep_ < MK_REP_NORM; ++rep_) for (int m = gw; m < MROWS; m += NGW) rms_row_to_bf16(X1 + (size_t)m * DM, g, Hb + (size_t)m * DM, lane); }
        else { const float* g = args.in[11]; float* out = args.out;
            for (int m = gw; m < MROWS; m += NGW) rms_row_f32(out + (size_t)m * DM, g, out + (size_t)m * DM, lane); }
    }
    SEAM(pb + 4);
}

__global__ void __launch_bounds__(NWAVES * 64, 2) mk_fwd(Args args) {
    extern __shared__ __attribute__((aligned(16))) unsigned char lds[];
    cg::grid_group grid = cg::this_grid();
    const int G = gridDim.x; const int bx = blockIdx.x; const int vcu = (G % 8 == 0) ? (bx % 8) * (G / 8) + bx / 8 : bx;
    const int lo = args.ph_lo, hi = args.ph_hi;
    volatile LAS unsigned* MISC = (volatile LAS unsigned*)((LAS unsigned char*)lds + MISC_OFF);
    if (threadIdx.x < 32) MISC[threadIdx.x] = 0u;
    __syncthreads();
    const XcdBarrier bar = xcd_barrier_post(WSP(unsigned, WS_CTL) + CW_BAR, MISC + 8);
    STAMP(0);
#ifdef MK_UB
    {
        typedef short ub8 __attribute__((ext_vector_type(8))); typedef float uf16 __attribute__((ext_vector_type(16))); typedef short us4 __attribute__((ext_vector_type(4)));
        LAS unsigned char* lb_ = (LAS unsigned char*)lds + (threadIdx.x & 63) * 16 + (threadIdx.x >> 6) * 8192;
        ub8 a_, b_; for (int i = 0; i < 8; ++i) { a_[i] = (short)(0x3c00 + threadIdx.x + i); b_[i] = (short)(0x3a00 + i); }
        for (int i = 0; i < 8; ++i) *(LAS ub8*)(lb_ + i * 1024) = a_;
        __syncthreads();
        uf16 acc_; for (int i = 0; i < 16; ++i) acc_[i] = 0.f;
        float x_[12]; for (int i = 0; i < 12; ++i) x_[i] = 0.001f * (float)(threadIdx.x + i);
        ub8 nx_ = *(LAS const ub8*)(lb_);
        for (int it = 0; it < MK_UB_IT; ++it) {
            ub8 cur_ = a_;
            if (MK_UB_LDS == 1) cur_ = *(LAS const ub8*)(lb_ + (it & 7) * 1024);
            if (MK_UB_LDS == 2) { cur_ = nx_; nx_ = *(LAS const ub8*)(lb_ + ((it + 1) & 7) * 1024); }
            if (MK_UB_LDS == 3) { cur_ = nx_; const us4 l_ = __builtin_bit_cast(us4, __builtin_amdgcn_ds_read_tr16_b64_v4i16((LAS us4*)(lb_ - (threadIdx.x & 63) * 8 + ((it + 1) & 7) * 1024))), h_ = __builtin_bit_cast(us4, __builtin_amdgcn_ds_read_tr16_b64_v4i16((LAS us4*)(lb_ - (threadIdx.x & 63) * 8 + ((it + 1) & 7) * 1024 + 512))); nx_ = (ub8){l_[0], l_[1], l_[2], l_[3], h_[0], h_[1], h_[2], h_[3]}; }
#if MK_UB_ACC == 1
            asm volatile("v_mfma_f32_32x32x16_bf16 %0, %1, %2, %0" : "+a"(acc_) : "v"(cur_), "v"(b_));
#elif MK_UB_ACC == 2
            asm volatile("v_mfma_f32_32x32x16_bf16 %0, %1, %2, %0" : "+v"(acc_) : "v"(cur_), "v"(b_));
#else
            acc_ = __builtin_amdgcn_mfma_f32_32x32x16_bf16(cur_, b_, acc_, 0, 0, 0);
#endif
#pragma unroll
            for (int i = 0; i < MK_UB_N; ++i) { if (MK_UB_EXP) x_[i] = __builtin_amdgcn_exp2f(x_[i]); else x_[i] = fmaf(x_[i], 0.999f, 0.001f); asm volatile("" : "+v"(x_[i])); }
            __builtin_amdgcn_sched_barrier(0);
        }
        float sum_ = acc_[0] + acc_[5]; for (int i = 0; i < 12; ++i) sum_ += x_[i];
        if (sum_ == 123456.789f) args.out[threadIdx.x] = sum_;
        __syncthreads();
    }
#endif
    if (IN(0)) { for (int rep_ = 0; rep_ < MK_REP_P0; ++rep_) prologue_phase(args, lds, G, vcu); }
    SEAM(0);
    layer_phases<0>(args, lds, grid, bar, lo, hi, G, bx, vcu);
    layer_phases<1>(args, lds, grid, bar, lo, hi, G, bx, vcu);
#ifdef MK_TPROF
    xcd_barrier(bar);
    { const unsigned long long* a_ = WSP(unsigned long long, WS_CTL + 524288); const float n_ = (float)a_[3];
      const float qa = floorf((float)a_[MK_TPROF_A] / n_ * (1.0f / MK_TPROF_Q) + 0.5f), qb = floorf((float)a_[MK_TPROF_B] / n_ * (1.0f / MK_TPROF_Q) + 0.5f);
      float* o = args.out; const int gt = blockIdx.x * 512 + threadIdx.x;
      for (int i = gt; i < MROWS * DM; i += gridDim.x * 512) o[i] = (i == 0) ? 16.f * qb : qa; }
#endif
#ifdef MK_CLK
    xcd_barrier(bar);
    { const unsigned long long* ts = WSP(unsigned long long, WS_SMALL + 64);
      const float ca = (float)(ts[4] - ts[2]) / (float)(ts[5] - ts[3]), cg = (float)(ts[12] - ts[10]) / (float)(ts[13] - ts[11]);
      const float qa = floorf(ca + 0.5f), qg = floorf(cg + 0.5f);
      float* o = args.out; const int gt = blockIdx.x * 512 + threadIdx.x;
      for (int i = gt; i < MROWS * DM; i += gridDim.x * 512) o[i] = (i == 0) ? 16.f * qg : qa; }
#endif
#ifdef MK_STAMP
    xcd_barrier(bar);
    { const unsigned long long* ts = WSP(unsigned long long, WS_SMALL + 64);
      float da = 0.f, db = 0.f;
      for (int p = 0; p < N_PHASES; ++p) { const int kind = p == 0 ? 0 : 1 + (p - 1) % 6; const float d = (float)(ts[p + 1] - ts[p]) * 0.01f; if (kind == MK_STAMP_A) da += d; if (kind == MK_STAMP_B) db += d; }
      float* o = args.out; const int gt = blockIdx.x * 512 + threadIdx.x;
      for (int i = gt; i < MROWS * DM; i += gridDim.x * 512) o[i] = (i == 0) ? 16.f * db : da; }
#endif
}
#undef IN
#undef SEAM
#undef WSP

#ifndef MK_PH_MAX
#define MK_PH_MAX N_PHASES
#endif
#ifndef MK_PH_MIN
#define MK_PH_MIN 0
#endif
#ifndef MK_LAUNCH_PER_PHASE
#define MK_LAUNCH_PER_PHASE 0
#endif
__global__ void diag_fill(float* o, int n, float c) { for (int i = blockIdx.x * 256 + threadIdx.x; i < n; i += gridDim.x * 256) o[i] = c; }
#ifdef MK_UBK
__global__ void __launch_bounds__(512, 2) ub_kernel(float* out) {
    typedef short ub8 __attribute__((ext_vector_type(8))); typedef float uf16 __attribute__((ext_vector_type(16)));
    ub8 a_, b_; for (int i = 0; i < 8; ++i) { a_[i] = (short)(0x3c00 + threadIdx.x + i); b_[i] = (short)(0x3a00 + i); }
    uf16 acc_; for (int i = 0; i < 16; ++i) acc_[i] = 0.f;
    float x_[12]; for (int i = 0; i < 12; ++i) x_[i] = 0.001f * (float)(threadIdx.x + i);
    for (int it = 0; it < MK_UBK_IT; ++it) {
#if MK_UBK_ACC == 1
        asm volatile("v_mfma_f32_32x32x16_bf16 %0, %1, %2, %0" : "+a"(acc_) : "v"(a_), "v"(b_));
#else
        asm volatile("v_mfma_f32_32x32x16_bf16 %0, %1, %2, %0" : "+v"(acc_) : "v"(a_), "v"(b_));
#endif
#pragma unroll
        for (int i = 0; i < MK_UBK_N; ++i) { x_[i] = fmaf(x_[i], 0.999f, 0.001f); asm volatile("" : "+v"(x_[i])); }
        __builtin_amdgcn_sched_barrier(0);
    }
    float sum_ = acc_[0] + acc_[5]; for (int i = 0; i < 12; ++i) sum_ += x_[i];
    if (sum_ == 123456.789f) out[threadIdx.x] = sum_;
}
#endif
extern "C" void kernel_launch(void* const* d_in, const int* in_sizes, int n_in, void* d_out, int out_size, void* d_ws, size_t ws_size, hipStream_t stream) {
    static int grid = 0;
    if (grid == 0) {
        if (n_in != 12 || in_sizes[0] != MROWS * DM || out_size != MROWS * DM || ws_size < WS_END) {
            fprintf(stderr, "kernel_launch: unexpected shapes: n_in %d in0 %d out %d ws %zu (need >= %zu)\n", n_in, n_in > 0 ? in_sizes[0] : -1, out_size, ws_size, (size_t)WS_END);
            const float code = (n_in != 12) ? 30.f : (in_sizes[0] != MROWS * DM) ? 40.f : (out_size != MROWS * DM) ? 50.f : (float)(ws_size >> 26);
            hipLaunchKernelGGL(diag_fill, dim3(1024), dim3(256), 0, stream, (float*)d_out, out_size, code); return; }
        int dev = 0, cus = 0, per_cu = 0;
        if (hipGetDevice(&dev) != hipSuccess || hipDeviceGetAttribute(&cus, hipDeviceAttributeMultiprocessorCount, dev) != hipSuccess) { fprintf(stderr, "kernel_launch: device query failed\n"); grid = -1; return; }
        if (hipFuncSetAttribute((const void*)mk_fwd, hipFuncAttributeMaxDynamicSharedMemorySize, LDS_BYTES) != hipSuccess) { fprintf(stderr, "kernel_launch: hipFuncSetAttribute failed\n"); grid = -1; return; }
        if (hipOccupancyMaxActiveBlocksPerMultiprocessor(&per_cu, (const void*)mk_fwd, NWAVES * 64, LDS_BYTES) != hipSuccess || per_cu < 1) {
            fprintf(stderr, "kernel_launch: occupancy query reports %d workgroups per CU\n", per_cu); (void)hipGetLastError(); per_cu = 1; }
        grid = cus;
        if (grid > 256) grid = 256;
    }
    if (grid < 0) return;
    (void)hipMemsetAsync((char*)d_ws + WS_CTL, 0, CTL_ZERO_BYTES, stream);
#ifdef MK_UBK
    hipLaunchKernelGGL(ub_kernel, dim3(256), dim3(512), 0, stream, (float*)d_ws + (WS_END >> 2) - 4096);
#endif
    Args a{};
    for (int i = 0; i < 12; ++i) a.in[i] = (const float*)d_in[i];
    a.out = (float*)d_out; a.ws = (unsigned char*)d_ws;
#if MK_LAUNCH_PER_PHASE
    for (int p = MK_PH_MIN; p < MK_PH_MAX; ++p) { a.ph_lo = p; a.ph_hi = p + 1; hipLaunchKernelGGL(mk_fwd, dim3(grid), dim3(NWAVES * 64), LDS_BYTES, stream, a); }
    { const hipError_t le = hipPeekAtLastError(); if (le != hipSuccess) fprintf(stderr, "kernel_launch: launch failed: %s\n", hipGetErrorName(le)); }
#else
    a.ph_lo = 0; a.ph_hi = N_PHASES;
    void* kargs[] = {&a};
    const hipError_t e = hipLaunchCooperativeKernel((const void*)mk_fwd, dim3(grid), dim3(NWAVES * 64), kargs, LDS_BYTES, stream);
    if (e != hipSuccess) fprintf(stderr, "kernel_launch: cooperative launch failed: %s (grid %d)\n", hipGetErrorString(e), grid);
#endif
}
```

```cpp
#include <hip/hip_runtime.h>
#include <hip/hip_cooperative_groups.h>
#include <cstdio>
#include <cstdint>
namespace cg = cooperative_groups;

constexpr int BATCH = 4, SEQ = 4096, DM = 2048, MROWS = BATCH * SEQ, DEPTH = 2;
constexpr int NIN = 5952, NINP = 6144;
constexpr int QLORA = 512, KVLORA = 256, NQB = 1536, NKVB = 2048;
constexpr float EPS = 1e-6f;
constexpr float LOG2E = 1.4426950408889634f;
namespace pg8 {
#define PG8_LAS __attribute__((address_space(3)))
typedef unsigned short bf16_t;
typedef short bf16x8 __attribute__((ext_vector_type(8)));
typedef float f32x4 __attribute__((ext_vector_type(4)));
typedef unsigned u32x4 __attribute__((ext_vector_type(4)));
constexpr int BM = 256, BK = 64, HALF = 128, HTB = HALF * BK * 2  , STAGE_BYTES = 8 * HTB, NXCD = 8, WGM = 8;

__host__ __device__ __forceinline__ int lds_byte(int r, int c) { const int st = (r >> 4) * 2 + (c >> 5), rr = r & 15, cc = c & 31, ob = rr * 64 + cc * 2; return st * 1024 + (ob ^ (((ob >> 9) & 1) << 5)); }
__host__ __device__ __forceinline__ void stage_rc(int b, int& R, int& C) { const int st = b / 1024, sb = b % 1024, swz = sb ^ (((sb >> 9) & 1) << 5); R = (st >> 1) * 16 + swz / 64; C = (st & 1) * 32 + (swz % 64) / 2; }
__host__ __device__ __forceinline__ int perm32(int rho) { const int n = rho >> 4, i = rho & 15; return 8 * (i >> 2) + 4 * n + (i & 3); }

struct Unit { int pm, pn; };
struct Gemm { const bf16_t* A; const bf16_t* Bt; int M, N, K; };

struct StaticOrder {
    int nM, nN, nwg, G, c;
    __host__ __device__ void init(int M, int N, int G_, int c_) { nM = M / BM; nN = N / BM; nwg = nM * nN; G = G_; c = c_; }
    __host__ __device__ bool next(int i, Unit& u) const {
        const long L = (long)i * G + c; if (L >= nwg) return false;
        int wgid = (int)L; { const int q = nwg / NXCD, r = nwg % NXCD, xcd = wgid % NXCD, off = wgid / NXCD; wgid = (xcd < r ? xcd * (q + 1) : r * (q + 1) + (xcd - r) * q) + off; }
        const int nig = WGM * nN, gid = wgid / nig, fm = gid * WGM, gsz = (nM - fm) < WGM ? (nM - fm) : WGM;
        u.pm = fm + ((wgid % nig) % gsz); u.pn = (wgid % nig) / gsz; return true;
    }
    __device__ __forceinline__ void a_ready(const Unit&) const {}
    __device__ __forceinline__ void done(const Unit&) const {}
};

__device__ __forceinline__ unsigned cvt_pk_bf16(float lo, float hi) { unsigned r; asm volatile("v_cvt_pk_bf16_f32 %0, %1, %2" : "=v"(r) : "v"(lo), "v"(hi)); return r; }
typedef float f32x2 __attribute__((ext_vector_type(2)));
struct EpiInProj {
    static constexpr bool PERM = true, AFTER_DRAIN = false;
    bf16_t *QKV, *CQ, *CKV, *KR, *GATE; const float* ropec; const float* ropes; float* ssq_q; float* ssq_kv;
    __device__ __forceinline__ void operator()(const f32x4 (&acc)[2][2][4][2], const Unit& u, int wr, int wc, int fr, int fq) const {
        const int row0 = u.pm * BM + wr * 64 + fr; const int pn = u.pn;
        if (pn == 15) {
            if (wc < 2) {
                const int a = wc * 4 + fq;
#pragma unroll
                for (int ai = 0; ai < 2; ++ai)
#pragma unroll
                    for (int m = 0; m < 4; ++m) { const int row = row0 + ai * HALF + m * 16, s = row & (SEQ - 1);
                        const f32x4 c = *(const f32x4*)(ropec + s * 32 + 4 * a), sn = *(const f32x4*)(ropes + s * 32 + 4 * a);
                        const f32x4 x1 = acc[ai][0][m][0], x2 = acc[ai][0][m][1];
                        const f32x4 y1 = x1 * c - x2 * sn, y2 = x1 * sn + x2 * c;
                        u32x4 w; w.x = cvt_pk_bf16(y1[0], y1[1]); w.y = cvt_pk_bf16(y1[2], y1[3]); w.z = cvt_pk_bf16(y2[0], y2[1]); w.w = cvt_pk_bf16(y2[2], y2[3]);
                        *(u32x4*)(KR + (size_t)row * 64 + 8 * a) = w; }
            }
            return;
        }
        bf16_t* base; int ldc, colt;
        if (pn < 12) { base = QKV; ldc = 3072; colt = pn * 256; }
        else if (pn < 14) { base = CQ; ldc = 512; colt = (pn - 12) * 256; }
        else if (pn == 14) { base = CKV; ldc = 256; colt = 0; }
        else { base = GATE; ldc = 2048; colt = (pn - 16) * 256; }
        const int col0 = colt + wc * 32 + 8 * fq;
        const float sc = (pn < 4) ? 0.125f * 1.4426950408889634f : 1.0f;
#pragma unroll
        for (int ai = 0; ai < 2; ++ai)
#pragma unroll
            for (int m = 0; m < 4; ++m) { bf16_t* rowp = base + (size_t)(row0 + ai * HALF + m * 16) * ldc + col0;
#pragma unroll
                for (int bj = 0; bj < 2; ++bj) { const f32x4 v0 = acc[ai][bj][m][0] * sc, v1 = acc[ai][bj][m][1] * sc;
                    u32x4 w; w.x = cvt_pk_bf16(v0[0], v0[1]); w.y = cvt_pk_bf16(v0[2], v0[3]); w.z = cvt_pk_bf16(v1[0], v1[1]); w.w = cvt_pk_bf16(v1[2], v1[3]);
                    *(u32x4*)(rowp + bj * HALF) = w; } }
        if (pn >= 12 && pn <= 14) {
            float* ssq = (pn == 14) ? ssq_kv : ssq_q;
#pragma unroll
            for (int ai = 0; ai < 2; ++ai)
#pragma unroll
                for (int m = 0; m < 4; ++m) { float s = 0.f;
#pragma unroll
                    for (int bj = 0; bj < 2; ++bj)
#pragma unroll
                        for (int n = 0; n < 2; ++n) { const f32x4 v = acc[ai][bj][m][n]; s += (v[0] * v[0] + v[1] * v[1]) + (v[2] * v[2] + v[3] * v[3]); }
                    s += __shfl_xor(s, 16); s += __shfl_xor(s, 32);
                    if (fq == 0) __hip_atomic_fetch_add(ssq + row0 + ai * HALF + m * 16, s, __ATOMIC_RELAXED, __HIP_MEMORY_SCOPE_AGENT); }
        }
    }
};
template <bool ROPE> struct EpiRowScale {
    static constexpr bool PERM = true, AFTER_DRAIN = false;
    bf16_t* O; int ldc; const float* ssq; float inv_n; const float* ropec; const float* ropes; float qscale;
    __device__ __forceinline__ void operator()(const f32x4 (&acc)[2][2][4][2], const Unit& u, int wr, int wc, int fr, int fq) const {
        const int row0 = u.pm * BM + wr * 64 + fr; const int col0 = u.pn * BM + wc * 32 + 8 * fq;
        bool isr[2]; int ra[2];
#pragma unroll
        for (int bj = 0; bj < 2; ++bj) { const int c0 = col0 + bj * HALF, off = c0 % 192; isr[bj] = ROPE && (off >= 128); ra[bj] = (off - 128) >> 3; }
#pragma unroll
        for (int ai = 0; ai < 2; ++ai)
#pragma unroll
            for (int m = 0; m < 4; ++m) { const int row = row0 + ai * HALF + m * 16, s = row & (SEQ - 1); const float r = qscale / sqrtf(ssq[row] * inv_n + 1e-6f);
                bf16_t* rowp = O + (size_t)row * ldc + col0;
#pragma unroll
                for (int bj = 0; bj < 2; ++bj) { f32x4 v0 = acc[ai][bj][m][0] * r, v1 = acc[ai][bj][m][1] * r;
                    if (ROPE) { if (isr[bj]) { const f32x4 c = *(const f32x4*)(ropec + s * 32 + 4 * ra[bj]), sn = *(const f32x4*)(ropes + s * 32 + 4 * ra[bj]);
                        const f32x4 y1 = v0 * c - v1 * sn, y2 = v0 * sn + v1 * c; v0 = y1; v1 = y2; } }
                    u32x4 w; w.x = cvt_pk_bf16(v0[0], v0[1]); w.y = cvt_pk_bf16(v0[2], v0[3]); w.z = cvt_pk_bf16(v1[0], v1[1]); w.w = cvt_pk_bf16(v1[2], v1[3]);
                    *(u32x4*)(rowp + bj * HALF) = w; } }
    }
};
struct EpiResF32 {
    static constexpr bool PERM = false, AFTER_DRAIN = false;
    const float* base; float* out; int ldc;
    __device__ __forceinline__ void operator()(const f32x4 (&acc)[2][2][4][2], const Unit& u, int wr, int wc, int fr, int fq) const {
        const int row0 = u.pm * BM + wr * 64 + fr, col0 = u.pn * BM + wc * 32 + 4 * fq;
#pragma unroll
        for (int ai = 0; ai < 2; ++ai)
#pragma unroll
            for (int m = 0; m < 4; ++m) { const size_t off = (size_t)(row0 + ai * HALF + m * 16) * ldc + col0;
#pragma unroll
                for (int bj = 0; bj < 2; ++bj)
#pragma unroll
                    for (int n = 0; n < 2; ++n) { const f32x4 bs = *(const f32x4*)(base + off + bj * HALF + n * 16); *(f32x4*)(out + off + bj * HALF + n * 16) = bs + acc[ai][bj][m][n]; } }
    }
};
struct KvOrder : StaticOrder {
    __host__ __device__ bool next(int i, Unit& u) const {
        long L; if (G != 256) { L = (long)i * G + c; if (L >= nwg) return false; }
        else if (c < 128) { if (i > 0) return false; L = c; }
        else { if (i > 2) return false; L = 128 + 3 * (c - 128) + i; }
        int wgid = (int)L; { const int q = nwg / NXCD, r = nwg % NXCD, xcd = wgid % NXCD, off = wgid / NXCD; wgid = (xcd < r ? xcd * (q + 1) : r * (q + 1) + (xcd - r) * q) + off; }
        const int nig = WGM * nN, gid = wgid / nig, fm = gid * WGM, gsz = (nM - fm) < WGM ? (nM - fm) : WGM;
        u.pm = fm + ((wgid % nig) % gsz); u.pn = (wgid % nig) / gsz; return true;
    }
};
template <class Epi, class Sched, bool ALIGN_EPI = false, bool SP2 = false>
__device__ __forceinline__ void gemm_phase(PG8_LAS unsigned char* lds, const Gemm g, const Sched& S, const Epi& E) {
    int tid_ = threadIdx.x; asm volatile("" : "+v"(tid_));
    const int tid = tid_, wid = __builtin_amdgcn_readfirstlane(tid >> 6), lane = tid & 63, wr = wid >> 2, wc = wid & 3, fr = lane & 15, fq = lane >> 4;
    const int K = g.K, nt = K / BK;
    unsigned voffA[2], voffB[2];
#pragma unroll
    for (int i = 0; i < 2; ++i) { int R, C; stage_rc(tid * 16 + i * 8192, R, C); const int Rb = Epi::PERM ? ((R & ~31) + perm32(R & 31)) : R;
        voffA[i] = (unsigned)(R * K + C) * 2u; voffB[i] = (unsigned)(Rb * K + C) * 2u; }
    const size_t kstep = (size_t)(BK * 2);
    const size_t hstep = (size_t)HALF * K * 2;
    const size_t tstep = 2 * hstep;
    const unsigned ldsw = (unsigned)wid * 1024u;
    const int aoff = lds_byte(wr * 64 + fr, fq * 8), boff = lds_byte(wc * 32 + fr, fq * 8);
#define PG8_SA(b, h) (((b) * 2 + (h)) * HTB)
#define PG8_SB(b, h) ((4 + (b) * 2 + (h)) * HTB)
#define PG8_STAGE(bufoff, gbase, voff) do { _Pragma("unroll") for (int _i = 0; _i < 2; ++_i) \
        __builtin_amdgcn_global_load_lds((const unsigned*)((const char*)(gbase) + (voff)[_i]), (PG8_LAS unsigned*)(lds + (bufoff) + ldsw + _i * 8192), 16, 0, 0); } while (0)
#define PG8_LDA(dst, b, h) do { _Pragma("unroll") for (int m = 0; m < 4; ++m) _Pragma("unroll") for (int k = 0; k < 2; ++k) dst[m][k] = *(const PG8_LAS bf16x8*)(lds + PG8_SA(b, h) + aoff + m * 2048 + k * 1024); } while (0)
#define PG8_LDB(dst, b, h) do { _Pragma("unroll") for (int n = 0; n < 2; ++n) _Pragma("unroll") for (int k = 0; k < 2; ++k) dst[n][k] = *(const PG8_LAS bf16x8*)(lds + PG8_SB(b, h) + boff + n * 2048 + k * 1024); } while (0)
#define PG8_MMA(ai, bj, At, Bt) do { __builtin_amdgcn_s_setprio(1); _Pragma("unroll") for (int m = 0; m < 4; ++m) _Pragma("unroll") for (int n = 0; n < 2; ++n) _Pragma("unroll") for (int k = 0; k < 2; ++k) \
        acc[ai][bj][m][n] = __builtin_amdgcn_mfma_f32_16x16x32_bf16(Bt[n][k], At[m][k], acc[ai][bj][m][n], 0, 0, 0); __builtin_amdgcn_s_setprio(0); } while (0)
#define PG8_WAIT_V(n) asm volatile("s_waitcnt vmcnt(" #n ")" ::: "memory")
#define PG8_WAIT_L(n) asm volatile("s_waitcnt lgkmcnt(" #n ")" ::: "memory")
#define PG8_BAR __builtin_amdgcn_s_barrier()
#define PG8_SCHED __builtin_amdgcn_sched_barrier(0)
    Unit cur, nxt; int ui = 0;
    if (!S.next(0, cur)) return;
    f32x4 acc[2][2][4][2];
#pragma unroll
    for (int a = 0; a < 2; ++a)
#pragma unroll
        for (int b = 0; b < 2; ++b)
#pragma unroll
            for (int m = 0; m < 4; ++m)
#pragma unroll
                for (int n = 0; n < 2; ++n) acc[a][b][m][n] = (f32x4){0.f, 0.f, 0.f, 0.f};
    bf16x8 At[4][2], B0[2][2], B1[2][2];
    const char* cA = (const char*)g.A + (size_t)cur.pm * tstep; const char* cB = (const char*)g.Bt + (size_t)cur.pn * tstep;
    S.a_ready(cur);
    if constexpr (SP2) {
        PG8_STAGE(PG8_SB(0, 0), cB, voffB); PG8_STAGE(PG8_SB(0, 1), cB + hstep, voffB); PG8_STAGE(PG8_SA(0, 0), cA, voffA); PG8_STAGE(PG8_SA(0, 1), cA + hstep, voffA);
        if (wr == 1) PG8_BAR;
        PG8_WAIT_V(2); PG8_BAR;
        PG8_STAGE(PG8_SB(1, 0), cB + kstep, voffB); PG8_STAGE(PG8_SA(1, 0), cA + kstep, voffA); PG8_STAGE(PG8_SB(1, 1), cB + hstep + kstep, voffB);
        PG8_WAIT_V(6); PG8_BAR;
    } else {
        PG8_STAGE(PG8_SB(0, 0), cB, voffB); PG8_STAGE(PG8_SA(0, 0), cA, voffA); PG8_STAGE(PG8_SB(0, 1), cB + hstep, voffB); PG8_STAGE(PG8_SA(0, 1), cA + hstep, voffA);
        if (wr == 1) PG8_BAR;
        PG8_WAIT_V(4); PG8_BAR;
        PG8_STAGE(PG8_SB(1, 0), cB + kstep, voffB); PG8_STAGE(PG8_SA(1, 0), cA + kstep, voffA); PG8_STAGE(PG8_SB(1, 1), cB + hstep + kstep, voffB);
        PG8_WAIT_V(6); PG8_BAR;
    }
    for (;;) {
        const bool has_next = S.next(ui + 1, nxt);
        const char* nA = has_next ? (const char*)g.A + (size_t)nxt.pm * tstep : cA; const char* nB = has_next ? (const char*)g.Bt + (size_t)nxt.pn * tstep : cB;
        for (int t = 0; t < nt; t += 2) {
            const bool last = (t == nt - 2);
            const char* a1 = cA + (size_t)(t + 1) * kstep;
            const char* a2 = last ? nA : cA + (size_t)(t + 2) * kstep; const char* b2 = last ? nB : cB + (size_t)(t + 2) * kstep;
            const char* a3 = a2 + kstep; const char* b3 = b2 + kstep;
            if (last && has_next) S.a_ready(nxt);
            if constexpr (SP2) {
            PG8_LDB(B0, 0, 0); PG8_LDB(B1, 0, 1); PG8_SCHED; PG8_LDA(At, 0, 0); PG8_STAGE(PG8_SA(1, 1), a1 + hstep, voffA);
            PG8_WAIT_V(8); PG8_WAIT_L(0); PG8_BAR; PG8_MMA(0, 0, At, B0); PG8_MMA(0, 1, At, B1); PG8_BAR; PG8_SCHED;
            PG8_LDA(At, 0, 1); PG8_STAGE(PG8_SB(0, 0), b2, voffB); PG8_STAGE(PG8_SB(0, 1), b2 + hstep, voffB); PG8_STAGE(PG8_SA(0, 0), a2, voffA);
            PG8_WAIT_V(8); PG8_WAIT_L(0); PG8_BAR; PG8_MMA(1, 0, At, B0); PG8_MMA(1, 1, At, B1); PG8_BAR; PG8_SCHED;
            PG8_LDB(B0, 1, 0); PG8_LDB(B1, 1, 1); PG8_SCHED; PG8_LDA(At, 1, 0); PG8_STAGE(PG8_SA(0, 1), a2 + hstep, voffA);
            PG8_WAIT_V(8); PG8_WAIT_L(0); PG8_BAR; PG8_MMA(0, 0, At, B0); PG8_MMA(0, 1, At, B1); PG8_BAR; PG8_SCHED;
            PG8_LDA(At, 1, 1); PG8_STAGE(PG8_SB(1, 0), b3, voffB); PG8_STAGE(PG8_SB(1, 1), b3 + hstep, voffB); PG8_STAGE(PG8_SA(1, 0), a3, voffA);
            PG8_WAIT_V(8); PG8_WAIT_L(0); PG8_BAR; PG8_MMA(1, 0, At, B0); PG8_MMA(1, 1, At, B1); PG8_BAR; PG8_SCHED;
            } else {
            PG8_LDB(B0, 0, 0); PG8_SCHED; PG8_LDA(At, 0, 0); PG8_STAGE(PG8_SA(1, 1), a1 + hstep, voffA);
            PG8_WAIT_L(8); PG8_BAR; PG8_WAIT_L(0); PG8_MMA(0, 0, At, B0); PG8_BAR; PG8_SCHED;
            PG8_LDB(B1, 0, 1); PG8_STAGE(PG8_SB(0, 0), b2, voffB);
            PG8_BAR; PG8_WAIT_L(0); PG8_MMA(0, 1, At, B1); PG8_BAR;
            PG8_LDA(At, 0, 1); PG8_STAGE(PG8_SA(0, 0), a2, voffA);
            PG8_BAR; PG8_WAIT_L(0); PG8_MMA(1, 0, At, B0); PG8_BAR; PG8_SCHED;
            PG8_STAGE(PG8_SB(0, 1), b2 + hstep, voffB);
            PG8_WAIT_V(6); PG8_BAR; PG8_MMA(1, 1, At, B1); PG8_BAR;
            PG8_LDB(B0, 1, 0); PG8_SCHED; PG8_LDA(At, 1, 0); PG8_STAGE(PG8_SA(0, 1), a2 + hstep, voffA);
            PG8_WAIT_L(8); PG8_BAR; PG8_WAIT_L(0); PG8_MMA(0, 0, At, B0); PG8_BAR; PG8_SCHED;
            PG8_LDB(B1, 1, 1); PG8_STAGE(PG8_SB(1, 0), b3, voffB);
            PG8_BAR; PG8_WAIT_L(0); PG8_MMA(0, 1, At, B1); PG8_BAR;
            PG8_LDA(At, 1, 1); PG8_STAGE(PG8_SA(1, 0), a3, voffA);
            PG8_BAR; PG8_WAIT_L(0); PG8_MMA(1, 0, At, B0); PG8_BAR; PG8_SCHED;
            PG8_STAGE(PG8_SB(1, 1), b3 + hstep, voffB);
            PG8_WAIT_V(6); PG8_BAR; PG8_MMA(1, 1, At, B1); PG8_BAR;
            }
        }
        if constexpr (ALIGN_EPI) { if (wr == 0) PG8_BAR; }
        if constexpr (!Epi::AFTER_DRAIN) { E(acc, cur, wr, wc, fr, fq); S.done(cur); }
        if (!has_next) break;
#pragma unroll
        for (int a = 0; a < 2; ++a)
#pragma unroll
            for (int b = 0; b < 2; ++b)
#pragma unroll
                for (int m = 0; m < 4; ++m)
#pragma unroll
                    for (int n = 0; n < 2; ++n) acc[a][b][m][n] = (f32x4){0.f, 0.f, 0.f, 0.f};
        cur = nxt; cA = nA; cB = nB; ++ui;
        if constexpr (ALIGN_EPI) { if (wr == 1) PG8_BAR; }
    }
    PG8_WAIT_V(0);
    if constexpr (!ALIGN_EPI) { if (wr == 0) PG8_BAR; }
    PG8_BAR;
    if constexpr (Epi::AFTER_DRAIN) { E.fused(acc, cur, wr, wc, fr, fq, lds, wid, lane); S.done(cur); }
#undef PG8_SA
#undef PG8_SB
#undef PG8_STAGE
#undef PG8_LDA
#undef PG8_LDB
#undef PG8_MMA
#undef PG8_WAIT_V
#undef PG8_WAIT_L
#undef PG8_BAR
#undef PG8_SCHED
}
}
#define GAS __attribute__((address_space(1)))
#define LAS __attribute__((address_space(3)))
typedef unsigned short bf16;
typedef unsigned v4u __attribute__((ext_vector_type(4)));
typedef float f32x4 __attribute__((ext_vector_type(4)));
typedef short bf16x8 __attribute__((ext_vector_type(8)));
typedef GAS unsigned gu32;
typedef GAS unsigned long long gu64;
#define RLX_AGENT __ATOMIC_RELAXED, __HIP_MEMORY_SCOPE_AGENT
#define LDS_WAIT() asm volatile("s_waitcnt lgkmcnt(0)" ::: "memory")
#define VM_WAIT() asm volatile("s_waitcnt vmcnt(0)" ::: "memory")
__device__ __forceinline__ unsigned long long rt() { return __builtin_amdgcn_s_memrealtime(); }
__device__ __forceinline__ unsigned f2bf(float f) { unsigned u = __builtin_bit_cast(unsigned, f); return (u + 0x7fffu + ((u >> 16) & 1u)) >> 16; }
__device__ __forceinline__ unsigned pk2(float lo, float hi) { return f2bf(lo) | (f2bf(hi) << 16); }

#define XB_TMO      128
#define XB_XCNT(j)  (256  + 64 * (j))
#define XB_XSUB(j)  (1280 + 64 * (j))
#define XB_XGEN(j)  (2304 + 64 * (j))
#define XB_TOP      3328
#define XB_TOPGEN   3392
#define XCD_BAR_WORDS 3456
#define XB_SPIN_CAP (1u << 18)

__device__ __forceinline__ unsigned xb_ld(unsigned* p)              { return __hip_atomic_load(p, __ATOMIC_RELAXED, __HIP_MEMORY_SCOPE_AGENT); }
__device__ __forceinline__ unsigned xb_add(unsigned* p, unsigned v) { return __hip_atomic_fetch_add(p, v, __ATOMIC_RELAXED, __HIP_MEMORY_SCOPE_AGENT); }
__device__ __forceinline__ unsigned xb_xcc_id() { return (unsigned)__builtin_amdgcn_s_getreg((3 << 11) | 20) & 0xFu; }
#define XB_SPIN(cond, bar) do { unsigned _sp = 0; while (cond) { __builtin_amdgcn_s_sleep(1); \
    if ((++_sp & 255u) == 0u) { if (xb_ld(&(bar)[XB_TMO])) break; if (_sp > XB_SPIN_CAP) { atomicAdd(&(bar)[XB_TMO], 1u); break; } } } } while (0)

struct XcdBarrier {
    unsigned* bar; unsigned x;
    volatile LAS unsigned* st;
};

__device__ __forceinline__ XcdBarrier xcd_barrier_post(unsigned* bar, volatile LAS unsigned* st) {
    XcdBarrier b; b.bar = bar; b.x = xb_xcc_id(); b.st = st;
    if (threadIdx.x == 0) (void)xb_add(&bar[XB_XCNT(b.x)], 1u);
    return b;
}
__device__ __forceinline__ void xcd_barrier_complete(unsigned* bar, unsigned x, unsigned& nloc, unsigned& nx) {
    const unsigned G = gridDim.x * gridDim.y * gridDim.z;
    unsigned sum, cnt, mine, sp = 0u;
    for (;;) {
        sum = 0u; cnt = 0u; mine = 0u;
#pragma unroll
        for (unsigned j = 0; j < 16; ++j) { const unsigned c = xb_ld(&bar[XB_XCNT(j)]); sum += c; cnt += (c > 0u) ? 1u : 0u; mine = (j == x) ? c : mine; }
        if (sum == G) break;
        __builtin_amdgcn_s_sleep(1);
        if ((++sp & 255u) == 0u) { if (xb_ld(&bar[XB_TMO])) break; if (sp > XB_SPIN_CAP) { atomicAdd(&bar[XB_TMO], 1u); break; } }
    }
    nloc = mine > 0u ? mine : 1u; nx = cnt > 0u ? cnt : 1u;
}

__device__ __forceinline__ void xcd_barrier(const XcdBarrier& b) {
    asm volatile("s_waitcnt vmcnt(0)" ::: "memory");
    __syncthreads();
    if (threadIdx.x == 0) {
        unsigned* bar = b.bar;
        __builtin_amdgcn_s_waitcnt(0);
        unsigned nloc = b.st[0], nx = b.st[1];
        if (nloc == 0u) { xcd_barrier_complete(bar, b.x, nloc, nx); b.st[0] = nloc; b.st[1] = nx; }
        const unsigned old = xb_add(&bar[XB_XSUB(b.x)], 1u);
        const unsigned gen = old / nloc;
        if (old + 1u == (gen + 1u) * nloc) {
            __builtin_amdgcn_fence(__ATOMIC_RELEASE, "agent");
            asm volatile("s_waitcnt vmcnt(0)" ::: "memory");
            const unsigned og = xb_add(&bar[XB_TOP], 1u);
            const unsigned tg = og / nx;
            if (og + 1u == (tg + 1u) * nx) xb_add(&bar[XB_TOPGEN], 1u);
            else XB_SPIN(xb_ld(&bar[XB_TOPGEN]) == tg, bar);
            __builtin_amdgcn_fence(__ATOMIC_ACQUIRE, "agent");
            xb_add(&bar[XB_XGEN(b.x)], 1u);
            asm volatile("s_waitcnt vmcnt(0)" ::: "memory");
        } else {
            XB_SPIN(xb_ld(&bar[XB_XGEN(b.x)]) == gen, bar);
            __builtin_amdgcn_fence(__ATOMIC_ACQUIRE, "agent");
            asm volatile("s_waitcnt vmcnt(0)" ::: "memory");
        }
    }
    __syncthreads();
}
namespace att {
typedef unsigned short bf16;
typedef short bf16x8 __attribute__((ext_vector_type(8)));
typedef short s16x4 __attribute__((ext_vector_type(4)));
typedef short v4i16_t __attribute__((ext_vector_type(4)));
typedef float f32x16 __attribute__((ext_vector_type(16)));
typedef unsigned u32x4 __attribute__((ext_vector_type(4)));
typedef float f32x2_t __attribute__((ext_vector_type(2)));
typedef __bf16 bf16x2_t __attribute__((ext_vector_type(2)));
#define ALDS __attribute__((address_space(3)))
#define ASBAR() __builtin_amdgcn_sched_barrier(0)
constexpr int WS_OFF = 135168;
constexpr int TAB_OFF = WS_OFF + 2048;
constexpr int QR_OFF = 81920;
constexpr int NQL = 6;
constexpr int ATT_LDS_BYTES = TAB_OFF + 2048;
static_assert(QR_OFF + 8 * NQL * 1024 <= WS_OFF, "MLA query park fits below the scratch");
#ifndef ATT_STAGGER
#define ATT_STAGGER 0
#endif
constexpr float THR2 = 8.0f;
__device__ __forceinline__ int crow(int r, int hi) { return (r & 3) + 8 * (r >> 2) + 4 * hi; }
__device__ __forceinline__ void glds16(const void* gsrc, unsigned lds_dst) { unsigned keep;
    asm volatile("s_mov_b32 %0, m0\n\ts_mov_b32 m0, %2\n\ts_nop 0\n\tglobal_load_lds_dwordx4 %1, off\n\ts_mov_b32 m0, %0" : "=&s"(keep) : "v"(gsrc), "s"(lds_dst) : "memory"); }
template <int IMM> __device__ __forceinline__ void glds16s(const void* sbase, unsigned voff, unsigned lds_dst_) { unsigned keep; const unsigned lds_dst = lds_dst_ - (unsigned)IMM;
    asm volatile("s_mov_b32 %0, m0\n\ts_mov_b32 m0, %3\n\ts_nop 3\n\tglobal_load_lds_dwordx4 %1, %2 offset:%c4\n\ts_mov_b32 m0, %0" : "=&s"(keep) : "v"(voff), "s"(sbase), "s"(lds_dst), "i"(IMM) : "memory"); }
__device__ __forceinline__ const unsigned char* uni_ptr(const void* p) { const unsigned long long v = (unsigned long long)p;
    const unsigned lo = __builtin_amdgcn_readfirstlane((unsigned)v), hi = __builtin_amdgcn_readfirstlane((unsigned)(v >> 32)); return (const unsigned char*)(((unsigned long long)hi << 32) | lo); }
__device__ __forceinline__ unsigned cvtpk_s(float lo, float hi) { f32x2_t v = {lo, hi}; bf16x2_t b = __builtin_convertvector(v, bf16x2_t); return __builtin_bit_cast(unsigned, b); }
__device__ __forceinline__ float swapmax(float v) { auto rr = __builtin_amdgcn_permlane32_swap(__float_as_uint(v), __float_as_uint(v), false, false); return fmaxf(__uint_as_float(rr[0]), __uint_as_float(rr[1])); }
__device__ __forceinline__ float swapsum(float v) { auto rr = __builtin_amdgcn_permlane32_swap(__float_as_uint(v), __float_as_uint(v), false, false); return __uint_as_float(rr[0]) + __uint_as_float(rr[1]); }
#define ATT_WAIT_BAR() asm volatile("s_waitcnt vmcnt(0) lgkmcnt(0)\n\ts_barrier" ::: "memory")
#define ATT_WAIT_BAR_N(N) asm volatile("s_waitcnt vmcnt(" #N ") lgkmcnt(0)\n\ts_barrier" ::: "memory")

__device__ __forceinline__ float fadd_s(float a, float b) { float r; asm("v_add_f32_e32 %0, %1, %2" : "=v"(r) : "v"(a), "v"(b)); return r; }
__device__ __forceinline__ s16x4 vtr(ALDS const unsigned char* p) { return __builtin_bit_cast(s16x4, __builtin_amdgcn_ds_read_tr16_b64_v4i16((ALDS v4i16_t*)p)); }

struct AttnArgs { void* prof; const bf16* QKV; const bf16* QM; const bf16* KVM; const bf16* KR; const bf16* GATE; bf16* Y; const float* biastab; const float* subg; float lam; float oml; };

__device__ __forceinline__ void pv4(f32x16* o, int vb, bf16x8 pa0, bf16x8 pa1, bf16x8 pa2, bf16x8 pa3) {
#pragma unroll
    for (int d0 = 0; d0 < 4; ++d0) { s16x4 lo[4], hh[4];
#pragma unroll
        for (int ks = 0; ks < 4; ++ks) {
            asm volatile("ds_read_b64_tr_b16 %0, %1 offset:%c2" : "=&v"(lo[ks]) : "v"(vb), "i"(d0 * 4096 + ks * 1024) : "memory");
            asm volatile("ds_read_b64_tr_b16 %0, %1 offset:%c2" : "=&v"(hh[ks]) : "v"(vb), "i"(d0 * 4096 + ks * 1024 + 512) : "memory"); }
        asm volatile("s_waitcnt lgkmcnt(0)" ::: "memory"); ASBAR();
#define ATT_PK(k) (bf16x8){lo[k][0], lo[k][1], lo[k][2], lo[k][3], hh[k][0], hh[k][1], hh[k][2], hh[k][3]}
        o[d0] = __builtin_amdgcn_mfma_f32_32x32x16_bf16(pa0, ATT_PK(0), o[d0], 0, 0, 0);
        o[d0] = __builtin_amdgcn_mfma_f32_32x32x16_bf16(pa1, ATT_PK(1), o[d0], 0, 0, 0);
        o[d0] = __builtin_amdgcn_mfma_f32_32x32x16_bf16(pa2, ATT_PK(2), o[d0], 0, 0, 0);
        o[d0] = __builtin_amdgcn_mfma_f32_32x32x16_bf16(pa3, ATT_PK(3), o[d0], 0, 0, 0);
#undef ATT_PK
    }
}

template <bool DIFF, int MODE = 0>
__device__ __forceinline__ void attn_unit(const AttnArgs& A, int b, int h, int qb, unsigned char* shm) {
    constexpr int ND0 = DIFF ? 4 : 12;
    constexpr int QROWS = DIFF ? 128 : 256;
    constexpr int KSLOT = DIFF ? 16384 : 24576;
    constexpr int NSLOT = 3;
    constexpr int V_OFF = NSLOT * KSLOT;
    constexpr int NDF = DIFF ? 4 : 5;
    static_assert(V_OFF + NSLOT * 16384 <= WS_OFF, "rings fit below the scratch");
    int tid_ = threadIdx.x; asm volatile("" : "+v"(tid_));
    const int tid = tid_, lane = tid & 63, r32 = lane & 31, hi = lane >> 5; const int wid = __builtin_amdgcn_readfirstlane(tid >> 6);
    const int grp = wid >> 2;
    const int map = DIFF ? grp : 0, wrow = DIFF ? (wid & 3) : wid;
    const int q0 = qb * QROWS + wrow * 32;
    const int cw = q0 >> 6;
    const int NT = (qb * QROWS + QROWS) >> 6;
    const int KL = DIFF ? 3 : 2 + grp, VL = 1 + grp;
    const long rowbase = (long)b * SEQ;
    const unsigned lds0 = (unsigned)(uintptr_t)shm;
    ALDS unsigned char* shm3 = (ALDS unsigned char*)shm;
    ALDS float* wsf = (ALDS float*)(shm3 + WS_OFF) + wid * 64;
    ALDS float* tabl = (ALDS float*)(shm3 + TAB_OFF) + map * 256;
    const int vrow = 16 * (wid & 3) + (lane >> 2), vcol = (wid >> 2) * 32 + (lane & 3) * 8;
    constexpr int PITCHB = DIFF ? 6144 : 4096;
    const int krow = 8 * wid + (lane >> 3), kchk = (lane & 7) ^ ((krow >> 1) & 7);
    const unsigned voffK = (unsigned)(krow * PITCHB + kchk * 16), voffV = (unsigned)(vrow * PITCHB + vcol * 2), voffR = (unsigned)(krow * 128 + kchk * 16);
    const unsigned char* kvbase = DIFF ? (const unsigned char*)(A.QKV + rowbase * 3072 + 1024 + h * 128) : (const unsigned char*)(A.KVM + rowbase * 2048 + h * 256);
    const unsigned char* krbase = (const unsigned char*)(A.KR + rowbase * 64);
    const unsigned kd0 = lds0 + wid * 1024, vd0 = lds0 + V_OFF + wid * 1024;
    constexpr int VIMM = DIFF ? 2048 : 256;
#define ATT_DMA_K(t, sl) do { const long _t = (t); const unsigned _so = (unsigned)((sl) * KSLOT); const unsigned char* _b = uni_ptr(kvbase + _t * (64L * PITCHB)); \
        glds16s<0>(_b, voffK, (unsigned)__builtin_amdgcn_readfirstlane(kd0 + _so)); \
        glds16s<128>(_b, voffK, (unsigned)__builtin_amdgcn_readfirstlane(kd0 + 8192 + _so)); \
        if (!DIFF) glds16s<0>(uni_ptr(krbase + _t * (64L * 128)), voffR, (unsigned)__builtin_amdgcn_readfirstlane(kd0 + 16384 + _so)); } while (0)
#define ATT_DMA_V(t, sl) do { const long _t = (t); const unsigned _so = (unsigned)((sl) * 16384); const unsigned char* _b = uni_ptr(kvbase + _t * (64L * PITCHB)); \
        glds16s<VIMM>(_b, voffV, (unsigned)__builtin_amdgcn_readfirstlane(vd0 + _so)); \
        glds16s<VIMM + 128>(_b, voffV, (unsigned)__builtin_amdgcn_readfirstlane(vd0 + 8192 + _so)); } while (0)
    if (MODE < 2) { ATT_DMA_K(0, 0); ATT_DMA_K(1, 1); if (KL > 2 && 2 < NT) ATT_DMA_K(2, 2);
    ATT_DMA_V(0, 0); if (VL > 1) ATT_DMA_V(1, 1); }
    if (DIFF) { ((ALDS float*)(shm3 + TAB_OFF))[tid] = A.biastab[(h * 2 + (tid >> 8)) * 256 + (tid & 255)]; }
    bf16x8 qr[ND0];
    { const bf16* Qw = DIFF ? A.QKV + (rowbase + q0 + r32) * 3072 + h * 128 + map * 64 + hi * 8 : A.QM + (rowbase + q0 + r32) * 1536 + h * 192 + hi * 8;
#pragma unroll
      for (int d0 = 0; d0 < ND0; ++d0) qr[d0] = *reinterpret_cast<const bf16x8*>(Qw + d0 * 16); }
    float boff = 0.f; if (DIFF) boff = A.biastab[(h * 2 + map) * 256];
    float m_ref = 0.f, l_reg = 0.f; f32x16 o[4];
#pragma unroll
    for (int d = 0; d < 4; ++d) o[d] = f32x16{};
    const int kfo = (DIFF ? map * 8192 : 0) + r32 * 128;
    int ko[4];
#pragma unroll
    for (int i = 0; i < 4; ++i) ko[i] = 16 * ((2 * i + hi) ^ ((r32 >> 1) & 7));
    const int vbo = V_OFF + ((lane >> 4) & 1) * 32 + (lane & 3) * 8 + (4 * hi + ((lane & 15) >> 2)) * 64;
    f32x16 S0, S1; float al = 1.f;
    u32x4 pw0, pw1, pw2, pw3; if (MODE >= 1) { pw0 = pw1 = pw2 = pw3 = (u32x4){0u, 0u, 0u, 0u}; }
    s16x4 vAl[4], vAh[4], vBl[4], vBh[4]; bf16x8 kf[8]; bf16x8 kA[4], kB[4]; f32x16 negm; float negv = 3e38f;
    bf16x8 vfix = {1, 2, 3, 4, 5, 6, 7, 8}; if (MODE == 14 || MODE == 15 || MODE == 16) asm volatile("" : "+v"(vfix));
#pragma unroll
    for (int r = 0; r < 16; ++r) negm[r] = 0.f;
#define ATT_MF(acc, a, b) acc = __builtin_amdgcn_mfma_f32_32x32x16_bf16(a, b, acc, 0, 0, 0)
#define ATT_XBAR() asm volatile("s_waitcnt lgkmcnt(0)\n\ts_barrier" ::: "memory")
#define ATT_KFRD(SL) do { ALDS const unsigned char* kp_ = shm3 + (SL) * KSLOT + kfo; \
        _Pragma("unroll") for (int d0 = 0; d0 < 4; ++d0) { kf[2 * d0] = *(ALDS const bf16x8*)(kp_ + ko[d0]); kf[2 * d0 + 1] = *(ALDS const bf16x8*)(kp_ + ko[d0] + 4096); } } while (0)
#define ATT_QK_D(T) do { const float nb_ = (((T) + 2 < cw) ? boff : 0.f) - m_ref;     \
        if (__any(nb_ != negv)) { negv = nb_; _Pragma("unroll") for (int r = 0; r < 16; ++r) negm[r] = nb_; asm volatile("" : "+v"(negm)); } \
        S0 = __builtin_amdgcn_mfma_f32_32x32x16_bf16(kf[0], qr[0], negm, 0, 0, 0); S1 = __builtin_amdgcn_mfma_f32_32x32x16_bf16(kf[1], qr[0], negm, 0, 0, 0); \
        _Pragma("unroll") for (int d0 = 1; d0 < 4; ++d0) { ATT_MF(S0, kf[2 * d0], qr[d0]); ATT_MF(S1, kf[2 * d0 + 1], qr[d0]); } } while (0)
#define ATT_KRD(KB, g) do { _Pragma("unroll") for (int i_ = 0; i_ < 2; ++i_) { const int d0_ = 2 * (g) + i_; \
            KB[2 * i_] = *(ALDS const bf16x8*)(kp_ + (d0_ >> 2) * 8192 + ko[d0_ & 3]); KB[2 * i_ + 1] = *(ALDS const bf16x8*)(kp_ + (d0_ >> 2) * 8192 + ko[d0_ & 3] + 4096); } } while (0)
#define ATT_KMF(KB, g) do { _Pragma("unroll") for (int i_ = 0; i_ < 2; ++i_) { const int d0_ = 2 * (g) + i_; ATT_MF(S0, KB[2 * i_], qr[d0_]); ATT_MF(S1, KB[2 * i_ + 1], qr[d0_]); } } while (0)
#define ATT_QK_M(SL) do { ALDS const unsigned char* kp_ = shm3 + (SL) * KSLOT + kfo; \
        const float nb_ = -m_ref; \
        ATT_KRD(kA, 0); ATT_KRD(kB, 1); \
        if (__all(nb_ == 0.f)) { const f32x16 z16_ = f32x16{};     \
            S0 = __builtin_amdgcn_mfma_f32_32x32x16_bf16(kA[0], qr[0], z16_, 0, 0, 0); S1 = __builtin_amdgcn_mfma_f32_32x32x16_bf16(kA[1], qr[0], z16_, 0, 0, 0); } \
        else { _Pragma("unroll") for (int r = 0; r < 16; ++r) { S0[r] = nb_; S1[r] = nb_; } \
            ATT_MF(S0, kA[0], qr[0]); ATT_MF(S1, kA[1], qr[0]); } \
        ATT_MF(S0, kA[2], qr[1]); ATT_MF(S1, kA[3], qr[1]); ASBAR(); \
        ATT_KRD(kA, 2); ATT_KMF(kB, 1); ASBAR(); \
        ATT_KRD(kB, 3); ATT_KMF(kA, 2); ASBAR(); \
        ATT_KRD(kA, 4); ATT_KMF(kB, 3); ASBAR(); \
        ATT_KRD(kB, 5); ATT_KMF(kA, 4); ASBAR(); \
        ATT_VRDK(vAl, vAh, 0); ATT_KMF(kB, 5); ASBAR(); } while (0)
#define ATT_VRD(VL_, VH_, d0) do { if (MODE == 14 || MODE == 15 || MODE == 16) break; _Pragma("unroll") for (int ks = 0; ks < 4; ++ks) { VL_[ks] = vtr(vp_ + (d0) * 4096 + ks * 1024); VH_[ks] = vtr(vp_ + (d0) * 4096 + ks * 1024 + 512); } } while (0)
#define ATT_VRDK(VL_, VH_, ks) do { if (MODE == 14 || MODE == 15 || MODE == 16) break; _Pragma("unroll") for (int d_ = 0; d_ < 4; ++d_) { VL_[d_] = vtr(vp_ + d_ * 4096 + (ks) * 1024); VH_[d_] = vtr(vp_ + d_ * 4096 + (ks) * 1024 + 512); } } while (0)
#define ATT_MFK(PW, VL_, VH_) do { _Pragma("unroll") for (int d_ = 0; d_ < 4; ++d_) ATT_MF(o[d_], __builtin_bit_cast(bf16x8, PW), ATT_VF(VL_, VH_, d_)); } while (0)
#define ATT_VF(VL_, VH_, k) (MODE == 14 || MODE == 15 || MODE == 16) ? vfix : (bf16x8){VL_[k][0], VL_[k][1], VL_[k][2], VL_[k][3], VH_[k][0], VH_[k][1], VH_[k][2], VH_[k][3]}
#define ATT_MF4(od, VL_, VH_) do { ATT_MF(od, __builtin_bit_cast(bf16x8, pw0), ATT_VF(VL_, VH_, 0)); ATT_MF(od, __builtin_bit_cast(bf16x8, pw1), ATT_VF(VL_, VH_, 1)); \
        ATT_MF(od, __builtin_bit_cast(bf16x8, pw2), ATT_VF(VL_, VH_, 2)); ATT_MF(od, __builtin_bit_cast(bf16x8, pw3), ATT_VF(VL_, VH_, 3)); } while (0)
#define ATT_RESC(AL) do { if (__any((AL) < 1.f)) { l_reg *= (AL); if (hi == 0) wsf[r32] = (AL); asm volatile("s_waitcnt lgkmcnt(0)" ::: "memory"); \
        _Pragma("unroll") for (int r = 0; r < 16; ++r) { const float al_ = wsf[crow(r, hi)]; _Pragma("unroll") for (int d = 0; d < 4; ++d) o[d][r] *= al_; } } } while (0)
    ATT_WAIT_BAR();
    int s0 = 0;
    { ALDS const unsigned char* vp_ = shm3 + vbo; if (DIFF) { ATT_KFRD(0); ATT_QK_D(0); } else ATT_QK_M(0); }
    ATT_XBAR();
    if (MODE != 5 && MODE != 15 && grp) ATT_XBAR();
    for (int j = 0; j < NT; ++j) {
        const int s1 = (s0 == 2) ? 0 : s0 + 1, s2 = (s1 == 2) ? 0 : s1 + 1;
        int nd_ = 0;
        { const int tk_ = j + KL, tv_ = j + VL; const int slk_ = DIFF ? s0 : (grp ? s0 : s2), slv_ = grp ? s2 : s1;
          if (MODE < 2) { if (tk_ < NT) { ATT_DMA_K(tk_, slk_); nd_ += DIFF ? 2 : 3; }
          if (tv_ < NT) { ATT_DMA_V(tv_, slv_); nd_ += 2; } } }
        if ((MODE == 7 || MODE == 14 || MODE == 15 || MODE == 16) && j <= cw) { if (DIFF) ATT_KFRD(s1); l_reg += S0[0] + S1[3]; }
        if (MODE != 1 && MODE != 10 && MODE != 3 && MODE != 7 && MODE != 14 && MODE != 15 && MODE != 16 && j <= cw) {
            if (DIFF) ATT_KFRD(s1);
            if (DIFF && (j + 2 >= cw)) { ALDS const float* tb_ = tabl + (64 * j - q0 - r32 + 192);
#pragma unroll
                for (int r = 0; r < 16; ++r) { const int kk_ = crow(r, hi); S0[r] += tb_[kk_]; S1[r] += tb_[kk_ + 32]; } }
            f32x16 P0, P1;
#pragma unroll
            for (int r = 0; r < 16; ++r) { P0[r] = __builtin_amdgcn_exp2f(S0[r]); P1[r] = __builtin_amdgcn_exp2f(S1[r]); }
            float ps_;
            { float a0_ = fadd_s(P0[0], P1[0]), a1_ = fadd_s(P0[1], P1[1]), a2_ = fadd_s(P0[2], P1[2]), a3_ = fadd_s(P0[3], P1[3]);
#pragma unroll
              for (int r = 4; r < 16; r += 4) { a0_ = fadd_s(a0_, fadd_s(P0[r], P1[r])); a1_ = fadd_s(a1_, fadd_s(P0[r + 1], P1[r + 1])); a2_ = fadd_s(a2_, fadd_s(P0[r + 2], P1[r + 2])); a3_ = fadd_s(a3_, fadd_s(P0[r + 3], P1[r + 3])); }
              ps_ = fadd_s(fadd_s(a0_, a1_), fadd_s(a2_, a3_)); }
            l_reg += ps_;
            pw0 = (u32x4){cvtpk_s(P0[0], P0[1]), cvtpk_s(P0[2], P0[3]), cvtpk_s(P0[4], P0[5]), cvtpk_s(P0[6], P0[7])};
            pw1 = (u32x4){cvtpk_s(P0[8], P0[9]), cvtpk_s(P0[10], P0[11]), cvtpk_s(P0[12], P0[13]), cvtpk_s(P0[14], P0[15])};
            pw2 = (u32x4){cvtpk_s(P1[0], P1[1]), cvtpk_s(P1[2], P1[3]), cvtpk_s(P1[4], P1[5]), cvtpk_s(P1[6], P1[7])};
            pw3 = (u32x4){cvtpk_s(P1[8], P1[9]), cvtpk_s(P1[10], P1[11]), cvtpk_s(P1[12], P1[13]), cvtpk_s(P1[14], P1[15])};
            al = 1.f;
            if (__any(ps_ > 65536.f)) { const float pr_ = swapsum(ps_); const float dl_ = pr_ > 65536.f ? __builtin_amdgcn_logf(pr_) : 0.f; m_ref += dl_; al = __builtin_amdgcn_exp2f(-dl_); }
        }
        if (nd_ == NDF) { if (DIFF) ATT_WAIT_BAR_N(4); else ATT_WAIT_BAR_N(5); } else ATT_WAIT_BAR();
        if (MODE != 1 && MODE != 10 && MODE != 4 && j <= cw) {
            ALDS const unsigned char* vp_ = shm3 + vbo + s0 * 16384;
            if (DIFF) { ATT_VRDK(vAl, vAh, 0); if (j < cw) ATT_QK_D(j + 1); }
            else { if (j < cw) ATT_QK_M(s1); else ATT_VRDK(vAl, vAh, 0); }
            ASBAR();
            ATT_VRDK(vBl, vBh, 1); ASBAR(); ATT_MFK(pw0, vAl, vAh); ASBAR();
            ATT_VRDK(vAl, vAh, 2); ASBAR(); ATT_MFK(pw1, vBl, vBh); ASBAR();
            ATT_VRDK(vBl, vBh, 3); ASBAR(); ATT_MFK(pw2, vAl, vAh); ASBAR();
            ATT_MFK(pw3, vBl, vBh);
            ATT_RESC(al);
        }
        ATT_XBAR();
        s0 = s1;
    }
    if (MODE != 5 && MODE != 15 && !grp) ATT_XBAR();
#undef ATT_DMA_K
#undef ATT_DMA_V
#undef ATT_KFRD
#undef ATT_QK_D
#undef ATT_QK_M
#undef ATT_KRD
#undef ATT_KMF
#undef ATT_VRD
#undef ATT_VRDK
#undef ATT_MFK
#undef ATT_VF
#undef ATT_MF4
#undef ATT_MF
#undef ATT_RESC
#undef ATT_XBAR
    if (MODE >= 1) { asm volatile("" : "+v"(l_reg)); ATT_WAIT_BAR(); if (l_reg == 123456.f) A.Y[tid] = (bf16)(int)(o[0][0] + o[1][1] + o[2][2] + o[3][3] + m_ref); ATT_WAIT_BAR(); return; }
    {
    int tid2_ = threadIdx.x; asm volatile("" : "+v"(tid2_));
    const int lane = tid2_ & 63, r32 = lane & 31, hi = lane >> 5; const int wid = __builtin_amdgcn_readfirstlane(tid2_ >> 6);
    const int map = DIFF ? (wid >> 2) : 0, wrow = DIFF ? (wid & 3) : wid;
    const int q0 = qb * QROWS + wrow * 32;
    ALDS float* wsf = (ALDS float*)(shm3 + WS_OFF) + wid * 64;
    ATT_WAIT_BAR();
    l_reg = swapsum(l_reg);
    if (hi == 0) wsf[32 + r32] = __builtin_amdgcn_rcpf(l_reg);
    asm volatile("s_waitcnt lgkmcnt(0)" ::: "memory");
    float rli[16];
#pragma unroll
    for (int r = 0; r < 16; ++r) rli[r] = wsf[32 + crow(r, hi)];
    ALDS bf16* stg;
    bool writer = true;
    if (DIFF) {
        ALDS float* X = (ALDS float*)(shm3 + (wid & 3) * 16384);
        if (map == 1) {
            const float lam = A.lam;
#pragma unroll
            for (int r = 0; r < 16; ++r) { const float f = rli[r] * lam; const int orow = crow(r, hi);
#pragma unroll
                for (int d = 0; d < 4; ++d) X[orow * 128 + d * 32 + r32] = o[d][r] * f; }
        }
        ATT_WAIT_BAR();
        stg = (ALDS bf16*)(shm3 + (wid & 3) * 16384);
        if (map == 0) {
            float g4[4];
#pragma unroll
            for (int d = 0; d < 4; ++d) g4[d] = A.subg[d * 32 + r32] * A.oml;
            float ss[16];
#pragma unroll
            for (int r = 0; r < 16; ++r) { const int orow = crow(r, hi); float s = 0.f;
#pragma unroll
                for (int d = 0; d < 4; ++d) { const float v = o[d][r] * rli[r] - X[orow * 128 + d * 32 + r32]; o[d][r] = v; s += v * v; }
                ss[r] = s; }
#pragma unroll
            for (int r = 0; r < 16; ++r) { float s = ss[r];
                s += __shfl_xor(s, 1); s += __shfl_xor(s, 2); s += __shfl_xor(s, 4); s += __shfl_xor(s, 8); s += __shfl_xor(s, 16);
                ss[r] = 1.0f / sqrtf(s * (1.0f / 128.0f) + EPS); }
            asm volatile("s_waitcnt lgkmcnt(0)" ::: "memory");
#pragma unroll
            for (int r = 0; r < 16; ++r) { const int orow = crow(r, hi);
#pragma unroll
                for (int d = 0; d < 4; ++d) stg[orow * 128 + d * 32 + r32] = (bf16)(cvtpk_s(o[d][r] * ss[r] * g4[d], 0.f) & 0xffffu); }
        } else writer = false;
    } else {
        stg = (ALDS bf16*)(shm3 + wid * 8192);
#pragma unroll
        for (int r = 0; r < 16; ++r) { const int orow = crow(r, hi);
#pragma unroll
            for (int d = 0; d < 4; ++d) stg[orow * 128 + d * 32 + r32] = (bf16)(cvtpk_s(o[d][r] * rli[r], 0.f) & 0xffffu); }
    }
    if (writer) {
        asm volatile("s_waitcnt lgkmcnt(0)" ::: "memory");
        const int gcol = (DIFF ? 0 : 1024) + h * 128;
#pragma unroll
        for (int i = 0; i < 8; ++i) { const int row = i * 4 + (lane >> 4), ch = lane & 15;
            const u32x4 ov = *(ALDS const u32x4*)(stg + row * 128 + ch * 8);
            const size_t gi = (size_t)(rowbase + q0 + row) * 2048 + gcol + ch * 8;
            const u32x4 gv = *(const u32x4*)(A.GATE + gi);
            u32x4 yv;
#pragma unroll
            for (int e = 0; e < 4; ++e) {
                const float o_lo = __uint_as_float(ov[e] << 16), o_hi = __uint_as_float(ov[e] & 0xffff0000u);
                const float g_lo = __uint_as_float(gv[e] << 16), g_hi = __uint_as_float(gv[e] & 0xffff0000u);
                const float s_lo = g_lo * __builtin_amdgcn_rcpf(1.0f + __builtin_amdgcn_exp2f(-g_lo * LOG2E));
                const float s_hi = g_hi * __builtin_amdgcn_rcpf(1.0f + __builtin_amdgcn_exp2f(-g_hi * LOG2E));
                yv[e] = cvtpk_s(o_lo * s_lo, o_hi * s_hi); }
            *(u32x4*)(A.Y + gi) = yv; }
    }
    ATT_WAIT_BAR();
    }
}
#undef ASBAR
}
constexpr size_t MiB = 1u << 20;
constexpr size_t WS_CTL = 0, CTL_ZERO_BYTES = 1 * MiB;
constexpr size_t WS_ROPEC = 1 * MiB, WS_ROPES = WS_ROPEC + 512 * 1024;
constexpr size_t WS_SMALL = 2 * MiB;
constexpr size_t SM_BIAS = 1024, SM_RSQ = 128 * 1024, SM_RSKV = 256 * 1024;
constexpr size_t WS_WIN = 4 * MiB;
constexpr size_t WS_WQB = 52 * MiB;
constexpr size_t WS_WKVB = 55 * MiB;
constexpr size_t WS_WOUT = 57 * MiB;
constexpr size_t WS_H = 80 * MiB;
constexpr size_t WS_Y = WS_H;
constexpr size_t WS_QKV = 144 * MiB;
constexpr size_t WS_CQ = 240 * MiB;
constexpr size_t WS_CKV = 256 * MiB;
constexpr size_t WS_KR = 264 * MiB;
constexpr size_t WS_GATE = 272 * MiB;
constexpr size_t WS_QM = 336 * MiB;
constexpr size_t WS_KVM = 384 * MiB;
constexpr size_t WS_END = 448 * MiB;
constexpr int CW_BAR = 4096;
constexpr size_t CTL_SSQ = 65536;

constexpr int RING_OFF = 0, RING_BYTES = 139264;
constexpr int LDSCTL_OFF = RING_BYTES, MISC_OFF = LDSCTL_OFF + 320;
constexpr int LDS_BYTES = 147456;
constexpr int NWAVES = 8;
static_assert(att::ATT_LDS_BYTES <= RING_BYTES, "attention scratch fits the ring region");

__device__ __forceinline__ float wave_sum(float v) {
#pragma unroll
    for (int o = 1; o < 64; o <<= 1) v += __shfl_xor(v, o);
    return v;
}
__device__ __forceinline__ int in_srccol(int n) {
    if (n < 3840) return n;
    if (n < 3904) { const int p = n - 3840, a = p >> 3, j = p & 7; return 3840 + (j < 4 ? 4 * a + j : 32 + 4 * a + (j - 4)); }
    if (n < 4096) return -1;
    return n - 192;
}
__device__ __forceinline__ int qb_srccol(int n) {
    const int hh = n / 192, off = n - hh * 192; if (off < 128) return n;
    const int p = off - 128, a = p >> 3, j = p & 7; return hh * 192 + 128 + (j < 4 ? 4 * a + j : 32 + 4 * a + (j - 4));
}
template <int MODE>
__device__ __forceinline__ void transpose_item(const float* W, int K, int Nsrc, int Ndst, bf16* WT, const float* gk, LAS float* scr, int item, int lane) {
    const int nblk = Ndst / 32, kb = item / nblk, nb = item - kb * nblk, k0 = 64 * kb, n0 = 32 * nb;
    const int nd = n0 + (lane & 31);
    const int src = (MODE == 1) ? in_srccol(nd) : (MODE == 2) ? qb_srccol(nd) : nd;
    float v[32];
#pragma unroll
    for (int i = 0; i < 32; ++i) { const int kk = 2 * i + (lane >> 5); v[i] = 0.f;
        if (src >= 0) { v[i] = W[(size_t)(k0 + kk) * Nsrc + src]; if (gk) v[i] *= gk[k0 + kk]; } }
#pragma unroll
    for (int i = 0; i < 32; ++i) { const int kk = 2 * i + (lane >> 5); scr[kk * 33 + (lane & 31)] = v[i]; }
    LDS_WAIT(); asm volatile("" ::: "memory");
    const int c = lane & 7;
#pragma unroll
    for (int j = 0; j < 4; ++j) { const int n = (lane >> 3) + 8 * j; const LAS float* s = scr + (8 * c) * 33 + n;
        v4u o; o.x = pk2(s[0 * 33], s[1 * 33]); o.y = pk2(s[2 * 33], s[3 * 33]); o.z = pk2(s[4 * 33], s[5 * 33]); o.w = pk2(s[6 * 33], s[7 * 33]);
        *(GAS v4u*)(WT + (size_t)(n0 + n) * K + k0 + 8 * c) = o; }
    LDS_WAIT(); asm volatile("" ::: "memory");
}
__device__ __forceinline__ void rms_row_to_bf16(const float* xrow, const float* g, bf16* orow, int lane) {
    const GAS f32x4* xr = (const GAS f32x4*)xrow + lane; const GAS f32x4* gr = (const GAS f32x4*)g + lane;
    f32x4 v[8]; float s = 0.f;
#pragma unroll
    for (int j = 0; j < 8; ++j) { v[j] = xr[64 * j]; s += (v[j].x * v[j].x + v[j].y * v[j].y) + (v[j].z * v[j].z + v[j].w * v[j].w); }
    const float rstd = 1.0f / sqrtf(wave_sum(s) * (1.0f / DM) + EPS);
    GAS unsigned long long* o8 = (GAS unsigned long long*)orow + lane;
#pragma unroll
    for (int j = 0; j < 8; ++j) { const f32x4 gg = gr[64 * j];
        o8[64 * j] = (unsigned long long)pk2(v[j].x * rstd * gg.x, v[j].y * rstd * gg.y) | ((unsigned long long)pk2(v[j].z * rstd * gg.z, v[j].w * rstd * gg.w) << 32); }
}
__device__ __forceinline__ void rms_row_f32(const float* xrow, const float* g, float* orow, int lane) {
    const GAS f32x4* xr = (const GAS f32x4*)xrow + lane; const GAS f32x4* gr = (const GAS f32x4*)g + lane;
    f32x4 v[8]; float s = 0.f;
#pragma unroll
    for (int j = 0; j < 8; ++j) { v[j] = xr[64 * j]; s += (v[j].x * v[j].x + v[j].y * v[j].y) + (v[j].z * v[j].z + v[j].w * v[j].w); }
    const float rstd = 1.0f / sqrtf(wave_sum(s) * (1.0f / DM) + EPS);
    GAS f32x4* o4 = (GAS f32x4*)orow + lane;
#pragma unroll
    for (int j = 0; j < 8; ++j) { const f32x4 gg = gr[64 * j]; o4[64 * j] = v[j] * rstd * gg; }
}
__device__ __forceinline__ int rel_bucket(int rel) {
    const int n = rel < 0 ? -rel : rel; int bk;
    if (n < 8) bk = n; else if (n < 12) bk = 8; else if (n < 16) bk = 9; else if (n < 23) bk = 10; else if (n < 32) bk = 11;
    else if (n < 46) bk = 12; else if (n < 64) bk = 13; else if (n < 91) bk = 14; else bk = 15;
    return (rel > 0 ? 16 : 0) + bk;
}

struct Args { const float* in[12]; float* out; unsigned char* ws; int ph_lo, ph_hi; };
constexpr int N_PHASES = 11;

#define IN(k) (lo <= (k) && (k) < hi)
#ifndef MK_REP_G23
#define MK_REP_G23 1
#endif
#ifndef MK_REP_G4
#define MK_REP_G4 1
#endif
#ifndef MK_REP_NORM
#define MK_REP_NORM 1
#endif
#ifndef MK_REP_RS
#define MK_REP_RS 1
#endif
#ifndef MK_ATT_MIX
#define MK_ATT_MIX 1
#endif
#ifndef MK_ATT_PROBE
#define MK_ATT_PROBE 0
#endif
#ifndef MK_REP_G1
#define MK_REP_G1 1
#endif
#ifndef MK_REP_P0
#define MK_REP_P0 1
#endif
#ifndef MK_CG_ONLY
#define MK_CG_ONLY 0
#endif
#ifdef MK_STAMP
#define STAMP(k) do { if (blockIdx.x == 0 && threadIdx.x == 0) WSP(unsigned long long, WS_SMALL + 64)[(k)] = __builtin_amdgcn_s_memrealtime(); } while (0)
#else
#define STAMP(k) do { } while (0)
#endif
#define SEAM(k) do { if (IN(k) && IN((k) + 1)) { if (MK_CG_ONLY || (k) == 0) grid.sync(); else xcd_barrier(bar); } STAMP((k) + 1); } while (0)
#define WSP(T, off) ((T*)(args.ws + (off)))

__device__ __forceinline__ void prologue_phase(const Args& args, unsigned char* lds, int G, int vcu) {
    int tid_ = threadIdx.x; asm volatile("" : "+v"(tid_));
    const int tid = tid_, lane = tid & 63, wave = __builtin_amdgcn_readfirstlane(tid >> 6);
    const int gw = vcu * NWAVES + wave, NGW = G * NWAVES;
    const float* x = args.in[0]; const float* norm_g = args.in[1]; const float* w_in = args.in[2]; const float* diff_lambda = args.in[3];
    const float* qnorm_g = args.in[5]; const float* w_qb = args.in[6]; const float* kvnorm_g = args.in[7];
    const float* w_kvb = args.in[8]; const float* w_out = args.in[9]; const float* rel_bias = args.in[10];
    float* ropec = WSP(float, WS_ROPEC); float* ropes = WSP(float, WS_ROPES); float* smallf = WSP(float, WS_SMALL); float* biastab = WSP(float, WS_SMALL + SM_BIAS);
    bf16* Win_t = WSP(bf16, WS_WIN); bf16* Wqb_t = WSP(bf16, WS_WQB); bf16* Wkvb_t = WSP(bf16, WS_WKVB); bf16* Wout_t = WSP(bf16, WS_WOUT); bf16* Hb = WSP(bf16, WS_H);
    LAS float* scr = (LAS float*)((LAS unsigned char*)lds + RING_OFF + wave * 16384);
    constexpr int I_IN = (DM / 64) * (NINP / 32), I_QB = (QLORA / 64) * (NQB / 32), I_KVB = (KVLORA / 64) * (NKVB / 32), I_OUT = (DM / 64) * (DM / 32);
    constexpr int PER_L = I_IN + I_QB + I_KVB + I_OUT;
    for (int it = gw; it < DEPTH * PER_L; it += NGW) {
        const int l = it / PER_L; int r = it - l * PER_L;
        if (r < I_IN) { transpose_item<1>(w_in + (size_t)l * DM * NIN, DM, NIN, NINP, Win_t + (size_t)l * NINP * DM, nullptr, scr, r, lane); continue; } r -= I_IN;
        if (r < I_QB) { transpose_item<2>(w_qb + (size_t)l * QLORA * NQB, QLORA, NQB, NQB, Wqb_t + (size_t)l * NQB * QLORA, qnorm_g + l * QLORA, scr, r, lane); continue; } r -= I_QB;
        if (r < I_KVB) { transpose_item<0>(w_kvb + (size_t)l * KVLORA * NKVB, KVLORA, NKVB, NKVB, Wkvb_t + (size_t)l * NKVB * KVLORA, kvnorm_g + l * KVLORA, scr, r, lane); continue; } r -= I_KVB;
        transpose_item<0>(w_out + (size_t)l * DM * DM, DM, DM, DM, Wout_t + (size_t)l * DM * DM, nullptr, scr, r, lane);
    }
    const int gt = vcu * (NWAVES * 64) + tid, NGT = G * NWAVES * 64;
    for (int e = gt; e < SEQ * 32; e += NGT) { const int s = e >> 5, i = e & 31;
        const float inv = powf(10000.0f, -(float)i * (1.0f / 32.0f)); const float ang = (float)s * inv;
        ropec[e] = cosf(ang); ropes[e] = sinf(ang); }
    for (int e = gt; e < 16 * 256; e += NGT) { const int mh = e >> 8, idx = e & 255; biastab[e] = rel_bias[rel_bucket(idx - 192) * 16 + mh] * LOG2E; }
    if (gt < DEPTH) { const float* lp = diff_lambda + gt * 256; float s01 = 0.f, s23 = 0.f;
        for (int i = 0; i < 64; ++i) { s01 += lp[i] * lp[64 + i]; s23 += lp[128 + i] * lp[192 + i]; }
        const float lam_init = 0.8f - 0.6f * expf(-0.3f * (float)gt);
        smallf[gt] = expf(s01) - expf(s23) + lam_init; smallf[8 + gt] = 1.0f - lam_init; }
    for (int m = gw; m < MROWS; m += NGW) rms_row_to_bf16(x + (size_t)m * DM, norm_g, Hb + (size_t)m * DM, lane);
}

template <int L>
__device__ __forceinline__ void layer_phases(const Args& args, unsigned char* lds, cg::grid_group& grid, const XcdBarrier& bar, int lo, int hi, int G, int bx, int vcu) {
    constexpr int pb = 1 + 5 * L;
    LAS unsigned char* ldsl = (LAS unsigned char*)lds;
#ifdef MK_CLK
    if (L == 0 && blockIdx.x == 0 && threadIdx.x == 0) { unsigned long long* ts = WSP(unsigned long long, WS_SMALL + 64); ts[10] = __builtin_amdgcn_s_memtime(); ts[11] = __builtin_amdgcn_s_memrealtime(); }
#endif
    if (IN(pb)) {
        pg8::Gemm g{WSP(bf16, WS_H), WSP(bf16, WS_WIN) + (size_t)L * NINP * DM, MROWS, NINP, DM}; pg8::StaticOrder S; S.init(MROWS, NINP, G, bx);
        pg8::EpiInProj E{WSP(bf16, WS_QKV), WSP(bf16, WS_CQ), WSP(bf16, WS_CKV), WSP(bf16, WS_KR), WSP(bf16, WS_GATE), WSP(float, WS_ROPEC), WSP(float, WS_ROPES), WSP(float, WS_CTL + CTL_SSQ + (size_t)(2 * L) * 65536), WSP(float, WS_CTL + CTL_SSQ + (size_t)(2 * L + 1) * 65536)};
        for (int rep_ = 0; rep_ < MK_REP_G1; ++rep_)
        pg8::gemm_phase<pg8::EpiInProj, pg8::StaticOrder, true, true>(ldsl + RING_OFF, g, S, E);
    }
#ifdef MK_CLK
    if (L == 0 && blockIdx.x == 0 && threadIdx.x == 0) { unsigned long long* ts = WSP(unsigned long long, WS_SMALL + 64); ts[12] = __builtin_amdgcn_s_memtime(); ts[13] = __builtin_amdgcn_s_memrealtime(); }
#endif
    SEAM(pb);
    if (IN(pb + 1)) for (int rep_ = 0; rep_ < MK_REP_G23; ++rep_) {
        { pg8::Gemm g{WSP(bf16, WS_CQ), WSP(bf16, WS_WQB) + (size_t)L * NQB * QLORA, MROWS, NQB, QLORA}; pg8::StaticOrder S; S.init(MROWS, NQB, G, bx);
          pg8::EpiRowScale<true> E{WSP(bf16, WS_QM), NQB, WSP(float, WS_CTL + CTL_SSQ + (size_t)(2 * L) * 65536), 1.0f / QLORA, WSP(float, WS_ROPEC), WSP(float, WS_ROPES), 0.07216878364870323f * LOG2E};
#ifndef NO_G2
          pg8::gemm_phase<pg8::EpiRowScale<true>, pg8::StaticOrder, true, true>(ldsl + RING_OFF, g, S, E);
#endif
        }
        { pg8::Gemm g{WSP(bf16, WS_CKV), WSP(bf16, WS_WKVB) + (size_t)L * NKVB * KVLORA, MROWS, NKVB, KVLORA}; pg8::KvOrder S; S.init(MROWS, NKVB, G, bx);
          pg8::EpiRowScale<false> E{WSP(bf16, WS_KVM), NKVB, WSP(float, WS_CTL + CTL_SSQ + (size_t)(2 * L + 1) * 65536), 1.0f / KVLORA, nullptr, nullptr, 1.0f};
#ifndef NO_G3
          pg8::gemm_phase<pg8::EpiRowScale<false>, pg8::KvOrder, true, true>(ldsl + RING_OFF, g, S, E);
#endif
        }
    }
    SEAM(pb + 1);
#ifdef MK_CLK
    if (L == 0 && blockIdx.x == 0 && threadIdx.x == 0) { unsigned long long* ts = WSP(unsigned long long, WS_SMALL + 64); ts[2] = __builtin_amdgcn_s_memtime(); ts[3] = __builtin_amdgcn_s_memrealtime(); }
#endif
    if (IN(pb + 2)) {
        const float* smallf = WSP(float, WS_SMALL);
        att::AttnArgs A{WSP(void, WS_CTL + 524288), WSP(bf16, WS_QKV), WSP(bf16, WS_QM), WSP(bf16, WS_KVM), WSP(bf16, WS_KR), WSP(bf16, WS_GATE), WSP(bf16, WS_Y), WSP(float, WS_SMALL + SM_BIAS), args.in[4] + L * 128, smallf[L], smallf[8 + L]};
        for (int p = vcu; p < 256; p += G) {
            const int bh = p >> 3, s = p & 7, b = bh >> 3, h = bh & 7;
            for (int pass_ = 0; pass_ < 2; ++pass_) {
                const bool mla_ = ((pass_ == 0) == ((s & 1) == 0)) || !MK_ATT_MIX;
                if (MK_ATT_MIX ? mla_ : pass_ == 0) { for (int i = 0; i < 2; ++i) att::attn_unit<false>(A, b, h, i == 0 ? 15 - s : s, lds + RING_OFF); }
                else { for (int i = 0; i < 4; ++i) att::attn_unit<true>(A, b, h, i == 0 ? 31 - 2 * s : i == 1 ? 30 - 2 * s : i == 2 ? 2 * s + 1 : 2 * s, lds + RING_OFF); }
            }
#if MK_ATT_PROBE
#ifndef MK_ATT_PROBE_KIND
#define MK_ATT_PROBE_KIND 3
#endif
            if (MK_ATT_PROBE_KIND & 1) for (int i = 0; i < 2; ++i) att::attn_unit<false, MK_ATT_PROBE>(A, b, h, i == 0 ? 15 - s : s, lds + RING_OFF);
            if (MK_ATT_PROBE_KIND & 2) for (int i = 0; i < 4; ++i) att::attn_unit<true, MK_ATT_PROBE>(A, b, h, i == 0 ? 31 - 2 * s : i == 1 ? 30 - 2 * s : i == 2 ? 2 * s + 1 : 2 * s, lds + RING_OFF);
#endif
        }
    }
#ifdef MK_CLK
    if (L == 0 && blockIdx.x == 0 && threadIdx.x == 0) { unsigned long long* ts = WSP(unsigned long long, WS_SMALL + 64); ts[4] = __builtin_amdgcn_s_memtime(); ts[5] = __builtin_amdgcn_s_memrealtime(); }
#endif
    SEAM(pb + 2);
    if (IN(pb + 3)) {
        pg8::Gemm g{WSP(bf16, WS_Y), WSP(bf16, WS_WOUT) + (size_t)L * DM * DM, MROWS, DM, DM}; pg8::StaticOrder S; S.init(MROWS, DM, G, bx);
        pg8::EpiResF32 E{L == 0 ? args.in[0] : (const float*)args.out, args.out, DM};
        for (int rep_ = 0; rep_ < (L == 0 ? MK_REP_G4 : 1); ++rep_)
        pg8::gemm_phase<pg8::EpiResF32, pg8::StaticOrder, true, true>(ldsl + RING_OFF, g, S, E);
    }
    SEAM(pb + 3);
    if (IN(pb + 4)) {
        int tid_ = threadIdx.x; asm volatile("" : "+v"(tid_));
        const int lane = tid_ & 63, wave = __builtin_amdgcn_readfirstlane(tid_ >> 6); const int gw = vcu * NWAVES + wave, NGW = G * NWAVES;
        if (L == 0) { const float* X1 = args.out; bf16* Hb = WSP(bf16, WS_H); const float* g = args.in[1] + DM;
            for (int rep_ = 0; rep_ < MK_REP_NORM; ++rep_) for (int m = gw; m < MROWS; m += NGW) rms_row_to_bf16(X1 + (size_t)m * DM, g, Hb + (size_t)m * DM, lane); }
        else { const float* g = args.in[11]; float* out = args.out;
            for (int m = gw; m < MROWS; m += NGW) rms_row_f32(out + (size_t)m * DM, g, out + (size_t)m * DM, lane); }
    }
    SEAM(pb + 4);
}

__global__ void __launch_bounds__(NWAVES * 64, 2) mk_fwd(Args args) {
    extern __shared__ __attribute__((aligned(16))) unsigned char lds[];
    cg::grid_group grid = cg::this_grid();
    const int G = gridDim.x; const int bx = blockIdx.x; const int vcu = (G % 8 == 0) ? (bx % 8) * (G / 8) + bx / 8 : bx;
    const int lo = args.ph_lo, hi = args.ph_hi;
    volatile LAS unsigned* MISC = (volatile LAS unsigned*)((LAS unsigned char*)lds + MISC_OFF);
    if (threadIdx.x < 32) MISC[threadIdx.x] = 0u;
    __syncthreads();
    const XcdBarrier bar = xcd_barrier_post(WSP(unsigned, WS_CTL) + CW_BAR, MISC + 8);
    STAMP(0);
#ifdef MK_UB
    {
        typedef short ub8 __attribute__((ext_vector_type(8))); typedef float uf16 __attribute__((ext_vector_type(16))); typedef short us4 __attribute__((ext_vector_type(4)));
        LAS unsigned char* lb_ = (LAS unsigned char*)lds + (threadIdx.x & 63) * 16 + (threadIdx.x >> 6) * 8192;
        ub8 a_, b_; for (int i = 0; i < 8; ++i) { a_[i] = (short)(0x3c00 + threadIdx.x + i); b_[i] = (short)(0x3a00 + i); }
        for (int i = 0; i < 8; ++i) *(LAS ub8*)(lb_ + i * 1024) = a_;
        __syncthreads();
        uf16 acc_; for (int i = 0; i < 16; ++i) acc_[i] = 0.f;
        float x_[12]; for (int i = 0; i < 12; ++i) x_[i] = 0.001f * (float)(threadIdx.x + i);
        ub8 nx_ = *(LAS const ub8*)(lb_);
        for (int it = 0; it < MK_UB_IT; ++it) {
            ub8 cur_ = a_;
            if (MK_UB_LDS == 1) cur_ = *(LAS const ub8*)(lb_ + (it & 7) * 1024);
            if (MK_UB_LDS == 2) { cur_ = nx_; nx_ = *(LAS const ub8*)(lb_ + ((it + 1) & 7) * 1024); }
            if (MK_UB_LDS == 3) { cur_ = nx_; const us4 l_ = __builtin_bit_cast(us4, __builtin_amdgcn_ds_read_tr16_b64_v4i16((LAS us4*)(lb_ - (threadIdx.x & 63) * 8 + ((it + 1) & 7) * 1024))), h_ = __builtin_bit_cast(us4, __builtin_amdgcn_ds_read_tr16_b64_v4i16((LAS us4*)(lb_ - (threadIdx.x & 63) * 8 + ((it + 1) & 7) * 1024 + 512))); nx_ = (ub8){l_[0], l_[1], l_[2], l_[3], h_[0], h_[1], h_[2], h_[3]}; }
#if MK_UB_ACC == 1
            asm volatile("v_mfma_f32_32x32x16_bf16 %0, %1, %2, %0" : "+a"(acc_) : "v"(cur_), "v"(b_));
#elif MK_UB_ACC == 2
            asm volatile("v_mfma_f32_32x32x16_bf16 %0, %1, %2, %0" : "+v"(acc_) : "v"(cur_), "v"(b_));
#else
            acc_ = __builtin_amdgcn_mfma_f32_32x32x16_bf16(cur_, b_, acc_, 0, 0, 0);
#endif
#pragma unroll
            for (int i = 0; i < MK_UB_N; ++i) { if (MK_UB_EXP) x_[i] = __builtin_amdgcn_exp2f(x_[i]); else x_[i] = fmaf(x_[i], 0.999f, 0.001f); asm volatile("" : "+v"(x_[i])); }
            __builtin_amdgcn_sched_barrier(0);
        }
        float sum_ = acc_[0] + acc_[5]; for (int i = 0; i < 12; ++i) sum_ += x_[i];
        if (sum_ == 123456.789f) args.out[threadIdx.x] = sum_;
        __syncthreads();
    }
#endif
    if (IN(0)) { for (int rep_ = 0; rep_ < MK_REP_P0; ++rep_) prologue_phase(args, lds, G, vcu); }
    SEAM(0);
    layer_phases<0>(args, lds, grid, bar, lo, hi, G, bx, vcu);
    layer_phases<1>(args, lds, grid, bar, lo, hi, G, bx, vcu);
#ifdef MK_TPROF
    xcd_barrier(bar);
    { const unsigned long long* a_ = WSP(unsigned long long, WS_CTL + 524288); const float n_ = (float)a_[3];
      const float qa = floorf((float)a_[MK_TPROF_A] / n_ * (1.0f / MK_TPROF_Q) + 0.5f), qb = floorf((float)a_[MK_TPROF_B] / n_ * (1.0f / MK_TPROF_Q) + 0.5f);
      float* o = args.out; const int gt = blockIdx.x * 512 + threadIdx.x;
      for (int i = gt; i < MROWS * DM; i += gridDim.x * 512) o[i] = (i == 0) ? 16.f * qb : qa; }
#endif
#ifdef MK_CLK
    xcd_barrier(bar);
    { const unsigned long long* ts = WSP(unsigned long long, WS_SMALL + 64);
      const float ca = (float)(ts[4] - ts[2]) / (float)(ts[5] - ts[3]), cg = (float)(ts[12] - ts[10]) / (float)(ts[13] - ts[11]);
      const float qa = floorf(ca + 0.5f), qg = floorf(cg + 0.5f);
      float* o = args.out; const int gt = blockIdx.x * 512 + threadIdx.x;
      for (int i = gt; i < MROWS * DM; i += gridDim.x * 512) o[i] = (i == 0) ? 16.f * qg : qa; }
#endif
#ifdef MK_STAMP
    xcd_barrier(bar);
    { const unsigned long long* ts = WSP(unsigned long long, WS_SMALL + 64);
      float da = 0.f, db = 0.f;
      for (int p = 0; p < N_PHASES; ++p) { const int kind = p == 0 ? 0 : 1 + (p - 1) % 6; const float d = (float)(ts[p + 1] - ts[p]) * 0.01f; if (kind == MK_STAMP_A) da += d; if (kind == MK_STAMP_B) db += d; }
      float* o = args.out; const int gt = blockIdx.x * 512 + threadIdx.x;
      for (int i = gt; i < MROWS * DM; i += gridDim.x * 512) o[i] = (i == 0) ? 16.f * db : da; }
#endif
}
#undef IN
#undef SEAM
#undef WSP

#ifndef MK_PH_MAX
#define MK_PH_MAX N_PHASES
#endif
#ifndef MK_PH_MIN
#define MK_PH_MIN 0
#endif
#ifndef MK_LAUNCH_PER_PHASE
#define MK_LAUNCH_PER_PHASE 0
#endif
__global__ void diag_fill(float* o, int n, float c) { for (int i = blockIdx.x * 256 + threadIdx.x; i < n; i += gridDim.x * 256) o[i] = c; }
#ifdef MK_UBK
__global__ void __launch_bounds__(512, 2) ub_kernel(float* out) {
    typedef short ub8 __attribute__((ext_vector_type(8))); typedef float uf16 __attribute__((ext_vector_type(16)));
    ub8 a_, b_; for (int i = 0; i < 8; ++i) { a_[i] = (short)(0x3c00 + threadIdx.x + i); b_[i] = (short)(0x3a00 + i); }
    uf16 acc_; for (int i = 0; i < 16; ++i) acc_[i] = 0.f;
    float x_[12]; for (int i = 0; i < 12; ++i) x_[i] = 0.001f * (float)(threadIdx.x + i);
    for (int it = 0; it < MK_UBK_IT; ++it) {
#if MK_UBK_ACC == 1
        asm volatile("v_mfma_f32_32x32x16_bf16 %0, %1, %2, %0" : "+a"(acc_) : "v"(a_), "v"(b_));
#else
        asm volatile("v_mfma_f32_32x32x16_bf16 %0, %1, %2, %0" : "+v"(acc_) : "v"(a_), "v"(b_));
#endif
#pragma unroll
        for (int i = 0; i < MK_UBK_N; ++i) { x_[i] = fmaf(x_[i], 0.999f, 0.001f); asm volatile("" : "+v"(x_[i])); }
        __builtin_amdgcn_sched_barrier(0);
    }
    float sum_ = acc_[0] + acc_[5]; for (int i = 0; i < 12; ++i) sum_ += x_[i];
    if (sum_ == 123456.789f) out[threadIdx.x] = sum_;
}
#endif
extern "C" void kernel_launch(void* const* d_in, const int* in_sizes, int n_in, void* d_out, int out_size, void* d_ws, size_t ws_size, hipStream_t stream) {
    static int grid = 0;
    if (grid == 0) {
        if (n_in != 12 || in_sizes[0] != MROWS * DM || out_size != MROWS * DM || ws_size < WS_END) {
            fprintf(stderr, "kernel_launch: unexpected shapes: n_in %d in0 %d out %d ws %zu (need >= %zu)\n", n_in, n_in > 0 ? in_sizes[0] : -1, out_size, ws_size, (size_t)WS_END);
            const float code = (n_in != 12) ? 30.f : (in_sizes[0] != MROWS * DM) ? 40.f : (out_size != MROWS * DM) ? 50.f : (float)(ws_size >> 26);
            hipLaunchKernelGGL(diag_fill, dim3(1024), dim3(256), 0, stream, (float*)d_out, out_size, code); return; }
        int dev = 0, cus = 0, per_cu = 0;
        if (hipGetDevice(&dev) != hipSuccess || hipDeviceGetAttribute(&cus, hipDeviceAttributeMultiprocessorCount, dev) != hipSuccess) { fprintf(stderr, "kernel_launch: device query failed\n"); grid = -1; return; }
        if (hipFuncSetAttribute((const void*)mk_fwd, hipFuncAttributeMaxDynamicSharedMemorySize, LDS_BYTES) != hipSuccess) { fprintf(stderr, "kernel_launch: hipFuncSetAttribute failed\n"); grid = -1; return; }
        if (hipOccupancyMaxActiveBlocksPerMultiprocessor(&per_cu, (const void*)mk_fwd, NWAVES * 64, LDS_BYTES) != hipSuccess || per_cu < 1) {
            fprintf(stderr, "kernel_launch: occupancy query reports %d workgroups per CU\n", per_cu); (void)hipGetLastError(); per_cu = 1; }
        grid = cus;
        if (grid > 256) grid = 256;
    }
    if (grid < 0) return;
    (void)hipMemsetAsync((char*)d_ws + WS_CTL, 0, CTL_ZERO_BYTES, stream);
#ifdef MK_UBK
    hipLaunchKernelGGL(ub_kernel, dim3(256), dim3(512), 0, stream, (float*)d_ws + (WS_END >> 2) - 4096);
#endif
    Args a{};
    for (int i = 0; i < 12; ++i) a.in[i] = (const float*)d_in[i];
    a.out = (float*)d_out; a.ws = (unsigned char*)d_ws;
#if MK_LAUNCH_PER_PHASE
    for (int p = MK_PH_MIN; p < MK_PH_MAX; ++p) { a.ph_lo = p; a.ph_hi = p + 1; hipLaunchKernelGGL(mk_fwd, dim3(grid), dim3(NWAVES * 64), LDS_BYTES, stream, a); }
    { const hipError_t le = hipPeekAtLastError(); if (le != hipSuccess) fprintf(stderr, "kernel_launch: launch failed: %s\n", hipGetErrorName(le)); }
#else
    a.ph_lo = 0; a.ph_hi = N_PHASES;
    void* kargs[] = {&a};
    const hipError_t e = hipLaunchCooperativeKernel((const void*)mk_fwd, dim3(grid), dim3(NWAVES * 64), kargs, LDS_BYTES, stream);
    if (e != hipSuccess) fprintf(stderr, "kernel_launch: cooperative launch failed: %s (grid %d)\n", hipGetErrorString(e), grid);
#endif
}
```

```cpp
#include <hip/hip_runtime.h>
#include <hip/hip_cooperative_groups.h>
#include <cstdio>
#include <cstdint>
namespace cg = cooperative_groups;

constexpr int BATCH = 4, SEQ = 4096, DM = 2048, MROWS = BATCH * SEQ, DEPTH = 2;
constexpr int NIN = 5952, NINP = 6144;
constexpr int QLORA = 512, KVLORA = 256, NQB = 1536, NKVB = 2048;
constexpr float EPS = 1e-6f;
constexpr float LOG2E = 1.4426950408889634f;
namespace pg8 {
#define PG8_LAS __attribute__((address_space(3)))
typedef unsigned short bf16_t;
typedef short bf16x8 __attribute__((ext_vector_type(8)));
typedef float f32x4 __attribute__((ext_vector_type(4)));
typedef unsigned u32x4 __attribute__((ext_vector_type(4)));
constexpr int BM = 256, BK = 64, HALF = 128, HTB = HALF * BK * 2  , STAGE_BYTES = 8 * HTB, NXCD = 8, WGM = 8;

__host__ __device__ __forceinline__ int lds_byte(int r, int c) { const int st = (r >> 4) * 2 + (c >> 5), rr = r & 15, cc = c & 31, ob = rr * 64 + cc * 2; return st * 1024 + (ob ^ (((ob >> 9) & 1) << 5)); }
__host__ __device__ __forceinline__ void stage_rc(int b, int& R, int& C) { const int st = b / 1024, sb = b % 1024, swz = sb ^ (((sb >> 9) & 1) << 5); R = (st >> 1) * 16 + swz / 64; C = (st & 1) * 32 + (swz % 64) / 2; }
__host__ __device__ __forceinline__ int perm32(int rho) { const int n = rho >> 4, i = rho & 15; return 8 * (i >> 2) + 4 * n + (i & 3); }

struct Unit { int pm, pn; };
struct Gemm { const bf16_t* A; const bf16_t* Bt; int M, N, K; };

struct StaticOrder {
    int nM, nN, nwg, G, c;
    __host__ __device__ void init(int M, int N, int G_, int c_) { nM = M / BM; nN = N / BM; nwg = nM * nN; G = G_; c = c_; }
    __host__ __device__ bool next(int i, Unit& u) const {
        const long L = (long)i * G + c; if (L >= nwg) return false;
        int wgid = (int)L; { const int q = nwg / NXCD, r = nwg % NXCD, xcd = wgid % NXCD, off = wgid / NXCD; wgid = (xcd < r ? xcd * (q + 1) : r * (q + 1) + (xcd - r) * q) + off; }
        const int nig = WGM * nN, gid = wgid / nig, fm = gid * WGM, gsz = (nM - fm) < WGM ? (nM - fm) : WGM;
        u.pm = fm + ((wgid % nig) % gsz); u.pn = (wgid % nig) / gsz; return true;
    }
    __device__ __forceinline__ void a_ready(const Unit&) const {}
    __device__ __forceinline__ void done(const Unit&) const {}
};

__device__ __forceinline__ unsigned cvt_pk_bf16(float lo, float hi) { unsigned r; asm volatile("v_cvt_pk_bf16_f32 %0, %1, %2" : "=v"(r) : "v"(lo), "v"(hi)); return r; }
typedef float f32x2 __attribute__((ext_vector_type(2)));
struct EpiInProj {
    static constexpr bool PERM = true, AFTER_DRAIN = false;
    bf16_t *QKV, *CQ, *CKV, *KR, *GATE; const float* ropec; const float* ropes; float* ssq_q; float* ssq_kv;
    __device__ __forceinline__ void operator()(const f32x4 (&acc)[2][2][4][2], const Unit& u, int wr, int wc, int fr, int fq) const {
        const int row0 = u.pm * BM + wr * 64 + fr; const int pn = u.pn;
        if (pn == 15) {
            if (wc < 2) {
                const int a = wc * 4 + fq;
#pragma unroll
                for (int ai = 0; ai < 2; ++ai)
#pragma unroll
                    for (int m = 0; m < 4; ++m) { const int row = row0 + ai * HALF + m * 16, s = row & (SEQ - 1);
                        const f32x4 c = *(const f32x4*)(ropec + s * 32 + 4 * a), sn = *(const f32x4*)(ropes + s * 32 + 4 * a);
                        const f32x4 x1 = acc[ai][0][m][0], x2 = acc[ai][0][m][1];
                        const f32x4 y1 = x1 * c - x2 * sn, y2 = x1 * sn + x2 * c;
                        u32x4 w; w.x = cvt_pk_bf16(y1[0], y1[1]); w.y = cvt_pk_bf16(y1[2], y1[3]); w.z = cvt_pk_bf16(y2[0], y2[1]); w.w = cvt_pk_bf16(y2[2], y2[3]);
                        *(u32x4*)(KR + (size_t)row * 64 + 8 * a) = w; }
            }
            return;
        }
        bf16_t* base; int ldc, colt;
        if (pn < 12) { base = QKV; ldc = 3072; colt = pn * 256; }
        else if (pn < 14) { base = CQ; ldc = 512; colt = (pn - 12) * 256; }
        else if (pn == 14) { base = CKV; ldc = 256; colt = 0; }
        else { base = GATE; ldc = 2048; colt = (pn - 16) * 256; }
        const int col0 = colt + wc * 32 + 8 * fq;
        const float sc = (pn < 4) ? 0.125f * 1.4426950408889634f : 1.0f;
#pragma unroll
        for (int ai = 0; ai < 2; ++ai)
#pragma unroll
            for (int m = 0; m < 4; ++m) { bf16_t* rowp = base + (size_t)(row0 + ai * HALF + m * 16) * ldc + col0;
#pragma unroll
                for (int bj = 0; bj < 2; ++bj) { const f32x4 v0 = acc[ai][bj][m][0] * sc, v1 = acc[ai][bj][m][1] * sc;
                    u32x4 w; w.x = cvt_pk_bf16(v0[0], v0[1]); w.y = cvt_pk_bf16(v0[2], v0[3]); w.z = cvt_pk_bf16(v1[0], v1[1]); w.w = cvt_pk_bf16(v1[2], v1[3]);
                    *(u32x4*)(rowp + bj * HALF) = w; } }
        if (pn >= 12 && pn <= 14) {
            float* ssq = (pn == 14) ? ssq_kv : ssq_q;
#pragma unroll
            for (int ai = 0; ai < 2; ++ai)
#pragma unroll
                for (int m = 0; m < 4; ++m) { float s = 0.f;
#pragma unroll
                    for (int bj = 0; bj < 2; ++bj)
#pragma unroll
                        for (int n = 0; n < 2; ++n) { const f32x4 v = acc[ai][bj][m][n]; s += (v[0] * v[0] + v[1] * v[1]) + (v[2] * v[2] + v[3] * v[3]); }
                    s += __shfl_xor(s, 16); s += __shfl_xor(s, 32);
                    if (fq == 0) __hip_atomic_fetch_add(ssq + row0 + ai * HALF + m * 16, s, __ATOMIC_RELAXED, __HIP_MEMORY_SCOPE_AGENT); }
        }
    }
};
template <bool ROPE> struct EpiRowScale {
    static constexpr bool PERM = true, AFTER_DRAIN = false;
    bf16_t* O; int ldc; const float* ssq; float inv_n; const float* ropec; const float* ropes; float qscale;
    __device__ __forceinline__ void operator()(const f32x4 (&acc)[2][2][4][2], const Unit& u, int wr, int wc, int fr, int fq) const {
        const int row0 = u.pm * BM + wr * 64 + fr; const int col0 = u.pn * BM + wc * 32 + 8 * fq;
        bool isr[2]; int ra[2];
#pragma unroll
        for (int bj = 0; bj < 2; ++bj) { const int c0 = col0 + bj * HALF, off = c0 % 192; isr[bj] = ROPE && (off >= 128); ra[bj] = (off - 128) >> 3; }
#pragma unroll
        for (int ai = 0; ai < 2; ++ai)
#pragma unroll
            for (int m = 0; m < 4; ++m) { const int row = row0 + ai * HALF + m * 16, s = row & (SEQ - 1); const float r = qscale / sqrtf(ssq[row] * inv_n + 1e-6f);
                bf16_t* rowp = O + (size_t)row * ldc + col0;
#pragma unroll
                for (int bj = 0; bj < 2; ++bj) { f32x4 v0 = acc[ai][bj][m][0] * r, v1 = acc[ai][bj][m][1] * r;
                    if (ROPE) { if (isr[bj]) { const f32x4 c = *(const f32x4*)(ropec + s * 32 + 4 * ra[bj]), sn = *(const f32x4*)(ropes + s * 32 + 4 * ra[bj]);
                        const f32x4 y1 = v0 * c - v1 * sn, y2 = v0 * sn + v1 * c; v0 = y1; v1 = y2; } }
                    u32x4 w; w.x = cvt_pk_bf16(v0[0], v0[1]); w.y = cvt_pk_bf16(v0[2], v0[3]); w.z = cvt_pk_bf16(v1[0], v1[1]); w.w = cvt_pk_bf16(v1[2], v1[3]);
                    *(u32x4*)(rowp + bj * HALF) = w; } }
    }
};
struct EpiResF32 {
    static constexpr bool PERM = false, AFTER_DRAIN = false;
    const float* base; float* out; int ldc;
    __device__ __forceinline__ void operator()(const f32x4 (&acc)[2][2][4][2], const Unit& u, int wr, int wc, int fr, int fq) const {
        const int row0 = u.pm * BM + wr * 64 + fr, col0 = u.pn * BM + wc * 32 + 4 * fq;
#pragma unroll
        for (int ai = 0; ai < 2; ++ai)
#pragma unroll
            for (int m = 0; m < 4; ++m) { const size_t off = (size_t)(row0 + ai * HALF + m * 16) * ldc + col0;
#pragma unroll
                for (int bj = 0; bj < 2; ++bj)
#pragma unroll
                    for (int n = 0; n < 2; ++n) { const f32x4 bs = *(const f32x4*)(base + off + bj * HALF + n * 16); *(f32x4*)(out + off + bj * HALF + n * 16) = bs + acc[ai][bj][m][n]; } }
    }
};
struct KvOrder : StaticOrder {
    __host__ __device__ bool next(int i, Unit& u) const {
        long L; if (G != 256) { L = (long)i * G + c; if (L >= nwg) return false; }
        else if (c < 128) { if (i > 0) return false; L = c; }
        else { if (i > 2) return false; L = 128 + 3 * (c - 128) + i; }
        int wgid = (int)L; { const int q = nwg / NXCD, r = nwg % NXCD, xcd = wgid % NXCD, off = wgid / NXCD; wgid = (xcd < r ? xcd * (q + 1) : r * (q + 1) + (xcd - r) * q) + off; }
        const int nig = WGM * nN, gid = wgid / nig, fm = gid * WGM, gsz = (nM - fm) < WGM ? (nM - fm) : WGM;
        u.pm = fm + ((wgid % nig) % gsz); u.pn = (wgid % nig) / gsz; return true;
    }
};
template <class Epi, class Sched, bool ALIGN_EPI = false, bool SP2 = false>
__device__ __forceinline__ void gemm_phase(PG8_LAS unsigned char* lds, const Gemm g, const Sched& S, const Epi& E) {
    int tid_ = threadIdx.x; asm volatile("" : "+v"(tid_));
    const int tid = tid_, wid = __builtin_amdgcn_readfirstlane(tid >> 6), lane = tid & 63, wr = wid >> 2, wc = wid & 3, fr = lane & 15, fq = lane >> 4;
    const int K = g.K, nt = K / BK;
    unsigned voffA[2], voffB[2];
#pragma unroll
    for (int i = 0; i < 2; ++i) { int R, C; stage_rc(tid * 16 + i * 8192, R, C); const int Rb = Epi::PERM ? ((R & ~31) + perm32(R & 31)) : R;
        voffA[i] = (unsigned)(R * K + C) * 2u; voffB[i] = (unsigned)(Rb * K + C) * 2u; }
    const size_t kstep = (size_t)(BK * 2);
    const size_t hstep = (size_t)HALF * K * 2;
    const size_t tstep = 2 * hstep;
    const unsigned ldsw = (unsigned)wid * 1024u;
    const int aoff = lds_byte(wr * 64 + fr, fq * 8), boff = lds_byte(wc * 32 + fr, fq * 8);
#define PG8_SA(b, h) (((b) * 2 + (h)) * HTB)
#define PG8_SB(b, h) ((4 + (b) * 2 + (h)) * HTB)
#define PG8_STAGE(bufoff, gbase, voff) do { _Pragma("unroll") for (int _i = 0; _i < 2; ++_i) \
        __builtin_amdgcn_global_load_lds((const unsigned*)((const char*)(gbase) + (voff)[_i]), (PG8_LAS unsigned*)(lds + (bufoff) + ldsw + _i * 8192), 16, 0, 0); } while (0)
#define PG8_LDA(dst, b, h) do { _Pragma("unroll") for (int m = 0; m < 4; ++m) _Pragma("unroll") for (int k = 0; k < 2; ++k) dst[m][k] = *(const PG8_LAS bf16x8*)(lds + PG8_SA(b, h) + aoff + m * 2048 + k * 1024); } while (0)
#define PG8_LDB(dst, b, h) do { _Pragma("unroll") for (int n = 0; n < 2; ++n) _Pragma("unroll") for (int k = 0; k < 2; ++k) dst[n][k] = *(const PG8_LAS bf16x8*)(lds + PG8_SB(b, h) + boff + n * 2048 + k * 1024); } while (0)
#define PG8_MMA(ai, bj, At, Bt) do { __builtin_amdgcn_s_setprio(1); _Pragma("unroll") for (int m = 0; m < 4; ++m) _Pragma("unroll") for (int n = 0; n < 2; ++n) _Pragma("unroll") for (int k = 0; k < 2; ++k) \
        acc[ai][bj][m][n] = __builtin_amdgcn_mfma_f32_16x16x32_bf16(Bt[n][k], At[m][k], acc[ai][bj][m][n], 0, 0, 0); __builtin_amdgcn_s_setprio(0); } while (0)
#define PG8_WAIT_V(n) asm volatile("s_waitcnt vmcnt(" #n ")" ::: "memory")
#define PG8_WAIT_L(n) asm volatile("s_waitcnt lgkmcnt(" #n ")" ::: "memory")
#define PG8_BAR __builtin_amdgcn_s_barrier()
#define PG8_SCHED __builtin_amdgcn_sched_barrier(0)
    Unit cur, nxt; int ui = 0;
    if (!S.next(0, cur)) return;
    f32x4 acc[2][2][4][2];
#pragma unroll
    for (int a = 0; a < 2; ++a)
#pragma unroll
        for (int b = 0; b < 2; ++b)
#pragma unroll
            for (int m = 0; m < 4; ++m)
#pragma unroll
                for (int n = 0; n < 2; ++n) acc[a][b][m][n] = (f32x4){0.f, 0.f, 0.f, 0.f};
    bf16x8 At[4][2], B0[2][2], B1[2][2];
    const char* cA = (const char*)g.A + (size_t)cur.pm * tstep; const char* cB = (const char*)g.Bt + (size_t)cur.pn * tstep;
    S.a_ready(cur);
    if constexpr (SP2) {
        PG8_STAGE(PG8_SB(0, 0), cB, voffB); PG8_STAGE(PG8_SB(0, 1), cB + hstep, voffB); PG8_STAGE(PG8_SA(0, 0), cA, voffA); PG8_STAGE(PG8_SA(0, 1), cA + hstep, voffA);
        if (wr == 1) PG8_BAR;
        PG8_WAIT_V(2); PG8_BAR;
        PG8_STAGE(PG8_SB(1, 0), cB + kstep, voffB); PG8_STAGE(PG8_SA(1, 0), cA + kstep, voffA); PG8_STAGE(PG8_SB(1, 1), cB + hstep + kstep, voffB);
        PG8_WAIT_V(6); PG8_BAR;
    } else {
        PG8_STAGE(PG8_SB(0, 0), cB, voffB); PG8_STAGE(PG8_SA(0, 0), cA, voffA); PG8_STAGE(PG8_SB(0, 1), cB + hstep, voffB); PG8_STAGE(PG8_SA(0, 1), cA + hstep, voffA);
        if (wr == 1) PG8_BAR;
        PG8_WAIT_V(4); PG8_BAR;
        PG8_STAGE(PG8_SB(1, 0), cB + kstep, voffB); PG8_STAGE(PG8_SA(1, 0), cA + kstep, voffA); PG8_STAGE(PG8_SB(1, 1), cB + hstep + kstep, voffB);
        PG8_WAIT_V(6); PG8_BAR;
    }
    for (;;) {
        const bool has_next = S.next(ui + 1, nxt);
        const char* nA = has_next ? (const char*)g.A + (size_t)nxt.pm * tstep : cA; const char* nB = has_next ? (const char*)g.Bt + (size_t)nxt.pn * tstep : cB;
        for (int t = 0; t < nt; t += 2) {
            const bool last = (t == nt - 2);
            const char* a1 = cA + (size_t)(t + 1) * kstep;
            const char* a2 = last ? nA : cA + (size_t)(t + 2) * kstep; const char* b2 = last ? nB : cB + (size_t)(t + 2) * kstep;
            const char* a3 = a2 + kstep; const char* b3 = b2 + kstep;
            if (last && has_next) S.a_ready(nxt);
            if constexpr (SP2) {
            PG8_LDB(B0, 0, 0); PG8_LDB(B1, 0, 1); PG8_SCHED; PG8_LDA(At, 0, 0); PG8_STAGE(PG8_SA(1, 1), a1 + hstep, voffA);
            PG8_WAIT_V(8); PG8_WAIT_L(0); PG8_BAR; PG8_MMA(0, 0, At, B0); PG8_MMA(0, 1, At, B1); PG8_BAR; PG8_SCHED;
            PG8_LDA(At, 0, 1); PG8_STAGE(PG8_SB(0, 0), b2, voffB); PG8_STAGE(PG8_SB(0, 1), b2 + hstep, voffB); PG8_STAGE(PG8_SA(0, 0), a2, voffA);
            PG8_WAIT_V(8); PG8_WAIT_L(0); PG8_BAR; PG8_MMA(1, 0, At, B0); PG8_MMA(1, 1, At, B1); PG8_BAR; PG8_SCHED;
            PG8_LDB(B0, 1, 0); PG8_LDB(B1, 1, 1); PG8_SCHED; PG8_LDA(At, 1, 0); PG8_STAGE(PG8_SA(0, 1), a2 + hstep, voffA);
            PG8_WAIT_V(8); PG8_WAIT_L(0); PG8_BAR; PG8_MMA(0, 0, At, B0); PG8_MMA(0, 1, At, B1); PG8_BAR; PG8_SCHED;
            PG8_LDA(At, 1, 1); PG8_STAGE(PG8_SB(1, 0), b3, voffB); PG8_STAGE(PG8_SB(1, 1), b3 + hstep, voffB); PG8_STAGE(PG8_SA(1, 0), a3, voffA);
            PG8_WAIT_V(8); PG8_WAIT_L(0); PG8_BAR; PG8_MMA(1, 0, At, B0); PG8_MMA(1, 1, At, B1); PG8_BAR; PG8_SCHED;
            } else {
            PG8_LDB(B0, 0, 0); PG8_SCHED; PG8_LDA(At, 0, 0); PG8_STAGE(PG8_SA(1, 1), a1 + hstep, voffA);
            PG8_WAIT_L(8); PG8_BAR; PG8_WAIT_L(0); PG8_MMA(0, 0, At, B0); PG8_BAR; PG8_SCHED;
            PG8_LDB(B1, 0, 1); PG8_STAGE(PG8_SB(0, 0), b2, voffB);
            PG8_BAR; PG8_WAIT_L(0); PG8_MMA(0, 1, At, B1); PG8_BAR;
            PG8_LDA(At, 0, 1); PG8_STAGE(PG8_SA(0, 0), a2, voffA);
            PG8_BAR; PG8_WAIT_L(0); PG8_MMA(1, 0, At, B0); PG8_BAR; PG8_SCHED;
            PG8_STAGE(PG8_SB(0, 1), b2 + hstep, voffB);
            PG8_WAIT_V(6); PG8_BAR; PG8_MMA(1, 1, At, B1); PG8_BAR;
            PG8_LDB(B0, 1, 0); PG8_SCHED; PG8_LDA(At, 1, 0); PG8_STAGE(PG8_SA(0, 1), a2 + hstep, voffA);
            PG8_WAIT_L(8); PG8_BAR; PG8_WAIT_L(0); PG8_MMA(0, 0, At, B0); PG8_BAR; PG8_SCHED;
            PG8_LDB(B1, 1, 1); PG8_STAGE(PG8_SB(1, 0), b3, voffB);
            PG8_BAR; PG8_WAIT_L(0); PG8_MMA(0, 1, At, B1); PG8_BAR;
            PG8_LDA(At, 1, 1); PG8_STAGE(PG8_SA(1, 0), a3, voffA);
            PG8_BAR; PG8_WAIT_L(0); PG8_MMA(1, 0, At, B0); PG8_BAR; PG8_SCHED;
            PG8_STAGE(PG8_SB(1, 1), b3 + hstep, voffB);
            PG8_WAIT_V(6); PG8_BAR; PG8_MMA(1, 1, At, B1); PG8_BAR;
            }
        }
        if constexpr (ALIGN_EPI) { if (wr == 0) PG8_BAR; }
        if constexpr (!Epi::AFTER_DRAIN) { E(acc, cur, wr, wc, fr, fq); S.done(cur); }
        if (!has_next) break;
#pragma unroll
        for (int a = 0; a < 2; ++a)
#pragma unroll
            for (int b = 0; b < 2; ++b)
#pragma unroll
                for (int m = 0; m < 4; ++m)
#pragma unroll
                    for (int n = 0; n < 2; ++n) acc[a][b][m][n] = (f32x4){0.f, 0.f, 0.f, 0.f};
        cur = nxt; cA = nA; cB = nB; ++ui;
        if constexpr (ALIGN_EPI) { if (wr == 1) PG8_BAR; }
    }
    PG8_WAIT_V(0);
    if constexpr (!ALIGN_EPI) { if (wr == 0) PG8_BAR; }
    PG8_BAR;
    if constexpr (Epi::AFTER_DRAIN) { E.fused(acc, cur, wr, wc, fr, fq, lds, wid, lane); S.done(cur); }
#undef PG8_SA
#undef PG8_SB
#undef PG8_STAGE
#undef PG8_LDA
#undef PG8_LDB
#undef PG8_MMA
#undef PG8_WAIT_V
#undef PG8_WAIT_L
#undef PG8_BAR
#undef PG8_SCHED
}
}
#define GAS __attribute__((address_space(1)))
#define LAS __attribute__((address_space(3)))
typedef unsigned short bf16;
typedef unsigned v4u __attribute__((ext_vector_type(4)));
typedef float f32x4 __attribute__((ext_vector_type(4)));
typedef short bf16x8 __attribute__((ext_vector_type(8)));
typedef GAS unsigned gu32;
typedef GAS unsigned long long gu64;
#define RLX_AGENT __ATOMIC_RELAXED, __HIP_MEMORY_SCOPE_AGENT
#define LDS_WAIT() asm volatile("s_waitcnt lgkmcnt(0)" ::: "memory")
#define VM_WAIT() asm volatile("s_waitcnt vmcnt(0)" ::: "memory")
__device__ __forceinline__ unsigned long long rt() { return __builtin_amdgcn_s_memrealtime(); }
__device__ __forceinline__ unsigned f2bf(float f) { unsigned u = __builtin_bit_cast(unsigned, f); return (u + 0x7fffu + ((u >> 16) & 1u)) >> 16; }
__device__ __forceinline__ unsigned pk2(float lo, float hi) { return f2bf(lo) | (f2bf(hi) << 16); }

#define XB_TMO      128
#define XB_XCNT(j)  (256  + 64 * (j))
#define XB_XSUB(j)  (1280 + 64 * (j))
#define XB_XGEN(j)  (2304 + 64 * (j))
#define XB_TOP      3328
#define XB_TOPGEN   3392
#define XCD_BAR_WORDS 3456
#define XB_SPIN_CAP (1u << 18)

__device__ __forceinline__ unsigned xb_ld(unsigned* p)              { return __hip_atomic_load(p, __ATOMIC_RELAXED, __HIP_MEMORY_SCOPE_AGENT); }
__device__ __forceinline__ unsigned xb_add(unsigned* p, unsigned v) { return __hip_atomic_fetch_add(p, v, __ATOMIC_RELAXED, __HIP_MEMORY_SCOPE_AGENT); }
__device__ __forceinline__ unsigned xb_xcc_id() { return (unsigned)__builtin_amdgcn_s_getreg((3 << 11) | 20) & 0xFu; }
#define XB_SPIN(cond, bar) do { unsigned _sp = 0; while (cond) { __builtin_amdgcn_s_sleep(1); \
    if ((++_sp & 255u) == 0u) { if (xb_ld(&(bar)[XB_TMO])) break; if (_sp > XB_SPIN_CAP) { atomicAdd(&(bar)[XB_TMO], 1u); break; } } } } while (0)

struct XcdBarrier {
    unsigned* bar; unsigned x;
    volatile LAS unsigned* st;
};

__device__ __forceinline__ XcdBarrier xcd_barrier_post(unsigned* bar, volatile LAS unsigned* st) {
    XcdBarrier b; b.bar = bar; b.x = xb_xcc_id(); b.st = st;
    if (threadIdx.x == 0) (void)xb_add(&bar[XB_XCNT(b.x)], 1u);
    return b;
}
__device__ __forceinline__ void xcd_barrier_complete(unsigned* bar, unsigned x, unsigned& nloc, unsigned& nx) {
    const unsigned G = gridDim.x * gridDim.y * gridDim.z;
    unsigned sum, cnt, mine, sp = 0u;
    for (;;) {
        sum = 0u; cnt = 0u; mine = 0u;
#pragma unroll
        for (unsigned j = 0; j < 16; ++j) { const unsigned c = xb_ld(&bar[XB_XCNT(j)]); sum += c; cnt += (c > 0u) ? 1u : 0u; mine = (j == x) ? c : mine; }
        if (sum == G) break;
        __builtin_amdgcn_s_sleep(1);
        if ((++sp & 255u) == 0u) { if (xb_ld(&bar[XB_TMO])) break; if (sp > XB_SPIN_CAP) { atomicAdd(&bar[XB_TMO], 1u); break; } }
    }
    nloc = mine > 0u ? mine : 1u; nx = cnt > 0u ? cnt : 1u;
}

__device__ __forceinline__ void xcd_barrier(const XcdBarrier& b) {
    asm volatile("s_waitcnt vmcnt(0)" ::: "memory");
    __syncthreads();
    if (threadIdx.x == 0) {
        unsigned* bar = b.bar;
        __builtin_amdgcn_s_waitcnt(0);
        unsigned nloc = b.st[0], nx = b.st[1];
        if (nloc == 0u) { xcd_barrier_complete(bar, b.x, nloc, nx); b.st[0] = nloc; b.st[1] = nx; }
        const unsigned old = xb_add(&bar[XB_XSUB(b.x)], 1u);
        const unsigned gen = old / nloc;
        if (old + 1u == (gen + 1u) * nloc) {
            __builtin_amdgcn_fence(__ATOMIC_RELEASE, "agent");
            asm volatile("s_waitcnt vmcnt(0)" ::: "memory");
            const unsigned og = xb_add(&bar[XB_TOP], 1u);
            const unsigned tg = og / nx;
            if (og + 1u == (tg + 1u) * nx) xb_add(&bar[XB_TOPGEN], 1u);
            else XB_SPIN(xb_ld(&bar[XB_TOPGEN]) == tg, bar);
            __builtin_amdgcn_fence(__ATOMIC_ACQUIRE, "agent");
            xb_add(&bar[XB_XGEN(b.x)], 1u);
            asm volatile("s_waitcnt vmcnt(0)" ::: "memory");
        } else {
            XB_SPIN(xb_ld(&bar[XB_XGEN(b.x)]) == gen, bar);
            __builtin_amdgcn_fence(__ATOMIC_ACQUIRE, "agent");
            asm volatile("s_waitcnt vmcnt(0)" ::: "memory");
        }
    }
    __syncthreads();
}
namespace att {
typedef unsigned short bf16;
typedef short bf16x8 __attribute__((ext_vector_type(8)));
typedef short s16x4 __attribute__((ext_vector_type(4)));
typedef short v4i16_t __attribute__((ext_vector_type(4)));
typedef float f32x16 __attribute__((ext_vector_type(16)));
typedef unsigned u32x4 __attribute__((ext_vector_type(4)));
typedef float f32x2_t __attribute__((ext_vector_type(2)));
typedef __bf16 bf16x2_t __attribute__((ext_vector_type(2)));
#define ALDS __attribute__((address_space(3)))
#define ASBAR() __builtin_amdgcn_sched_barrier(0)
constexpr int WS_OFF = 135168;
constexpr int TAB_OFF = WS_OFF + 2048;
constexpr int QR_OFF = 81920;
constexpr int NQL = 6;
constexpr int ATT_LDS_BYTES = TAB_OFF + 2048;
static_assert(QR_OFF + 8 * NQL * 1024 <= WS_OFF, "MLA query park fits below the scratch");
#ifndef ATT_PRIO
#define ATT_PRIO 0
#endif
#ifndef ATT_STAGGER
#define ATT_STAGGER 0
#endif
constexpr float THR2 = 8.0f;
__device__ __forceinline__ int crow(int r, int hi) { return (r & 3) + 8 * (r >> 2) + 4 * hi; }
__device__ __forceinline__ void glds16(const void* gsrc, unsigned lds_dst) { unsigned keep;
    asm volatile("s_mov_b32 %0, m0\n\ts_mov_b32 m0, %2\n\ts_nop 0\n\tglobal_load_lds_dwordx4 %1, off\n\ts_mov_b32 m0, %0" : "=&s"(keep) : "v"(gsrc), "s"(lds_dst) : "memory"); }
template <int IMM> __device__ __forceinline__ void glds16s(const void* sbase, unsigned voff, unsigned lds_dst_) { unsigned keep; const unsigned lds_dst = lds_dst_ - (unsigned)IMM;
    asm volatile("s_mov_b32 %0, m0\n\ts_mov_b32 m0, %3\n\ts_nop 3\n\tglobal_load_lds_dwordx4 %1, %2 offset:%c4\n\ts_mov_b32 m0, %0" : "=&s"(keep) : "v"(voff), "s"(sbase), "s"(lds_dst), "i"(IMM) : "memory"); }
__device__ __forceinline__ const unsigned char* uni_ptr(const void* p) { const unsigned long long v = (unsigned long long)p;
    const unsigned lo = __builtin_amdgcn_readfirstlane((unsigned)v), hi = __builtin_amdgcn_readfirstlane((unsigned)(v >> 32)); return (const unsigned char*)(((unsigned long long)hi << 32) | lo); }
__device__ __forceinline__ unsigned cvtpk_s(float lo, float hi) { f32x2_t v = {lo, hi}; bf16x2_t b = __builtin_convertvector(v, bf16x2_t); return __builtin_bit_cast(unsigned, b); }
__device__ __forceinline__ float swapmax(float v) { auto rr = __builtin_amdgcn_permlane32_swap(__float_as_uint(v), __float_as_uint(v), false, false); return fmaxf(__uint_as_float(rr[0]), __uint_as_float(rr[1])); }
__device__ __forceinline__ float swapsum(float v) { auto rr = __builtin_amdgcn_permlane32_swap(__float_as_uint(v), __float_as_uint(v), false, false); return __uint_as_float(rr[0]) + __uint_as_float(rr[1]); }
#define ATT_WAIT_BAR() asm volatile("s_waitcnt vmcnt(0) lgkmcnt(0)\n\ts_barrier" ::: "memory")
#define ATT_WAIT_BAR_N(N) asm volatile("s_waitcnt vmcnt(" #N ") lgkmcnt(0)\n\ts_barrier" ::: "memory")

__device__ __forceinline__ float fadd_s(float a, float b) { float r; asm("v_add_f32_e32 %0, %1, %2" : "=v"(r) : "v"(a), "v"(b)); return r; }
__device__ __forceinline__ s16x4 vtr(ALDS const unsigned char* p) { return __builtin_bit_cast(s16x4, __builtin_amdgcn_ds_read_tr16_b64_v4i16((ALDS v4i16_t*)p)); }

struct AttnArgs { void* prof; const bf16* QKV; const bf16* QM; const bf16* KVM; const bf16* KR; const bf16* GATE; bf16* Y; const float* biastab; const float* subg; float lam; float oml; };

__device__ __forceinline__ void pv4(f32x16* o, int vb, bf16x8 pa0, bf16x8 pa1, bf16x8 pa2, bf16x8 pa3) {
#pragma unroll
    for (int d0 = 0; d0 < 4; ++d0) { s16x4 lo[4], hh[4];
#pragma unroll
        for (int ks = 0; ks < 4; ++ks) {
            asm volatile("ds_read_b64_tr_b16 %0, %1 offset:%c2" : "=&v"(lo[ks]) : "v"(vb), "i"(d0 * 4096 + ks * 1024) : "memory");
            asm volatile("ds_read_b64_tr_b16 %0, %1 offset:%c2" : "=&v"(hh[ks]) : "v"(vb), "i"(d0 * 4096 + ks * 1024 + 512) : "memory"); }
        asm volatile("s_waitcnt lgkmcnt(0)" ::: "memory"); ASBAR();
#define ATT_PK(k) (bf16x8){lo[k][0], lo[k][1], lo[k][2], lo[k][3], hh[k][0], hh[k][1], hh[k][2], hh[k][3]}
        o[d0] = __builtin_amdgcn_mfma_f32_32x32x16_bf16(pa0, ATT_PK(0), o[d0], 0, 0, 0);
        o[d0] = __builtin_amdgcn_mfma_f32_32x32x16_bf16(pa1, ATT_PK(1), o[d0], 0, 0, 0);
        o[d0] = __builtin_amdgcn_mfma_f32_32x32x16_bf16(pa2, ATT_PK(2), o[d0], 0, 0, 0);
        o[d0] = __builtin_amdgcn_mfma_f32_32x32x16_bf16(pa3, ATT_PK(3), o[d0], 0, 0, 0);
#undef ATT_PK
    }
}

template <bool DIFF, int MODE = 0>
__device__ __forceinline__ void attn_unit(const AttnArgs& A, int b, int h, int qb, unsigned char* shm) {
    constexpr int ND0 = DIFF ? 4 : 12;
    constexpr int QROWS = DIFF ? 128 : 256;
    constexpr int KSLOT = DIFF ? 16384 : 24576;
    constexpr int NSLOT = 3;
    constexpr int V_OFF = NSLOT * KSLOT;
    constexpr int NDF = DIFF ? 4 : 5;
    static_assert(V_OFF + NSLOT * 16384 <= WS_OFF, "rings fit below the scratch");
    int tid_ = threadIdx.x; asm volatile("" : "+v"(tid_));
    const int tid = tid_, lane = tid & 63, r32 = lane & 31, hi = lane >> 5; const int wid = __builtin_amdgcn_readfirstlane(tid >> 6);
    const int grp = wid >> 2;
    const int map = DIFF ? grp : 0, wrow = DIFF ? (wid & 3) : wid;
    const int q0 = qb * QROWS + wrow * 32;
    const int cw = q0 >> 6;
    const int NT = (qb * QROWS + QROWS) >> 6;
    const int KL = DIFF ? 3 : 2 + grp, VL = 1 + grp;
    const long rowbase = (long)b * SEQ;
    const unsigned lds0 = (unsigned)(uintptr_t)shm;
    ALDS unsigned char* shm3 = (ALDS unsigned char*)shm;
    ALDS float* wsf = (ALDS float*)(shm3 + WS_OFF) + wid * 64;
    ALDS float* tabl = (ALDS float*)(shm3 + TAB_OFF) + map * 256;
    const int vrow = 16 * (wid & 3) + (lane >> 2), vcol = (wid >> 2) * 32 + (lane & 3) * 8;
    constexpr int PITCHB = DIFF ? 6144 : 4096;
    const int krow = 8 * wid + (lane >> 3), kchk = (lane & 7) ^ ((krow >> 1) & 7);
    const unsigned voffK = (unsigned)(krow * PITCHB + kchk * 16), voffV = (unsigned)(vrow * PITCHB + vcol * 2), voffR = (unsigned)(krow * 128 + kchk * 16);
    const unsigned char* kvbase = DIFF ? (const unsigned char*)(A.QKV + rowbase * 3072 + 1024 + h * 128) : (const unsigned char*)(A.KVM + rowbase * 2048 + h * 256);
    const unsigned char* krbase = (const unsigned char*)(A.KR + rowbase * 64);
    const unsigned kd0 = lds0 + wid * 1024, vd0 = lds0 + V_OFF + wid * 1024;
    constexpr int VIMM = DIFF ? 2048 : 256;
#define ATT_DMA_K(t, sl) do { const long _t = (t); const unsigned _so = (unsigned)((sl) * KSLOT); const unsigned char* _b = uni_ptr(kvbase + _t * (64L * PITCHB)); \
        glds16s<0>(_b, voffK, (unsigned)__builtin_amdgcn_readfirstlane(kd0 + _so)); \
        glds16s<128>(_b, voffK, (unsigned)__builtin_amdgcn_readfirstlane(kd0 + 8192 + _so)); \
        if (!DIFF) glds16s<0>(uni_ptr(krbase + _t * (64L * 128)), voffR, (unsigned)__builtin_amdgcn_readfirstlane(kd0 + 16384 + _so)); } while (0)
#define ATT_DMA_V(t, sl) do { const long _t = (t); const unsigned _so = (unsigned)((sl) * 16384); const unsigned char* _b = uni_ptr(kvbase + _t * (64L * PITCHB)); \
        glds16s<VIMM>(_b, voffV, (unsigned)__builtin_amdgcn_readfirstlane(vd0 + _so)); \
        glds16s<VIMM + 128>(_b, voffV, (unsigned)__builtin_amdgcn_readfirstlane(vd0 + 8192 + _so)); } while (0)
    if (MODE < 2) { ATT_DMA_K(0, 0); ATT_DMA_K(1, 1); if (KL > 2 && 2 < NT) ATT_DMA_K(2, 2);
    ATT_DMA_V(0, 0); if (VL > 1) ATT_DMA_V(1, 1); }
    if (DIFF) { ((ALDS float*)(shm3 + TAB_OFF))[tid] = A.biastab[(h * 2 + (tid >> 8)) * 256 + (tid & 255)]; }
    bf16x8 qr[ND0];
    { const bf16* Qw = DIFF ? A.QKV + (rowbase + q0 + r32) * 3072 + h * 128 + map * 64 + hi * 8 : A.QM + (rowbase + q0 + r32) * 1536 + h * 192 + hi * 8;
#pragma unroll
      for (int d0 = 0; d0 < ND0; ++d0) qr[d0] = *reinterpret_cast<const bf16x8*>(Qw + d0 * 16); }
    float boff = 0.f; if (DIFF) boff = A.biastab[(h * 2 + map) * 256];
    float m_ref = 0.f, l_reg = 0.f; f32x16 o[4];
#pragma unroll
    for (int d = 0; d < 4; ++d) o[d] = f32x16{};
    const int kfo = (DIFF ? map * 8192 : 0) + r32 * 128;
    int ko[4];
#pragma unroll
    for (int i = 0; i < 4; ++i) ko[i] = 16 * ((2 * i + hi) ^ ((r32 >> 1) & 7));
    const int vbo = V_OFF + ((lane >> 4) & 1) * 32 + (lane & 3) * 8 + (4 * hi + ((lane & 15) >> 2)) * 64;
    f32x16 S0, S1; float al = 1.f;
    u32x4 pw[4]; if (MODE >= 1) { pw[0] = pw[1] = pw[2] = pw[3] = (u32x4){0u, 0u, 0u, 0u}; }
    bf16x8 kf[8]; bf16x8 fb[8]; f32x16 negm; float negv = 3e38f;
#pragma unroll
    for (int r = 0; r < 16; ++r) negm[r] = 0.f;
#define ATT_MF(acc, a, b) acc = __builtin_amdgcn_mfma_f32_32x32x16_bf16(a, b, acc, 0, 0, 0)
#define ATT_XBAR() asm volatile("s_waitcnt lgkmcnt(0)\n\ts_barrier" ::: "memory")
#define ATT_KFRD(SL) do { ALDS const unsigned char* kp_ = shm3 + (SL) * KSLOT + kfo; \
        _Pragma("unroll") for (int d0 = 0; d0 < 4; ++d0) { kf[2 * d0] = *(ALDS const bf16x8*)(kp_ + ko[d0]); kf[2 * d0 + 1] = *(ALDS const bf16x8*)(kp_ + ko[d0] + 4096); } } while (0)
#define ATT_LDK(f) do { fb[(f) & 7] = *(ALDS const bf16x8*)(kp_ + ((f) >> 3) * 8192 + ko[((f) >> 1) & 3] + ((f) & 1) * 4096); } while (0)
#define ATT_LDV(g) do { const s16x4 l_ = vtr(vp_ + ((g) & 3) * 4096 + ((g) >> 2) * 1024), h_ = vtr(vp_ + ((g) & 3) * 4096 + ((g) >> 2) * 1024 + 512); \
        fb[(g) & 7] = (bf16x8){l_[0], l_[1], l_[2], l_[3], h_[0], h_[1], h_[2], h_[3]}; } while (0)
#define ATT_XQK_D(T, WITHV) do { const float nb_ = (((T) + 2 < cw) ? boff : 0.f) - m_ref; \
        if (__any(nb_ != negv)) { negv = nb_; _Pragma("unroll") for (int r = 0; r < 16; ++r) negm[r] = nb_; asm volatile("" : "+v"(negm)); } \
        S0 = __builtin_amdgcn_mfma_f32_32x32x16_bf16(kf[0], qr[0], negm, 0, 0, 0); if (WITHV) ATT_LDV(0); ASBAR(); \
        S1 = __builtin_amdgcn_mfma_f32_32x32x16_bf16(kf[1], qr[0], negm, 0, 0, 0); if (WITHV) ATT_LDV(1); ASBAR(); \
        _Pragma("unroll") for (int m_ = 2; m_ < 8; ++m_) { if (m_ & 1) ATT_MF(S1, kf[m_], qr[m_ >> 1]); else ATT_MF(S0, kf[m_], qr[m_ >> 1]); if (WITHV) ATT_LDV(m_); ASBAR(); } } while (0)
#define ATT_XQK_M(SL, WITHV) do { ALDS const unsigned char* kp_ = shm3 + (SL) * KSLOT + kfo; const float nb_ = -m_ref; \
        _Pragma("unroll") for (int f_ = 0; f_ < 6; ++f_) ATT_LDK(f_); \
        if (__all(nb_ == 0.f)) { const f32x16 z16_ = f32x16{};     \
            S0 = __builtin_amdgcn_mfma_f32_32x32x16_bf16(fb[0], qr[0], z16_, 0, 0, 0); S1 = __builtin_amdgcn_mfma_f32_32x32x16_bf16(fb[1], qr[0], z16_, 0, 0, 0); } \
        else { _Pragma("unroll") for (int r = 0; r < 16; ++r) { S0[r] = nb_; S1[r] = nb_; } \
            ATT_MF(S0, fb[0], qr[0]); ATT_MF(S1, fb[1], qr[0]); } \
        ATT_LDK(6); ATT_LDK(7); ASBAR(); \
        _Pragma("unroll") for (int m_ = 2; m_ < 24; ++m_) { if (m_ & 1) ATT_MF(S1, fb[m_ & 7], qr[m_ >> 1]); else ATT_MF(S0, fb[m_ & 7], qr[m_ >> 1]); \
            if (m_ + 6 < 24) ATT_LDK(m_ + 6); else if (WITHV) ATT_LDV(m_ + 6 - 24); ASBAR(); } } while (0)
#define ATT_XPV(FD) do { _Pragma("unroll") for (int g_ = 0; g_ < 16; ++g_) { ATT_MF(o[g_ & 3], __builtin_bit_cast(bf16x8, pw[g_ >> 2]), fb[g_ & 7]); if (g_ + (FD) < 16) ATT_LDV(g_ + (FD)); ASBAR(); } } while (0)
#define ATT_RESC(AL) do { if (__any((AL) < 1.f)) { l_reg *= (AL); if (hi == 0) wsf[r32] = (AL); asm volatile("s_waitcnt lgkmcnt(0)" ::: "memory"); \
        _Pragma("unroll") for (int r = 0; r < 16; ++r) { const float al_ = wsf[crow(r, hi)]; _Pragma("unroll") for (int d = 0; d < 4; ++d) o[d][r] *= al_; } } } while (0)
    ATT_WAIT_BAR();
    int s0 = 0;
    { ALDS const unsigned char* vp_ = shm3 + vbo; (void)vp_; if (DIFF) { ATT_KFRD(0); ATT_XQK_D(0, false); } else ATT_XQK_M(0, false); }
    ATT_XBAR();
    if (MODE != 5 && MODE != 15 && grp) ATT_XBAR();
    for (int j = 0; j < NT; ++j) {
        const int s1 = (s0 == 2) ? 0 : s0 + 1, s2 = (s1 == 2) ? 0 : s1 + 1;
        int nd_ = 0;
        { const int tk_ = j + KL, tv_ = j + VL; const int slk_ = DIFF ? s0 : (grp ? s0 : s2), slv_ = grp ? s2 : s1;
          if (MODE < 2) { if (tk_ < NT) { ATT_DMA_K(tk_, slk_); nd_ += DIFF ? 2 : 3; }
          if (tv_ < NT) { ATT_DMA_V(tv_, slv_); nd_ += 2; } } }
        if ((MODE == 7 || MODE >= 14) && j <= cw) { if (DIFF) ATT_KFRD(s1); l_reg += S0[0] + S1[3]; }
        if (MODE != 1 && MODE != 10 && MODE != 3 && MODE != 7 && MODE < 14 && j <= cw) {
            if (DIFF) ATT_KFRD(s1);
            if (DIFF && (j + 2 >= cw)) { ALDS const float* tb_ = tabl + (64 * j - q0 - r32 + 192);
#pragma unroll
                for (int r = 0; r < 16; ++r) { const int kk_ = crow(r, hi); S0[r] += tb_[kk_]; S1[r] += tb_[kk_ + 32]; } }
            f32x16 P0, P1;
#pragma unroll
            for (int r = 0; r < 16; ++r) { P0[r] = __builtin_amdgcn_exp2f(S0[r]); P1[r] = __builtin_amdgcn_exp2f(S1[r]); }
            float ps_;
            { float a0_ = fadd_s(P0[0], P1[0]), a1_ = fadd_s(P0[1], P1[1]), a2_ = fadd_s(P0[2], P1[2]), a3_ = fadd_s(P0[3], P1[3]);
#pragma unroll
              for (int r = 4; r < 16; r += 4) { a0_ = fadd_s(a0_, fadd_s(P0[r], P1[r])); a1_ = fadd_s(a1_, fadd_s(P0[r + 1], P1[r + 1])); a2_ = fadd_s(a2_, fadd_s(P0[r + 2], P1[r + 2])); a3_ = fadd_s(a3_, fadd_s(P0[r + 3], P1[r + 3])); }
              ps_ = fadd_s(fadd_s(a0_, a1_), fadd_s(a2_, a3_)); }
            l_reg += ps_;
            pw[0] = (u32x4){cvtpk_s(P0[0], P0[1]), cvtpk_s(P0[2], P0[3]), cvtpk_s(P0[4], P0[5]), cvtpk_s(P0[6], P0[7])};
            pw[1] = (u32x4){cvtpk_s(P0[8], P0[9]), cvtpk_s(P0[10], P0[11]), cvtpk_s(P0[12], P0[13]), cvtpk_s(P0[14], P0[15])};
            pw[2] = (u32x4){cvtpk_s(P1[0], P1[1]), cvtpk_s(P1[2], P1[3]), cvtpk_s(P1[4], P1[5]), cvtpk_s(P1[6], P1[7])};
            pw[3] = (u32x4){cvtpk_s(P1[8], P1[9]), cvtpk_s(P1[10], P1[11]), cvtpk_s(P1[12], P1[13]), cvtpk_s(P1[14], P1[15])};
            al = 1.f;
            if (__any(ps_ > 65536.f)) { const float pr_ = swapsum(ps_); const float dl_ = pr_ > 65536.f ? __builtin_amdgcn_logf(pr_) : 0.f; m_ref += dl_; al = __builtin_amdgcn_exp2f(-dl_); }
        }
        if (nd_ == NDF) { if (DIFF) ATT_WAIT_BAR_N(4); else ATT_WAIT_BAR_N(5); } else ATT_WAIT_BAR();
        if (MODE != 1 && MODE != 10 && MODE != 4 && j <= cw) {
            ALDS const unsigned char* vp_ = shm3 + vbo + s0 * 16384;
            if (ATT_PRIO) __builtin_amdgcn_s_setprio(ATT_PRIO);
            if (DIFF) { if (j < cw) ATT_XQK_D(j + 1, true); else { _Pragma("unroll") for (int g_ = 0; g_ < 8; ++g_) ATT_LDV(g_); } ASBAR(); ATT_XPV(8); }
            else { if (j < cw) ATT_XQK_M(s1, true); else { _Pragma("unroll") for (int g_ = 0; g_ < 6; ++g_) ATT_LDV(g_); } ASBAR(); ATT_XPV(6); }
            ATT_RESC(al);
            if (ATT_PRIO) __builtin_amdgcn_s_setprio(0);
        }
        ATT_XBAR();
        s0 = s1;
    }
    if (MODE != 5 && MODE != 15 && !grp) ATT_XBAR();
#undef ATT_DMA_K
#undef ATT_DMA_V
#undef ATT_KFRD
#undef ATT_LDK
#undef ATT_LDV
#undef ATT_XQK_D
#undef ATT_XQK_M
#undef ATT_XPV
#undef ATT_MF
#undef ATT_RESC
#undef ATT_XBAR
    if (MODE >= 1) { asm volatile("" : "+v"(l_reg)); ATT_WAIT_BAR(); if (l_reg == 123456.f) A.Y[tid] = (bf16)(int)(o[0][0] + o[1][1] + o[2][2] + o[3][3] + m_ref); ATT_WAIT_BAR(); return; }
    {
    int tid2_ = threadIdx.x; asm volatile("" : "+v"(tid2_));
    const int lane = tid2_ & 63, r32 = lane & 31, hi = lane >> 5; const int wid = __builtin_amdgcn_readfirstlane(tid2_ >> 6);
    const int map = DIFF ? (wid >> 2) : 0, wrow = DIFF ? (wid & 3) : wid;
    const int q0 = qb * QROWS + wrow * 32;
    ALDS float* wsf = (ALDS float*)(shm3 + WS_OFF) + wid * 64;
    ATT_WAIT_BAR();
    l_reg = swapsum(l_reg);
    if (hi == 0) wsf[32 + r32] = __builtin_amdgcn_rcpf(l_reg);
    asm volatile("s_waitcnt lgkmcnt(0)" ::: "memory");
    float rli[16];
#pragma unroll
    for (int r = 0; r < 16; ++r) rli[r] = wsf[32 + crow(r, hi)];
    ALDS bf16* stg;
    bool writer = true;
    if (DIFF) {
        ALDS float* X = (ALDS float*)(shm3 + (wid & 3) * 16384);
        if (map == 1) {
            const float lam = A.lam;
#pragma unroll
            for (int r = 0; r < 16; ++r) { const float f = rli[r] * lam; const int orow = crow(r, hi);
#pragma unroll
                for (int d = 0; d < 4; ++d) X[orow * 128 + d * 32 + r32] = o[d][r] * f; }
        }
        ATT_WAIT_BAR();
        stg = (ALDS bf16*)(shm3 + (wid & 3) * 16384);
        if (map == 0) {
            float g4[4];
#pragma unroll
            for (int d = 0; d < 4; ++d) g4[d] = A.subg[d * 32 + r32] * A.oml;
            float ss[16];
#pragma unroll
            for (int r = 0; r < 16; ++r) { const int orow = crow(r, hi); float s = 0.f;
#pragma unroll
                for (int d = 0; d < 4; ++d) { const float v = o[d][r] * rli[r] - X[orow * 128 + d * 32 + r32]; o[d][r] = v; s += v * v; }
                ss[r] = s; }
#pragma unroll
            for (int r = 0; r < 16; ++r) { float s = ss[r];
                s += __shfl_xor(s, 1); s += __shfl_xor(s, 2); s += __shfl_xor(s, 4); s += __shfl_xor(s, 8); s += __shfl_xor(s, 16);
                ss[r] = 1.0f / sqrtf(s * (1.0f / 128.0f) + EPS); }
            asm volatile("s_waitcnt lgkmcnt(0)" ::: "memory");
#pragma unroll
            for (int r = 0; r < 16; ++r) { const int orow = crow(r, hi);
#pragma unroll
                for (int d = 0; d < 4; ++d) stg[orow * 128 + d * 32 + r32] = (bf16)(cvtpk_s(o[d][r] * ss[r] * g4[d], 0.f) & 0xffffu); }
        } else writer = false;
    } else {
        stg = (ALDS bf16*)(shm3 + wid * 8192);
#pragma unroll
        for (int r = 0; r < 16; ++r) { const int orow = crow(r, hi);
#pragma unroll
            for (int d = 0; d < 4; ++d) stg[orow * 128 + d * 32 + r32] = (bf16)(cvtpk_s(o[d][r] * rli[r], 0.f) & 0xffffu); }
    }
    if (writer) {
        asm volatile("s_waitcnt lgkmcnt(0)" ::: "memory");
        const int gcol = (DIFF ? 0 : 1024) + h * 128;
#pragma unroll
        for (int i = 0; i < 8; ++i) { const int row = i * 4 + (lane >> 4), ch = lane & 15;
            const u32x4 ov = *(ALDS const u32x4*)(stg + row * 128 + ch * 8);
            const size_t gi = (size_t)(rowbase + q0 + row) * 2048 + gcol + ch * 8;
            const u32x4 gv = *(const u32x4*)(A.GATE + gi);
            u32x4 yv;
#pragma unroll
            for (int e = 0; e < 4; ++e) {
                const float o_lo = __uint_as_float(ov[e] << 16), o_hi = __uint_as_float(ov[e] & 0xffff0000u);
                const float g_lo = __uint_as_float(gv[e] << 16), g_hi = __uint_as_float(gv[e] & 0xffff0000u);
                const float s_lo = g_lo * __builtin_amdgcn_rcpf(1.0f + __builtin_amdgcn_exp2f(-g_lo * LOG2E));
                const float s_hi = g_hi * __builtin_amdgcn_rcpf(1.0f + __builtin_amdgcn_exp2f(-g_hi * LOG2E));
                yv[e] = cvtpk_s(o_lo * s_lo, o_hi * s_hi); }
            *(u32x4*)(A.Y + gi) = yv; }
    }
    ATT_WAIT_BAR();
    }
}
#undef ASBAR
}
constexpr size_t MiB = 1u << 20;
constexpr size_t WS_CTL = 0, CTL_ZERO_BYTES = 1 * MiB;
constexpr size_t WS_ROPEC = 1 * MiB, WS_ROPES = WS_ROPEC + 512 * 1024;
constexpr size_t WS_SMALL = 2 * MiB;
constexpr size_t SM_BIAS = 1024, SM_RSQ = 128 * 1024, SM_RSKV = 256 * 1024;
constexpr size_t WS_WIN = 4 * MiB;
constexpr size_t WS_WQB = 52 * MiB;
constexpr size_t WS_WKVB = 55 * MiB;
constexpr size_t WS_WOUT = 57 * MiB;
constexpr size_t WS_H = 80 * MiB;
constexpr size_t WS_Y = WS_H;
constexpr size_t WS_QKV = 144 * MiB;
constexpr size_t WS_CQ = 240 * MiB;
constexpr size_t WS_CKV = 256 * MiB;
constexpr size_t WS_KR = 264 * MiB;
constexpr size_t WS_GATE = 272 * MiB;
constexpr size_t WS_QM = 336 * MiB;
constexpr size_t WS_KVM = 384 * MiB;
constexpr size_t WS_END = 448 * MiB;
constexpr int CW_BAR = 4096;
constexpr size_t CTL_SSQ = 65536;

constexpr int RING_OFF = 0, RING_BYTES = 139264;
constexpr int LDSCTL_OFF = RING_BYTES, MISC_OFF = LDSCTL_OFF + 320;
constexpr int LDS_BYTES = 147456;
constexpr int NWAVES = 8;
static_assert(att::ATT_LDS_BYTES <= RING_BYTES, "attention scratch fits the ring region");

__device__ __forceinline__ float wave_sum(float v) {
#pragma unroll
    for (int o = 1; o < 64; o <<= 1) v += __shfl_xor(v, o);
    return v;
}
__device__ __forceinline__ int in_srccol(int n) {
    if (n < 3840) return n;
    if (n < 3904) { const int p = n - 3840, a = p >> 3, j = p & 7; return 3840 + (j < 4 ? 4 * a + j : 32 + 4 * a + (j - 4)); }
    if (n < 4096) return -1;
    return n - 192;
}
__device__ __forceinline__ int qb_srccol(int n) {
    const int hh = n / 192, off = n - hh * 192; if (off < 128) return n;
    const int p = off - 128, a = p >> 3, j = p & 7; return hh * 192 + 128 + (j < 4 ? 4 * a + j : 32 + 4 * a + (j - 4));
}
template <int MODE>
__device__ __forceinline__ void transpose_item(const float* W, int K, int Nsrc, int Ndst, bf16* WT, const float* gk, LAS float* scr, int item, int lane) {
    const int nblk = Ndst / 32, kb = item / nblk, nb = item - kb * nblk, k0 = 64 * kb, n0 = 32 * nb;
    const int nd = n0 + (lane & 31);
    const int src = (MODE == 1) ? in_srccol(nd) : (MODE == 2) ? qb_srccol(nd) : nd;
    float v[32];
#pragma unroll
    for (int i = 0; i < 32; ++i) { const int kk = 2 * i + (lane >> 5); v[i] = 0.f;
        if (src >= 0) { v[i] = W[(size_t)(k0 + kk) * Nsrc + src]; if (gk) v[i] *= gk[k0 + kk]; } }
#pragma unroll
    for (int i = 0; i < 32; ++i) { const int kk = 2 * i + (lane >> 5); scr[kk * 33 + (lane & 31)] = v[i]; }
    LDS_WAIT(); asm volatile("" ::: "memory");
    const int c = lane & 7;
#pragma unroll
    for (int j = 0; j < 4; ++j) { const int n = (lane >> 3) + 8 * j; const LAS float* s = scr + (8 * c) * 33 + n;
        v4u o; o.x = pk2(s[0 * 33], s[1 * 33]); o.y = pk2(s[2 * 33], s[3 * 33]); o.z = pk2(s[4 * 33], s[5 * 33]); o.w = pk2(s[6 * 33], s[7 * 33]);
        *(GAS v4u*)(WT + (size_t)(n0 + n) * K + k0 + 8 * c) = o; }
    LDS_WAIT(); asm volatile("" ::: "memory");
}
__device__ __forceinline__ void rms_row_to_bf16(const float* xrow, const float* g, bf16* orow, int lane) {
    const GAS f32x4* xr = (const GAS f32x4*)xrow + lane; const GAS f32x4* gr = (const GAS f32x4*)g + lane;
    f32x4 v[8]; float s = 0.f;
#pragma unroll
    for (int j = 0; j < 8; ++j) { v[j] = xr[64 * j]; s += (v[j].x * v[j].x + v[j].y * v[j].y) + (v[j].z * v[j].z + v[j].w * v[j].w); }
    const float rstd = 1.0f / sqrtf(wave_sum(s) * (1.0f / DM) + EPS);
    GAS unsigned long long* o8 = (GAS unsigned long long*)orow + lane;
#pragma unroll
    for (int j = 0; j < 8; ++j) { const f32x4 gg = gr[64 * j];
        o8[64 * j] = (unsigned long long)pk2(v[j].x * rstd * gg.x, v[j].y * rstd * gg.y) | ((unsigned long long)pk2(v[j].z * rstd * gg.z, v[j].w * rstd * gg.w) << 32); }
}
__device__ __forceinline__ void rms_row_f32(const float* xrow, const float* g, float* orow, int lane) {
    const GAS f32x4* xr = (const GAS f32x4*)xrow + lane; const GAS f32x4* gr = (const GAS f32x4*)g + lane;
    f32x4 v[8]; float s = 0.f;
#pragma unroll
    for (int j = 0; j < 8; ++j) { v[j] = xr[64 * j]; s += (v[j].x * v[j].x + v[j].y * v[j].y) + (v[j].z * v[j].z + v[j].w * v[j].w); }
    const float rstd = 1.0f / sqrtf(wave_sum(s) * (1.0f / DM) + EPS);
    GAS f32x4* o4 = (GAS f32x4*)orow + lane;
#pragma unroll
    for (int j = 0; j < 8; ++j) { const f32x4 gg = gr[64 * j]; o4[64 * j] = v[j] * rstd * gg; }
}
__device__ __forceinline__ int rel_bucket(int rel) {
    const int n = rel < 0 ? -rel : rel; int bk;
    if (n < 8) bk = n; else if (n < 12) bk = 8; else if (n < 16) bk = 9; else if (n < 23) bk = 10; else if (n < 32) bk = 11;
    else if (n < 46) bk = 12; else if (n < 64) bk = 13; else if (n < 91) bk = 14; else bk = 15;
    return (rel > 0 ? 16 : 0) + bk;
}

struct Args { const float* in[12]; float* out; unsigned char* ws; int ph_lo, ph_hi; };
constexpr int N_PHASES = 11;

#define IN(k) (lo <= (k) && (k) < hi)
#ifndef MK_REP_G23
#define MK_REP_G23 1
#endif
#ifndef MK_REP_G4
#define MK_REP_G4 1
#endif
#ifndef MK_REP_NORM
#define MK_REP_NORM 1
#endif
#ifndef MK_REP_RS
#define MK_REP_RS 1
#endif
#ifndef MK_ATT_MIX
#define MK_ATT_MIX 1
#endif
#ifndef MK_ATT_PROBE
#define MK_ATT_PROBE 0
#endif
#ifndef MK_REP_G1
#define MK_REP_G1 1
#endif
#ifndef MK_REP_P0
#define MK_REP_P0 1
#endif
#ifndef MK_CG_ONLY
#define MK_CG_ONLY 0
#endif
#ifdef MK_STAMP
#define STAMP(k) do { if (blockIdx.x == 0 && threadIdx.x == 0) WSP(unsigned long long, WS_SMALL + 64)[(k)] = __builtin_amdgcn_s_memrealtime(); } while (0)
#else
#define STAMP(k) do { } while (0)
#endif
#define SEAM(k) do { if (IN(k) && IN((k) + 1)) { if (MK_CG_ONLY || (k) == 0) grid.sync(); else xcd_barrier(bar); } STAMP((k) + 1); } while (0)
#define WSP(T, off) ((T*)(args.ws + (off)))

__device__ __forceinline__ void prologue_phase(const Args& args, unsigned char* lds, int G, int vcu) {
    int tid_ = threadIdx.x; asm volatile("" : "+v"(tid_));
    const int tid = tid_, lane = tid & 63, wave = __builtin_amdgcn_readfirstlane(tid >> 6);
    const int gw = vcu * NWAVES + wave, NGW = G * NWAVES;
    const float* x = args.in[0]; const float* norm_g = args.in[1]; const float* w_in = args.in[2]; const float* diff_lambda = args.in[3];
    const float* qnorm_g = args.in[5]; const float* w_qb = args.in[6]; const float* kvnorm_g = args.in[7];
    const float* w_kvb = args.in[8]; const float* w_out = args.in[9]; const float* rel_bias = args.in[10];
    float* ropec = WSP(float, WS_ROPEC); float* ropes = WSP(float, WS_ROPES); float* smallf = WSP(float, WS_SMALL); float* biastab = WSP(float, WS_SMALL + SM_BIAS);
    bf16* Win_t = WSP(bf16, WS_WIN); bf16* Wqb_t = WSP(bf16, WS_WQB); bf16* Wkvb_t = WSP(bf16, WS_WKVB); bf16* Wout_t = WSP(bf16, WS_WOUT); bf16* Hb = WSP(bf16, WS_H);
    LAS float* scr = (LAS float*)((LAS unsigned char*)lds + RING_OFF + wave * 16384);
    constexpr int I_IN = (DM / 64) * (NINP / 32), I_QB = (QLORA / 64) * (NQB / 32), I_KVB = (KVLORA / 64) * (NKVB / 32), I_OUT = (DM / 64) * (DM / 32);
    constexpr int PER_L = I_IN + I_QB + I_KVB + I_OUT;
    for (int it = gw; it < DEPTH * PER_L; it += NGW) {
        const int l = it / PER_L; int r = it - l * PER_L;
        if (r < I_IN) { transpose_item<1>(w_in + (size_t)l * DM * NIN, DM, NIN, NINP, Win_t + (size_t)l * NINP * DM, nullptr, scr, r, lane); continue; } r -= I_IN;
        if (r < I_QB) { transpose_item<2>(w_qb + (size_t)l * QLORA * NQB, QLORA, NQB, NQB, Wqb_t + (size_t)l * NQB * QLORA, qnorm_g + l * QLORA, scr, r, lane); continue; } r -= I_QB;
        if (r < I_KVB) { transpose_item<0>(w_kvb + (size_t)l * KVLORA * NKVB, KVLORA, NKVB, NKVB, Wkvb_t + (size_t)l * NKVB * KVLORA, kvnorm_g + l * KVLORA, scr, r, lane); continue; } r -= I_KVB;
        transpose_item<0>(w_out + (size_t)l * DM * DM, DM, DM, DM, Wout_t + (size_t)l * DM * DM, nullptr, scr, r, lane);
    }
    const int gt = vcu * (NWAVES * 64) + tid, NGT = G * NWAVES * 64;
    for (int e = gt; e < SEQ * 32; e += NGT) { const int s = e >> 5, i = e & 31;
        const float inv = powf(10000.0f, -(float)i * (1.0f / 32.0f)); const float ang = (float)s * inv;
        ropec[e] = cosf(ang); ropes[e] = sinf(ang); }
    for (int e = gt; e < 16 * 256; e += NGT) { const int mh = e >> 8, idx = e & 255; biastab[e] = rel_bias[rel_bucket(idx - 192) * 16 + mh] * LOG2E; }
    if (gt < DEPTH) { const float* lp = diff_lambda + gt * 256; float s01 = 0.f, s23 = 0.f;
        for (int i = 0; i < 64; ++i) { s01 += lp[i] * lp[64 + i]; s23 += lp[128 + i] * lp[192 + i]; }
        const float lam_init = 0.8f - 0.6f * expf(-0.3f * (float)gt);
        smallf[gt] = expf(s01) - expf(s23) + lam_init; smallf[8 + gt] = 1.0f - lam_init; }
    for (int m = gw; m < MROWS; m += NGW) rms_row_to_bf16(x + (size_t)m * DM, norm_g, Hb + (size_t)m * DM, lane);
}

template <int L>
__device__ __forceinline__ void layer_phases(const Args& args, unsigned char* lds, cg::grid_group& grid, const XcdBarrier& bar, int lo, int hi, int G, int bx, int vcu) {
    constexpr int pb = 1 + 5 * L;
    LAS unsigned char* ldsl = (LAS unsigned char*)lds;
#ifdef MK_CLK
    if (L == 0 && blockIdx.x == 0 && threadIdx.x == 0) { unsigned long long* ts = WSP(unsigned long long, WS_SMALL + 64); ts[10] = __builtin_amdgcn_s_memtime(); ts[11] = __builtin_amdgcn_s_memrealtime(); }
#endif
    if (IN(pb)) {
        pg8::Gemm g{WSP(bf16, WS_H), WSP(bf16, WS_WIN) + (size_t)L * NINP * DM, MROWS, NINP, DM}; pg8::StaticOrder S; S.init(MROWS, NINP, G, bx);
        pg8::EpiInProj E{WSP(bf16, WS_QKV), WSP(bf16, WS_CQ), WSP(bf16, WS_CKV), WSP(bf16, WS_KR), WSP(bf16, WS_GATE), WSP(float, WS_ROPEC), WSP(float, WS_ROPES), WSP(float, WS_CTL + CTL_SSQ + (size_t)(2 * L) * 65536), WSP(float, WS_CTL + CTL_SSQ + (size_t)(2 * L + 1) * 65536)};
        for (int rep_ = 0; rep_ < MK_REP_G1; ++rep_)
        pg8::gemm_phase<pg8::EpiInProj, pg8::StaticOrder, true, true>(ldsl + RING_OFF, g, S, E);
    }
#ifdef MK_CLK
    if (L == 0 && blockIdx.x == 0 && threadIdx.x == 0) { unsigned long long* ts = WSP(unsigned long long, WS_SMALL + 64); ts[12] = __builtin_amdgcn_s_memtime(); ts[13] = __builtin_amdgcn_s_memrealtime(); }
#endif
    SEAM(pb);
    if (IN(pb + 1)) for (int rep_ = 0; rep_ < MK_REP_G23; ++rep_) {
        { pg8::Gemm g{WSP(bf16, WS_CQ), WSP(bf16, WS_WQB) + (size_t)L * NQB * QLORA, MROWS, NQB, QLORA}; pg8::StaticOrder S; S.init(MROWS, NQB, G, bx);
          pg8::EpiRowScale<true> E{WSP(bf16, WS_QM), NQB, WSP(float, WS_CTL + CTL_SSQ + (size_t)(2 * L) * 65536), 1.0f / QLORA, WSP(float, WS_ROPEC), WSP(float, WS_ROPES), 0.07216878364870323f * LOG2E};
#ifndef NO_G2
          pg8::gemm_phase<pg8::EpiRowScale<true>, pg8::StaticOrder, true, true>(ldsl + RING_OFF, g, S, E);
#endif
        }
        { pg8::Gemm g{WSP(bf16, WS_CKV), WSP(bf16, WS_WKVB) + (size_t)L * NKVB * KVLORA, MROWS, NKVB, KVLORA}; pg8::KvOrder S; S.init(MROWS, NKVB, G, bx);
          pg8::EpiRowScale<false> E{WSP(bf16, WS_KVM), NKVB, WSP(float, WS_CTL + CTL_SSQ + (size_t)(2 * L + 1) * 65536), 1.0f / KVLORA, nullptr, nullptr, 1.0f};
#ifndef NO_G3
          pg8::gemm_phase<pg8::EpiRowScale<false>, pg8::KvOrder, true, true>(ldsl + RING_OFF, g, S, E);
#endif
        }
    }
    SEAM(pb + 1);
#ifdef MK_CLK
    if (L == 0 && blockIdx.x == 0 && threadIdx.x == 0) { unsigned long long* ts = WSP(unsigned long long, WS_SMALL + 64); ts[2] = __builtin_amdgcn_s_memtime(); ts[3] = __builtin_amdgcn_s_memrealtime(); }
#endif
    if (IN(pb + 2)) {
        const float* smallf = WSP(float, WS_SMALL);
        att::AttnArgs A{WSP(void, WS_CTL + 524288), WSP(bf16, WS_QKV), WSP(bf16, WS_QM), WSP(bf16, WS_KVM), WSP(bf16, WS_KR), WSP(bf16, WS_GATE), WSP(bf16, WS_Y), WSP(float, WS_SMALL + SM_BIAS), args.in[4] + L * 128, smallf[L], smallf[8 + L]};
        for (int p = vcu; p < 256; p += G) {
            const int bh = p >> 3, s = p & 7, b = bh >> 3, h = bh & 7;
            for (int pass_ = 0; pass_ < 2; ++pass_) {
                const bool mla_ = ((pass_ == 0) == ((s & 1) == 0)) || !MK_ATT_MIX;
                if (MK_ATT_MIX ? mla_ : pass_ == 0) { for (int i = 0; i < 2; ++i) att::attn_unit<false>(A, b, h, i == 0 ? 15 - s : s, lds + RING_OFF); }
                else { for (int i = 0; i < 4; ++i) att::attn_unit<true>(A, b, h, i == 0 ? 31 - 2 * s : i == 1 ? 30 - 2 * s : i == 2 ? 2 * s + 1 : 2 * s, lds + RING_OFF); }
            }
#if MK_ATT_PROBE
#ifndef MK_ATT_PROBE_KIND
#define MK_ATT_PROBE_KIND 3
#endif
            if (MK_ATT_PROBE_KIND & 1) for (int i = 0; i < 2; ++i) att::attn_unit<false, MK_ATT_PROBE>(A, b, h, i == 0 ? 15 - s : s, lds + RING_OFF);
            if (MK_ATT_PROBE_KIND & 2) for (int i = 0; i < 4; ++i) att::attn_unit<true, MK_ATT_PROBE>(A, b, h, i == 0 ? 31 - 2 * s : i == 1 ? 30 - 2 * s : i == 2 ? 2 * s + 1 : 2 * s, lds + RING_OFF);
#endif
        }
    }
#ifdef MK_CLK
    if (L == 0 && blockIdx.x == 0 && threadIdx.x == 0) { unsigned long long* ts = WSP(unsigned long long, WS_SMALL + 64); ts[4] = __builtin_amdgcn_s_memtime(); ts[5] = __builtin_amdgcn_s_memrealtime(); }
#endif
    SEAM(pb + 2);
    if (IN(pb + 3)) {
        pg8::Gemm g{WSP(bf16, WS_Y), WSP(bf16, WS_WOUT) + (size_t)L * DM * DM, MROWS, DM, DM}; pg8::StaticOrder S; S.init(MROWS, DM, G, bx);
        pg8::EpiResF32 E{L == 0 ? args.in[0] : (const float*)args.out, args.out, DM};
        for (int rep_ = 0; rep_ < (L == 0 ? MK_REP_G4 : 1); ++rep_)
        pg8::gemm_phase<pg8::EpiResF32, pg8::StaticOrder, true, true>(ldsl + RING_OFF, g, S, E);
    }
    SEAM(pb + 3);
    if (IN(pb + 4)) {
        int tid_ = threadIdx.x; asm volatile("" : "+v"(tid_));
        const int lane = tid_ & 63, wave = __builtin_amdgcn_readfirstlane(tid_ >> 6); const int gw = vcu * NWAVES + wave, NGW = G * NWAVES;
        if (L == 0) { const float* X1 = args.out; bf16* Hb = WSP(bf16, WS_H); const float* g = args.in[1] + DM;
            for (int rep_ = 0; rep_ < MK_REP_NORM; ++rep_) for (int m = gw; m < MROWS; m += NGW) rms_row_to_bf16(X1 + (size_t)m * DM, g, Hb + (size_t)m * DM, lane); }
        else { const float* g = args.in[11]; float* out = args.out;
            for (int m = gw; m < MROWS; m += NGW) rms_row_f32(out + (size_t)m * DM, g, out + (size_t)m * DM, lane); }
    }
    SEAM(pb + 4);
}

__global__ void __launch_bounds__(NWAVES * 64, 2) mk_fwd(Args args) {
    extern __shared__ __attribute__((aligned(16))) unsigned char lds[];
    cg::grid_group grid = cg::this_grid();
    const int G = gridDim.x; const int bx = blockIdx.x; const int vcu = (G % 8 == 0) ? (bx % 8) * (G / 8) + bx / 8 : bx;
    const int lo = args.ph_lo, hi = args.ph_hi;
    volatile LAS unsigned* MISC = (volatile LAS unsigned*)((LAS unsigned char*)lds + MISC_OFF);
    if (threadIdx.x < 32) MISC[threadIdx.x] = 0u;
    __syncthreads();
    const XcdBarrier bar = xcd_barrier_post(WSP(unsigned, WS_CTL) + CW_BAR, MISC + 8);
    STAMP(0);
#ifdef MK_UB
    {
        typedef short ub8 __attribute__((ext_vector_type(8))); typedef float uf16 __attribute__((ext_vector_type(16))); typedef short us4 __attribute__((ext_vector_type(4)));
        LAS unsigned char* lb_ = (LAS unsigned char*)lds + (threadIdx.x & 63) * 16 + (threadIdx.x >> 6) * 8192;
        ub8 a_, b_; for (int i = 0; i < 8; ++i) { a_[i] = (short)(0x3c00 + threadIdx.x + i); b_[i] = (short)(0x3a00 + i); }
        for (int i = 0; i < 8; ++i) *(LAS ub8*)(lb_ + i * 1024) = a_;
        __syncthreads();
        uf16 acc_; for (int i = 0; i < 16; ++i) acc_[i] = 0.f;
        float x_[12]; for (int i = 0; i < 12; ++i) x_[i] = 0.001f * (float)(threadIdx.x + i);
        ub8 nx_ = *(LAS const ub8*)(lb_);
        for (int it = 0; it < MK_UB_IT; ++it) {
            ub8 cur_ = a_;
            if (MK_UB_LDS == 1) cur_ = *(LAS const ub8*)(lb_ + (it & 7) * 1024);
            if (MK_UB_LDS == 2) { cur_ = nx_; nx_ = *(LAS const ub8*)(lb_ + ((it + 1) & 7) * 1024); }
            if (MK_UB_LDS == 3) { cur_ = nx_; const us4 l_ = __builtin_bit_cast(us4, __builtin_amdgcn_ds_read_tr16_b64_v4i16((LAS us4*)(lb_ - (threadIdx.x & 63) * 8 + ((it + 1) & 7) * 1024))), h_ = __builtin_bit_cast(us4, __builtin_amdgcn_ds_read_tr16_b64_v4i16((LAS us4*)(lb_ - (threadIdx.x & 63) * 8 + ((it + 1) & 7) * 1024 + 512))); nx_ = (ub8){l_[0], l_[1], l_[2], l_[3], h_[0], h_[1], h_[2], h_[3]}; }
#if MK_UB_ACC == 1
            asm volatile("v_mfma_f32_32x32x16_bf16 %0, %1, %2, %0" : "+a"(acc_) : "v"(cur_), "v"(b_));
#elif MK_UB_ACC == 2
            asm volatile("v_mfma_f32_32x32x16_bf16 %0, %1, %2, %0" : "+v"(acc_) : "v"(cur_), "v"(b_));
#else
            acc_ = __builtin_amdgcn_mfma_f32_32x32x16_bf16(cur_, b_, acc_, 0, 0, 0);
#endif
#pragma unroll
            for (int i = 0; i < MK_UB_N; ++i) { if (MK_UB_EXP) x_[i] = __builtin_amdgcn_exp2f(x_[i]); else x_[i] = fmaf(x_[i], 0.999f, 0.001f); asm volatile("" : "+v"(x_[i])); }
            __builtin_amdgcn_sched_barrier(0);
        }
        float sum_ = acc_[0] + acc_[5]; for (int i = 0; i < 12; ++i) sum_ += x_[i];
        if (sum_ == 123456.789f) args.out[threadIdx.x] = sum_;
        __syncthreads();
    }
#endif
    if (IN(0)) { for (int rep_ = 0; rep_ < MK_REP_P0; ++rep_) prologue_phase(args, lds, G, vcu); }
    SEAM(0);
    layer_phases<0>(args, lds, grid, bar, lo, hi, G, bx, vcu);
    layer_phases<1>(args, lds, grid, bar, lo, hi, G, bx, vcu);
#ifdef MK_TPROF
    xcd_barrier(bar);
    { const unsigned long long* a_ = WSP(unsigned long long, WS_CTL + 524288); const float n_ = (float)a_[3];
      const float qa = floorf((float)a_[MK_TPROF_A] / n_ * (1.0f / MK_TPROF_Q) + 0.5f), qb = floorf((float)a_[MK_TPROF_B] / n_ * (1.0f / MK_TPROF_Q) + 0.5f);
      float* o = args.out; const int gt = blockIdx.x * 512 + threadIdx.x;
      for (int i = gt; i < MROWS * DM; i += gridDim.x * 512) o[i] = (i == 0) ? 16.f * qb : qa; }
#endif
#ifdef MK_CLK
    xcd_barrier(bar);
    { const unsigned long long* ts = WSP(unsigned long long, WS_SMALL + 64);
      const float ca = (float)(ts[4] - ts[2]) / (float)(ts[5] - ts[3]), cg = (float)(ts[12] - ts[10]) / (float)(ts[13] - ts[11]);
      const float qa = floorf(ca + 0.5f), qg = floorf(cg + 0.5f);
      float* o = args.out; const int gt = blockIdx.x * 512 + threadIdx.x;
      for (int i = gt; i < MROWS * DM; i += gridDim.x * 512) o[i] = (i == 0) ? 16.f * qg : qa; }
#endif
#ifdef MK_STAMP
    xcd_barrier(bar);
    { const unsigned long long* ts = WSP(unsigned long long, WS_SMALL + 64);
      float da = 0.f, db = 0.f;
      for (int p = 0; p < N_PHASES; ++p) { const int kind = p == 0 ? 0 : 1 + (p - 1) % 6; const float d = (float)(ts[p + 1] - ts[p]) * 0.01f; if (kind == MK_STAMP_A) da += d; if (kind == MK_STAMP_B) db += d; }
      float* o = args.out; const int gt = blockIdx.x * 512 + threadIdx.x;
      for (int i = gt; i < MROWS * DM; i += gridDim.x * 512) o[i] = (i == 0) ? 16.f * db : da; }
#endif
}
#undef IN
#undef SEAM
#undef WSP

#ifndef MK_PH_MAX
#define MK_PH_MAX N_PHASES
#endif
#ifndef MK_PH_MIN
#define MK_PH_MIN 0
#endif
#ifndef MK_LAUNCH_PER_PHASE
#define MK_LAUNCH_PER_PHASE 0
#endif
__global__ void diag_fill(float* o, int n, float c) { for (int i = blockIdx.x * 256 + threadIdx.x; i < n; i += gridDim.x * 256) o[i] = c; }
#ifdef MK_UBK
__global__ void __launch_bounds__(512, 2) ub_kernel(float* out) {
    typedef short ub8 __attribute__((ext_vector_type(8))); typedef float uf16 __attribute__((ext_vector_type(16)));
    ub8 a_, b_; for (int i = 0; i < 8; ++i) { a_[i] = (short)(0x3c00 + threadIdx.x + i); b_[i] = (short)(0x3a00 + i); }
    uf16 acc_; for (int i = 0; i < 16; ++i) acc_[i] = 0.f;
    float x_[12]; for (int i = 0; i < 12; ++i) x_[i] = 0.001f * (float)(threadIdx.x + i);
    for (int it = 0; it < MK_UBK_IT; ++it) {
#if MK_UBK_ACC == 1
        asm volatile("v_mfma_f32_32x32x16_bf16 %0, %1, %2, %0" : "+a"(acc_) : "v"(a_), "v"(b_));
#else
        asm volatile("v_mfma_f32_32x32x16_bf16 %0, %1, %2, %0" : "+v"(acc_) : "v"(a_), "v"(b_));
#endif
#pragma unroll
        for (int i = 0; i < MK_UBK_N; ++i) { x_[i] = fmaf(x_[i], 0.999f, 0.001f); asm volatile("" : "+v"(x_[i])); }
        __builtin_amdgcn_sched_barrier(0);
    }
    float sum_ = acc_[0] + acc_[5]; for (int i = 0; i < 12; ++i) sum_ += x_[i];
    if (sum_ == 123456.789f) out[threadIdx.x] = sum_;
}
#endif
extern "C" void kernel_launch(void* const* d_in, const int* in_sizes, int n_in, void* d_out, int out_size, void* d_ws, size_t ws_size, hipStream_t stream) {
    static int grid = 0;
    if (grid == 0) {
        if (n_in != 12 || in_sizes[0] != MROWS * DM || out_size != MROWS * DM || ws_size < WS_END) {
            fprintf(stderr, "kernel_launch: unexpected shapes: n_in %d in0 %d out %d ws %zu (need >= %zu)\n", n_in, n_in > 0 ? in_sizes[0] : -1, out_size, ws_size, (size_t)WS_END);
            const float code = (n_in != 12) ? 30.f : (in_sizes[0] != MROWS * DM) ? 40.f : (out_size != MROWS * DM) ? 50.f : (float)(ws_size >> 26);
            hipLaunchKernelGGL(diag_fill, dim3(1024), dim3(256), 0, stream, (float*)d_out, out_size, code); return; }
        int dev = 0, cus = 0, per_cu = 0;
        if (hipGetDevice(&dev) != hipSuccess || hipDeviceGetAttribute(&cus, hipDeviceAttributeMultiprocessorCount, dev) != hipSuccess) { fprintf(stderr, "kernel_launch: device query failed\n"); grid = -1; return; }
        if (hipFuncSetAttribute((const void*)mk_fwd, hipFuncAttributeMaxDynamicSharedMemorySize, LDS_BYTES) != hipSuccess) { fprintf(stderr, "kernel_launch: hipFuncSetAttribute failed\n"); grid = -1; return; }
        if (hipOccupancyMaxActiveBlocksPerMultiprocessor(&per_cu, (const void*)mk_fwd, NWAVES * 64, LDS_BYTES) != hipSuccess || per_cu < 1) {
            fprintf(stderr, "kernel_launch: occupancy query reports %d workgroups per CU\n", per_cu); (void)hipGetLastError(); per_cu = 1; }
        grid = cus;
        if (grid > 256) grid = 256;
    }
    if (grid < 0) return;
    (void)hipMemsetAsync((char*)d_ws + WS_CTL, 0, CTL_ZERO_BYTES, stream);
#ifdef MK_UBK
    hipLaunchKernelGGL(ub_kernel, dim3(256), dim3(512), 0, stream, (float*)d_ws + (WS_END >> 2) - 4096);
#endif
    Args a{};
    for (int i = 0; i < 12; ++i) a.in[i] = (const float*)d_in[i];
    a.out = (float*)d_out; a.ws = (unsigned char*)d_ws;
#if MK_LAUNCH_PER_PHASE
    for (int p = MK_PH_MIN; p < MK_PH_MAX; ++p) { a.ph_lo = p; a.ph_hi = p + 1; hipLaunchKernelGGL(mk_fwd, dim3(grid), dim3(NWAVES * 64), LDS_BYTES, stream, a); }
    { const hipError_t le = hipPeekAtLastError(); if (le != hipSuccess) fprintf(stderr, "kernel_launch: launch failed: %s\n", hipGetErrorName(le)); }
#else
    a.ph_lo = 0; a.ph_hi = N_PHASES;
    void* kargs[] = {&a};
    const hipError_t e = hipLaunchCooperativeKernel((const void*)mk_fwd, dim3(grid), dim3(NWAVES * 64), kargs, LDS_BYTES, stream);
    if (e != hipSuccess) fprintf(stderr, "kernel_launch: cooperative launch failed: %s (grid %d)\n", hipGetErrorString(e), grid);
#endif
}
```

```cpp
#include <hip/hip_runtime.h>
#include <hip/hip_cooperative_groups.h>
#include <cstdio>
#include <cstdint>
namespace cg = cooperative_groups;

constexpr int BATCH = 4, SEQ = 4096, DM = 2048, MROWS = BATCH * SEQ, DEPTH = 2;
constexpr int NIN = 5952, NINP = 6144;
constexpr int QLORA = 512, KVLORA = 256, NQB = 1536, NKVB = 2048;
constexpr float EPS = 1e-6f;
constexpr float LOG2E = 1.4426950408889634f;
namespace pg8 {
#define PG8_LAS __attribute__((address_space(3)))
typedef unsigned short bf16_t;
typedef short bf16x8 __attribute__((ext_vector_type(8)));
typedef float f32x4 __attribute__((ext_vector_type(4)));
typedef unsigned u32x4 __attribute__((ext_vector_type(4)));
constexpr int BM = 256, BK = 64, HALF = 128, HTB = HALF * BK * 2  , STAGE_BYTES = 8 * HTB, NXCD = 8, WGM = 8;

__host__ __device__ __forceinline__ int lds_byte(int r, int c) { const int st = (r >> 4) * 2 + (c >> 5), rr = r & 15, cc = c & 31, ob = rr * 64 + cc * 2; return st * 1024 + (ob ^ (((ob >> 9) & 1) << 5)); }
__host__ __device__ __forceinline__ void stage_rc(int b, int& R, int& C) { const int st = b / 1024, sb = b % 1024, swz = sb ^ (((sb >> 9) & 1) << 5); R = (st >> 1) * 16 + swz / 64; C = (st & 1) * 32 + (swz % 64) / 2; }
__host__ __device__ __forceinline__ int perm32(int rho) { const int n = rho >> 4, i = rho & 15; return 8 * (i >> 2) + 4 * n + (i & 3); }

struct Unit { int pm, pn; };
struct Gemm { const bf16_t* A; const bf16_t* Bt; int M, N, K; };

struct StaticOrder {
    int nM, nN, nwg, G, c;
    __host__ __device__ void init(int M, int N, int G_, int c_) { nM = M / BM; nN = N / BM; nwg = nM * nN; G = G_; c = c_; }
    __host__ __device__ bool next(int i, Unit& u) const {
        const long L = (long)i * G + c; if (L >= nwg) return false;
        int wgid = (int)L; { const int q = nwg / NXCD, r = nwg % NXCD, xcd = wgid % NXCD, off = wgid / NXCD; wgid = (xcd < r ? xcd * (q + 1) : r * (q + 1) + (xcd - r) * q) + off; }
        const int nig = WGM * nN, gid = wgid / nig, fm = gid * WGM, gsz = (nM - fm) < WGM ? (nM - fm) : WGM;
        u.pm = fm + ((wgid % nig) % gsz); u.pn = (wgid % nig) / gsz; return true;
    }
    __device__ __forceinline__ void a_ready(const Unit&) const {}
    __device__ __forceinline__ void done(const Unit&) const {}
};

__device__ __forceinline__ unsigned cvt_pk_bf16(float lo, float hi) { unsigned r; asm volatile("v_cvt_pk_bf16_f32 %0, %1, %2" : "=v"(r) : "v"(lo), "v"(hi)); return r; }
typedef float f32x2 __attribute__((ext_vector_type(2)));
struct EpiInProj {
    static constexpr bool PERM = true, AFTER_DRAIN = false;
    bf16_t *QKV, *CQ, *CKV, *KR, *GATE; const float* ropec; const float* ropes; float* ssq_q; float* ssq_kv;
    __device__ __forceinline__ void operator()(const f32x4 (&acc)[2][2][4][2], const Unit& u, int wr, int wc, int fr, int fq) const {
        const int row0 = u.pm * BM + wr * 64 + fr; const int pn = u.pn;
        if (pn == 15) {
            if (wc < 2) {
                const int a = wc * 4 + fq;
#pragma unroll
                for (int ai = 0; ai < 2; ++ai)
#pragma unroll
                    for (int m = 0; m < 4; ++m) { const int row = row0 + ai * HALF + m * 16, s = row & (SEQ - 1);
                        const f32x4 c = *(const f32x4*)(ropec + s * 32 + 4 * a), sn = *(const f32x4*)(ropes + s * 32 + 4 * a);
                        const f32x4 x1 = acc[ai][0][m][0], x2 = acc[ai][0][m][1];
                        const f32x4 y1 = x1 * c - x2 * sn, y2 = x1 * sn + x2 * c;
                        u32x4 w; w.x = cvt_pk_bf16(y1[0], y1[1]); w.y = cvt_pk_bf16(y1[2], y1[3]); w.z = cvt_pk_bf16(y2[0], y2[1]); w.w = cvt_pk_bf16(y2[2], y2[3]);
                        *(u32x4*)(KR + (size_t)row * 64 + 8 * a) = w; }
            }
            return;
        }
        bf16_t* base; int ldc, colt;
        if (pn < 12) { base = QKV; ldc = 3072; colt = pn * 256; }
        else if (pn < 14) { base = CQ; ldc = 512; colt = (pn - 12) * 256; }
        else if (pn == 14) { base = CKV; ldc = 256; colt = 0; }
        else { base = GATE; ldc = 2048; colt = (pn - 16) * 256; }
        const int col0 = colt + wc * 32 + 8 * fq;
        const float sc = (pn < 4) ? 0.125f * 1.4426950408889634f : 1.0f;
#pragma unroll
        for (int ai = 0; ai < 2; ++ai)
#pragma unroll
            for (int m = 0; m < 4; ++m) { bf16_t* rowp = base + (size_t)(row0 + ai * HALF + m * 16) * ldc + col0;
#pragma unroll
                for (int bj = 0; bj < 2; ++bj) { const f32x4 v0 = acc[ai][bj][m][0] * sc, v1 = acc[ai][bj][m][1] * sc;
                    u32x4 w; w.x = cvt_pk_bf16(v0[0], v0[1]); w.y = cvt_pk_bf16(v0[2], v0[3]); w.z = cvt_pk_bf16(v1[0], v1[1]); w.w = cvt_pk_bf16(v1[2], v1[3]);
                    *(u32x4*)(rowp + bj * HALF) = w; } }
        if (pn >= 12 && pn <= 14) {
            float* ssq = (pn == 14) ? ssq_kv : ssq_q;
#pragma unroll
            for (int ai = 0; ai < 2; ++ai)
#pragma unroll
                for (int m = 0; m < 4; ++m) { float s = 0.f;
#pragma unroll
                    for (int bj = 0; bj < 2; ++bj)
#pragma unroll
                        for (int n = 0; n < 2; ++n) { const f32x4 v = acc[ai][bj][m][n]; s += (v[0] * v[0] + v[1] * v[1]) + (v[2] * v[2] + v[3] * v[3]); }
                    s += __shfl_xor(s, 16); s += __shfl_xor(s, 32);
                    if (fq == 0) __hip_atomic_fetch_add(ssq + row0 + ai * HALF + m * 16, s, __ATOMIC_RELAXED, __HIP_MEMORY_SCOPE_AGENT); }
        }
    }
};
template <bool ROPE> struct EpiRowScale {
    static constexpr bool PERM = true, AFTER_DRAIN = false;
    bf16_t* O; int ldc; const float* ssq; float inv_n; const float* ropec; const float* ropes; float qscale;
    __device__ __forceinline__ void operator()(const f32x4 (&acc)[2][2][4][2], const Unit& u, int wr, int wc, int fr, int fq) const {
        const int row0 = u.pm * BM + wr * 64 + fr; const int col0 = u.pn * BM + wc * 32 + 8 * fq;
        bool isr[2]; int ra[2];
#pragma unroll
        for (int bj = 0; bj < 2; ++bj) { const int c0 = col0 + bj * HALF, off = c0 % 192; isr[bj] = ROPE && (off >= 128); ra[bj] = (off - 128) >> 3; }
#pragma unroll
        for (int ai = 0; ai < 2; ++ai)
#pragma unroll
            for (int m = 0; m < 4; ++m) { const int row = row0 + ai * HALF + m * 16, s = row & (SEQ - 1); const float r = qscale / sqrtf(ssq[row] * inv_n + 1e-6f);
                bf16_t* rowp = O + (size_t)row * ldc + col0;
#pragma unroll
                for (int bj = 0; bj < 2; ++bj) { f32x4 v0 = acc[ai][bj][m][0] * r, v1 = acc[ai][bj][m][1] * r;
                    if (ROPE) { if (isr[bj]) { const f32x4 c = *(const f32x4*)(ropec + s * 32 + 4 * ra[bj]), sn = *(const f32x4*)(ropes + s * 32 + 4 * ra[bj]);
                        const f32x4 y1 = v0 * c - v1 * sn, y2 = v0 * sn + v1 * c; v0 = y1; v1 = y2; } }
                    u32x4 w; w.x = cvt_pk_bf16(v0[0], v0[1]); w.y = cvt_pk_bf16(v0[2], v0[3]); w.z = cvt_pk_bf16(v1[0], v1[1]); w.w = cvt_pk_bf16(v1[2], v1[3]);
                    *(u32x4*)(rowp + bj * HALF) = w; } }
    }
};
struct EpiResF32 {
    static constexpr bool PERM = false, AFTER_DRAIN = false;
    const float* base; float* out; int ldc;
    __device__ __forceinline__ void operator()(const f32x4 (&acc)[2][2][4][2], const Unit& u, int wr, int wc, int fr, int fq) const {
        const int row0 = u.pm * BM + wr * 64 + fr, col0 = u.pn * BM + wc * 32 + 4 * fq;
#pragma unroll
        for (int ai = 0; ai < 2; ++ai)
#pragma unroll
            for (int m = 0; m < 4; ++m) { const size_t off = (size_t)(row0 + ai * HALF + m * 16) * ldc + col0;
#pragma unroll
                for (int bj = 0; bj < 2; ++bj)
#pragma unroll
                    for (int n = 0; n < 2; ++n) { const f32x4 bs = *(const f32x4*)(base + off + bj * HALF + n * 16); *(f32x4*)(out + off + bj * HALF + n * 16) = bs + acc[ai][bj][m][n]; } }
    }
};
template <bool BASE_BF16> struct EpiResB {
    static constexpr bool PERM = true, AFTER_DRAIN = false;
    const void* base; bf16_t* out; int ldc;
    __device__ __forceinline__ void operator()(const f32x4 (&acc)[2][2][4][2], const Unit& u, int wr, int wc, int fr, int fq) const {
        const int row0 = u.pm * BM + wr * 64 + fr, col0 = u.pn * BM + wc * 32 + 8 * fq;
#pragma unroll
        for (int ai = 0; ai < 2; ++ai)
#pragma unroll
            for (int m = 0; m < 4; ++m) { const size_t off = (size_t)(row0 + ai * HALF + m * 16) * ldc + col0;
#pragma unroll
                for (int bj = 0; bj < 2; ++bj) { f32x4 b0, b1;
                    if (BASE_BF16) { const u32x4 bv = *(const u32x4*)((const bf16_t*)base + off + bj * HALF);
                        b0[0] = __uint_as_float(bv.x << 16); b0[1] = __uint_as_float(bv.x & 0xffff0000u); b0[2] = __uint_as_float(bv.y << 16); b0[3] = __uint_as_float(bv.y & 0xffff0000u);
                        b1[0] = __uint_as_float(bv.z << 16); b1[1] = __uint_as_float(bv.z & 0xffff0000u); b1[2] = __uint_as_float(bv.w << 16); b1[3] = __uint_as_float(bv.w & 0xffff0000u); }
                    else { b0 = *(const f32x4*)((const float*)base + off + bj * HALF); b1 = *(const f32x4*)((const float*)base + off + bj * HALF + 4); }
                    const f32x4 v0 = b0 + acc[ai][bj][m][0], v1 = b1 + acc[ai][bj][m][1];
                    u32x4 w; w.x = cvt_pk_bf16(v0[0], v0[1]); w.y = cvt_pk_bf16(v0[2], v0[3]); w.z = cvt_pk_bf16(v1[0], v1[1]); w.w = cvt_pk_bf16(v1[2], v1[3]);
                    *(u32x4*)(out + off + bj * HALF) = w; } }
    }
};
struct KvOrder : StaticOrder {
    __host__ __device__ bool next(int i, Unit& u) const {
        long L; if (G != 256) { L = (long)i * G + c; if (L >= nwg) return false; }
        else if (c < 128) { if (i > 0) return false; L = c; }
        else { if (i > 2) return false; L = 128 + 3 * (c - 128) + i; }
        int wgid = (int)L; { const int q = nwg / NXCD, r = nwg % NXCD, xcd = wgid % NXCD, off = wgid / NXCD; wgid = (xcd < r ? xcd * (q + 1) : r * (q + 1) + (xcd - r) * q) + off; }
        const int nig = WGM * nN, gid = wgid / nig, fm = gid * WGM, gsz = (nM - fm) < WGM ? (nM - fm) : WGM;
        u.pm = fm + ((wgid % nig) % gsz); u.pn = (wgid % nig) / gsz; return true;
    }
};
template <class Epi, class Sched, bool ALIGN_EPI = false, bool SP2 = false>
__device__ __forceinline__ void gemm_phase(PG8_LAS unsigned char* lds, const Gemm g, const Sched& S, const Epi& E) {
    int tid_ = threadIdx.x; asm volatile("" : "+v"(tid_));
    const int tid = tid_, wid = __builtin_amdgcn_readfirstlane(tid >> 6), lane = tid & 63, wr = wid >> 2, wc = wid & 3, fr = lane & 15, fq = lane >> 4;
    const int K = g.K, nt = K / BK;
    unsigned voffA[2], voffB[2];
#pragma unroll
    for (int i = 0; i < 2; ++i) { int R, C; stage_rc(tid * 16 + i * 8192, R, C); const int Rb = Epi::PERM ? ((R & ~31) + perm32(R & 31)) : R;
        voffA[i] = (unsigned)(R * K + C) * 2u; voffB[i] = (unsigned)(Rb * K + C) * 2u; }
    const size_t kstep = (size_t)(BK * 2);
    const size_t hstep = (size_t)HALF * K * 2;
    const size_t tstep = 2 * hstep;
    const unsigned ldsw = (unsigned)wid * 1024u;
    const int aoff = lds_byte(wr * 64 + fr, fq * 8), boff = lds_byte(wc * 32 + fr, fq * 8);
#define PG8_SA(b, h) (((b) * 2 + (h)) * HTB)
#define PG8_SB(b, h) ((4 + (b) * 2 + (h)) * HTB)
#define PG8_STAGE(bufoff, gbase, voff) do { _Pragma("unroll") for (int _i = 0; _i < 2; ++_i) \
        __builtin_amdgcn_global_load_lds((const unsigned*)((const char*)(gbase) + (voff)[_i]), (PG8_LAS unsigned*)(lds + (bufoff) + ldsw + _i * 8192), 16, 0, 0); } while (0)
#define PG8_LDA(dst, b, h) do { _Pragma("unroll") for (int m = 0; m < 4; ++m) _Pragma("unroll") for (int k = 0; k < 2; ++k) dst[m][k] = *(const PG8_LAS bf16x8*)(lds + PG8_SA(b, h) + aoff + m * 2048 + k * 1024); } while (0)
#define PG8_LDB(dst, b, h) do { _Pragma("unroll") for (int n = 0; n < 2; ++n) _Pragma("unroll") for (int k = 0; k < 2; ++k) dst[n][k] = *(const PG8_LAS bf16x8*)(lds + PG8_SB(b, h) + boff + n * 2048 + k * 1024); } while (0)
#define PG8_MMA(ai, bj, At, Bt) do { __builtin_amdgcn_s_setprio(1); _Pragma("unroll") for (int m = 0; m < 4; ++m) _Pragma("unroll") for (int n = 0; n < 2; ++n) _Pragma("unroll") for (int k = 0; k < 2; ++k) \
        acc[ai][bj][m][n] = __builtin_amdgcn_mfma_f32_16x16x32_bf16(Bt[n][k], At[m][k], acc[ai][bj][m][n], 0, 0, 0); __builtin_amdgcn_s_setprio(0); } while (0)
#define PG8_WAIT_V(n) asm volatile("s_waitcnt vmcnt(" #n ")" ::: "memory")
#define PG8_WAIT_L(n) asm volatile("s_waitcnt lgkmcnt(" #n ")" ::: "memory")
#define PG8_BAR __builtin_amdgcn_s_barrier()
#define PG8_SCHED __builtin_amdgcn_sched_barrier(0)
    Unit cur, nxt; int ui = 0;
    if (!S.next(0, cur)) return;
    f32x4 acc[2][2][4][2];
#pragma unroll
    for (int a = 0; a < 2; ++a)
#pragma unroll
        for (int b = 0; b < 2; ++b)
#pragma unroll
            for (int m = 0; m < 4; ++m)
#pragma unroll
                for (int n = 0; n < 2; ++n) acc[a][b][m][n] = (f32x4){0.f, 0.f, 0.f, 0.f};
    bf16x8 At[4][2], B0[2][2], B1[2][2];
    const char* cA = (const char*)g.A + (size_t)cur.pm * tstep; const char* cB = (const char*)g.Bt + (size_t)cur.pn * tstep;
    S.a_ready(cur);
    if constexpr (SP2) {
        PG8_STAGE(PG8_SB(0, 0), cB, voffB); PG8_STAGE(PG8_SB(0, 1), cB + hstep, voffB); PG8_STAGE(PG8_SA(0, 0), cA, voffA); PG8_STAGE(PG8_SA(0, 1), cA + hstep, voffA);
        if (wr == 1) PG8_BAR;
        PG8_WAIT_V(2); PG8_BAR;
        PG8_STAGE(PG8_SB(1, 0), cB + kstep, voffB); PG8_STAGE(PG8_SA(1, 0), cA + kstep, voffA); PG8_STAGE(PG8_SB(1, 1), cB + hstep + kstep, voffB);
        PG8_WAIT_V(6); PG8_BAR;
    } else {
        PG8_STAGE(PG8_SB(0, 0), cB, voffB); PG8_STAGE(PG8_SA(0, 0), cA, voffA); PG8_STAGE(PG8_SB(0, 1), cB + hstep, voffB); PG8_STAGE(PG8_SA(0, 1), cA + hstep, voffA);
        if (wr == 1) PG8_BAR;
        PG8_WAIT_V(4); PG8_BAR;
        PG8_STAGE(PG8_SB(1, 0), cB + kstep, voffB); PG8_STAGE(PG8_SA(1, 0), cA + kstep, voffA); PG8_STAGE(PG8_SB(1, 1), cB + hstep + kstep, voffB);
        PG8_WAIT_V(6); PG8_BAR;
    }
    for (;;) {
        const bool has_next = S.next(ui + 1, nxt);
        const char* nA = has_next ? (const char*)g.A + (size_t)nxt.pm * tstep : cA; const char* nB = has_next ? (const char*)g.Bt + (size_t)nxt.pn * tstep : cB;
        for (int t = 0; t < nt; t += 2) {
            const bool last = (t == nt - 2);
            const char* a1 = cA + (size_t)(t + 1) * kstep;
            const char* a2 = last ? nA : cA + (size_t)(t + 2) * kstep; const char* b2 = last ? nB : cB + (size_t)(t + 2) * kstep;
            const char* a3 = a2 + kstep; const char* b3 = b2 + kstep;
            if (last && has_next) S.a_ready(nxt);
            if constexpr (SP2) {
            PG8_LDB(B0, 0, 0); PG8_LDB(B1, 0, 1); PG8_SCHED; PG8_LDA(At, 0, 0); PG8_STAGE(PG8_SA(1, 1), a1 + hstep, voffA);
            PG8_WAIT_V(8); PG8_WAIT_L(0); PG8_BAR; PG8_MMA(0, 0, At, B0); PG8_MMA(0, 1, At, B1); PG8_BAR; PG8_SCHED;
            PG8_LDA(At, 0, 1); PG8_STAGE(PG8_SB(0, 0), b2, voffB); PG8_STAGE(PG8_SB(0, 1), b2 + hstep, voffB); PG8_STAGE(PG8_SA(0, 0), a2, voffA);
            PG8_WAIT_V(8); PG8_WAIT_L(0); PG8_BAR; PG8_MMA(1, 0, At, B0); PG8_MMA(1, 1, At, B1); PG8_BAR; PG8_SCHED;
            PG8_LDB(B0, 1, 0); PG8_LDB(B1, 1, 1); PG8_SCHED; PG8_LDA(At, 1, 0); PG8_STAGE(PG8_SA(0, 1), a2 + hstep, voffA);
            PG8_WAIT_V(8); PG8_WAIT_L(0); PG8_BAR; PG8_MMA(0, 0, At, B0); PG8_MMA(0, 1, At, B1); PG8_BAR; PG8_SCHED;
            PG8_LDA(At, 1, 1); PG8_STAGE(PG8_SB(1, 0), b3, voffB); PG8_STAGE(PG8_SB(1, 1), b3 + hstep, voffB); PG8_STAGE(PG8_SA(1, 0), a3, voffA);
            PG8_WAIT_V(8); PG8_WAIT_L(0); PG8_BAR; PG8_MMA(1, 0, At, B0); PG8_MMA(1, 1, At, B1); PG8_BAR; PG8_SCHED;
            } else {
            PG8_LDB(B0, 0, 0); PG8_SCHED; PG8_LDA(At, 0, 0); PG8_STAGE(PG8_SA(1, 1), a1 + hstep, voffA);
            PG8_WAIT_L(8); PG8_BAR; PG8_WAIT_L(0); PG8_MMA(0, 0, At, B0); PG8_BAR; PG8_SCHED;
            PG8_LDB(B1, 0, 1); PG8_STAGE(PG8_SB(0, 0), b2, voffB);
            PG8_BAR; PG8_WAIT_L(0); PG8_MMA(0, 1, At, B1); PG8_BAR;
            PG8_LDA(At, 0, 1); PG8_STAGE(PG8_SA(0, 0), a2, voffA);
            PG8_BAR; PG8_WAIT_L(0); PG8_MMA(1, 0, At, B0); PG8_BAR; PG8_SCHED;
            PG8_STAGE(PG8_SB(0, 1), b2 + hstep, voffB);
            PG8_WAIT_V(6); PG8_BAR; PG8_MMA(1, 1, At, B1); PG8_BAR;
            PG8_LDB(B0, 1, 0); PG8_SCHED; PG8_LDA(At, 1, 0); PG8_STAGE(PG8_SA(0, 1), a2 + hstep, voffA);
            PG8_WAIT_L(8); PG8_BAR; PG8_WAIT_L(0); PG8_MMA(0, 0, At, B0); PG8_BAR; PG8_SCHED;
            PG8_LDB(B1, 1, 1); PG8_STAGE(PG8_SB(1, 0), b3, voffB);
            PG8_BAR; PG8_WAIT_L(0); PG8_MMA(0, 1, At, B1); PG8_BAR;
            PG8_LDA(At, 1, 1); PG8_STAGE(PG8_SA(1, 0), a3, voffA);
            PG8_BAR; PG8_WAIT_L(0); PG8_MMA(1, 0, At, B0); PG8_BAR; PG8_SCHED;
            PG8_STAGE(PG8_SB(1, 1), b3 + hstep, voffB);
            PG8_WAIT_V(6); PG8_BAR; PG8_MMA(1, 1, At, B1); PG8_BAR;
            }
        }
        if constexpr (ALIGN_EPI) { if (wr == 0) PG8_BAR; }
        if constexpr (!Epi::AFTER_DRAIN) { E(acc, cur, wr, wc, fr, fq); S.done(cur); }
        if (!has_next) break;
#pragma unroll
        for (int a = 0; a < 2; ++a)
#pragma unroll
            for (int b = 0; b < 2; ++b)
#pragma unroll
                for (int m = 0; m < 4; ++m)
#pragma unroll
                    for (int n = 0; n < 2; ++n) acc[a][b][m][n] = (f32x4){0.f, 0.f, 0.f, 0.f};
        cur = nxt; cA = nA; cB = nB; ++ui;
        if constexpr (ALIGN_EPI) { if (wr == 1) PG8_BAR; }
    }
    PG8_WAIT_V(0);
    if constexpr (!ALIGN_EPI) { if (wr == 0) PG8_BAR; }
    PG8_BAR;
    if constexpr (Epi::AFTER_DRAIN) { E.fused(acc, cur, wr, wc, fr, fq, lds, wid, lane); S.done(cur); }
#undef PG8_SA
#undef PG8_SB
#undef PG8_STAGE
#undef PG8_LDA
#undef PG8_LDB
#undef PG8_MMA
#undef PG8_WAIT_V
#undef PG8_WAIT_L
#undef PG8_BAR
#undef PG8_SCHED
}
}
#define GAS __attribute__((address_space(1)))
#define LAS __attribute__((address_space(3)))
typedef unsigned short bf16;
typedef unsigned v4u __attribute__((ext_vector_type(4)));
typedef float f32x4 __attribute__((ext_vector_type(4)));
typedef short bf16x8 __attribute__((ext_vector_type(8)));
typedef GAS unsigned gu32;
typedef GAS unsigned long long gu64;
#define RLX_AGENT __ATOMIC_RELAXED, __HIP_MEMORY_SCOPE_AGENT
#define LDS_WAIT() asm volatile("s_waitcnt lgkmcnt(0)" ::: "memory")
#define VM_WAIT() asm volatile("s_waitcnt vmcnt(0)" ::: "memory")
__device__ __forceinline__ unsigned long long rt() { return __builtin_amdgcn_s_memrealtime(); }
__device__ __forceinline__ unsigned f2bf(float f) { unsigned u = __builtin_bit_cast(unsigned, f); return (u + 0x7fffu + ((u >> 16) & 1u)) >> 16; }
__device__ __forceinline__ unsigned pk2(float lo, float hi) { return f2bf(lo) | (f2bf(hi) << 16); }

#define XB_TMO      128
#define XB_XCNT(j)  (256  + 64 * (j))
#define XB_XSUB(j)  (1280 + 64 * (j))
#define XB_XGEN(j)  (2304 + 64 * (j))
#define XB_TOP      3328
#define XB_TOPGEN   3392
#define XCD_BAR_WORDS 3456
#define XB_SPIN_CAP (1u << 18)

__device__ __forceinline__ unsigned xb_ld(unsigned* p)              { return __hip_atomic_load(p, __ATOMIC_RELAXED, __HIP_MEMORY_SCOPE_AGENT); }
__device__ __forceinline__ unsigned xb_add(unsigned* p, unsigned v) { return __hip_atomic_fetch_add(p, v, __ATOMIC_RELAXED, __HIP_MEMORY_SCOPE_AGENT); }
__device__ __forceinline__ unsigned xb_xcc_id() { return (unsigned)__builtin_amdgcn_s_getreg((3 << 11) | 20) & 0xFu; }
#define XB_SPIN(cond, bar) do { unsigned _sp = 0; while (cond) { __builtin_amdgcn_s_sleep(1); \
    if ((++_sp & 255u) == 0u) { if (xb_ld(&(bar)[XB_TMO])) break; if (_sp > XB_SPIN_CAP) { atomicAdd(&(bar)[XB_TMO], 1u); break; } } } } while (0)

struct XcdBarrier {
    unsigned* bar; unsigned x;
    volatile LAS unsigned* st;
};

__device__ __forceinline__ XcdBarrier xcd_barrier_post(unsigned* bar, volatile LAS unsigned* st) {
    XcdBarrier b; b.bar = bar; b.x = xb_xcc_id(); b.st = st;
    if (threadIdx.x == 0) (void)xb_add(&bar[XB_XCNT(b.x)], 1u);
    return b;
}
__device__ __forceinline__ void xcd_barrier_complete(unsigned* bar, unsigned x, unsigned& nloc, unsigned& nx) {
    const unsigned G = gridDim.x * gridDim.y * gridDim.z;
    unsigned sum, cnt, mine, sp = 0u;
    for (;;) {
        sum = 0u; cnt = 0u; mine = 0u;
#pragma unroll
        for (unsigned j = 0; j < 16; ++j) { const unsigned c = xb_ld(&bar[XB_XCNT(j)]); sum += c; cnt += (c > 0u) ? 1u : 0u; mine = (j == x) ? c : mine; }
        if (sum == G) break;
        __builtin_amdgcn_s_sleep(1);
        if ((++sp & 255u) == 0u) { if (xb_ld(&bar[XB_TMO])) break; if (sp > XB_SPIN_CAP) { atomicAdd(&bar[XB_TMO], 1u); break; } }
    }
    nloc = mine > 0u ? mine : 1u; nx = cnt > 0u ? cnt : 1u;
}

__device__ __forceinline__ void xcd_barrier(const XcdBarrier& b) {
    asm volatile("s_waitcnt vmcnt(0)" ::: "memory");
    __syncthreads();
    if (threadIdx.x == 0) {
        unsigned* bar = b.bar;
        __builtin_amdgcn_s_waitcnt(0);
        unsigned nloc = b.st[0], nx = b.st[1];
        if (nloc == 0u) { xcd_barrier_complete(bar, b.x, nloc, nx); b.st[0] = nloc; b.st[1] = nx; }
        const unsigned old = xb_add(&bar[XB_XSUB(b.x)], 1u);
        const unsigned gen = old / nloc;
        if (old + 1u == (gen + 1u) * nloc) {
            __builtin_amdgcn_fence(__ATOMIC_RELEASE, "agent");
            asm volatile("s_waitcnt vmcnt(0)" ::: "memory");
            const unsigned og = xb_add(&bar[XB_TOP], 1u);
            const unsigned tg = og / nx;
            if (og + 1u == (tg + 1u) * nx) xb_add(&bar[XB_TOPGEN], 1u);
            else XB_SPIN(xb_ld(&bar[XB_TOPGEN]) == tg, bar);
            __builtin_amdgcn_fence(__ATOMIC_ACQUIRE, "agent");
            xb_add(&bar[XB_XGEN(b.x)], 1u);
            asm volatile("s_waitcnt vmcnt(0)" ::: "memory");
        } else {
            XB_SPIN(xb_ld(&bar[XB_XGEN(b.x)]) == gen, bar);
            __builtin_amdgcn_fence(__ATOMIC_ACQUIRE, "agent");
            asm volatile("s_waitcnt vmcnt(0)" ::: "memory");
        }
    }
    __syncthreads();
}
namespace att {
typedef unsigned short bf16;
typedef short bf16x8 __attribute__((ext_vector_type(8)));
typedef short s16x4 __attribute__((ext_vector_type(4)));
typedef short v4i16_t __attribute__((ext_vector_type(4)));
typedef float f32x16 __attribute__((ext_vector_type(16)));
typedef unsigned u32x4 __attribute__((ext_vector_type(4)));
typedef float f32x2_t __attribute__((ext_vector_type(2)));
typedef __bf16 bf16x2_t __attribute__((ext_vector_type(2)));
#define ALDS __attribute__((address_space(3)))
#define ASBAR() __builtin_amdgcn_sched_barrier(0)
constexpr int WS_OFF = 135168;
constexpr int TAB_OFF = WS_OFF + 2048;
constexpr int QR_OFF = 81920;
constexpr int NQL = 6;
constexpr int ATT_LDS_BYTES = TAB_OFF + 2048;
static_assert(QR_OFF + 8 * NQL * 1024 <= WS_OFF, "MLA query park fits below the scratch");
#ifndef ATT_PRIO
#define ATT_PRIO 0
#endif
#ifndef ATT_RING
#define ATT_RING 8
#endif
#ifndef ATT_STAGGER
#define ATT_STAGGER 0
#endif
constexpr float THR2 = 8.0f;
__device__ __forceinline__ int crow(int r, int hi) { return (r & 3) + 8 * (r >> 2) + 4 * hi; }
__device__ __forceinline__ void glds16(const void* gsrc, unsigned lds_dst) { unsigned keep;
    asm volatile("s_mov_b32 %0, m0\n\ts_mov_b32 m0, %2\n\ts_nop 0\n\tglobal_load_lds_dwordx4 %1, off\n\ts_mov_b32 m0, %0" : "=&s"(keep) : "v"(gsrc), "s"(lds_dst) : "memory"); }
template <int IMM> __device__ __forceinline__ void glds16s(const void* sbase, unsigned voff, unsigned lds_dst_) { const unsigned lds_dst = lds_dst_ - (unsigned)IMM;
    asm volatile("s_mov_b32 m0, %2\n\ts_nop 0\n\tglobal_load_lds_dwordx4 %0, %1 offset:%c3" :: "v"(voff), "s"(sbase), "s"(lds_dst), "i"(IMM) : "m0", "memory"); }
__device__ __forceinline__ const unsigned char* uni_ptr(const void* p) { const unsigned long long v = (unsigned long long)p;
    const unsigned lo = __builtin_amdgcn_readfirstlane((unsigned)v), hi = __builtin_amdgcn_readfirstlane((unsigned)(v >> 32)); return (const unsigned char*)(((unsigned long long)hi << 32) | lo); }
__device__ __forceinline__ unsigned cvtpk_s(float lo, float hi) { f32x2_t v = {lo, hi}; bf16x2_t b = __builtin_convertvector(v, bf16x2_t); return __builtin_bit_cast(unsigned, b); }
__device__ __forceinline__ float swapmax(float v) { auto rr = __builtin_amdgcn_permlane32_swap(__float_as_uint(v), __float_as_uint(v), false, false); return fmaxf(__uint_as_float(rr[0]), __uint_as_float(rr[1])); }
__device__ __forceinline__ float swapsum(float v) { auto rr = __builtin_amdgcn_permlane32_swap(__float_as_uint(v), __float_as_uint(v), false, false); return __uint_as_float(rr[0]) + __uint_as_float(rr[1]); }
#define ATT_WAIT_BAR() asm volatile("s_waitcnt vmcnt(0) lgkmcnt(0)\n\ts_barrier" ::: "memory")
#define ATT_WAIT_BAR_N(N) asm volatile("s_waitcnt vmcnt(" #N ") lgkmcnt(0)\n\ts_barrier" ::: "memory")

__device__ __forceinline__ float fadd_s(float a, float b) { float r; asm("v_add_f32_e32 %0, %1, %2" : "=v"(r) : "v"(a), "v"(b)); return r; }
__device__ __forceinline__ s16x4 vtr(ALDS const unsigned char* p) { return __builtin_bit_cast(s16x4, __builtin_amdgcn_ds_read_tr16_b64_v4i16((ALDS v4i16_t*)p)); }

struct AttnArgs { void* prof; const bf16* QKV; const bf16* QM; const bf16* KVM; const bf16* KR; const bf16* GATE; bf16* Y; const float* biastab; const float* subg; float lam; float oml; };

__device__ __forceinline__ void pv4(f32x16* o, int vb, bf16x8 pa0, bf16x8 pa1, bf16x8 pa2, bf16x8 pa3) {
#pragma unroll
    for (int d0 = 0; d0 < 4; ++d0) { s16x4 lo[4], hh[4];
#pragma unroll
        for (int ks = 0; ks < 4; ++ks) {
            asm volatile("ds_read_b64_tr_b16 %0, %1 offset:%c2" : "=&v"(lo[ks]) : "v"(vb), "i"(d0 * 4096 + ks * 1024) : "memory");
            asm volatile("ds_read_b64_tr_b16 %0, %1 offset:%c2" : "=&v"(hh[ks]) : "v"(vb), "i"(d0 * 4096 + ks * 1024 + 512) : "memory"); }
        asm volatile("s_waitcnt lgkmcnt(0)" ::: "memory"); ASBAR();
#define ATT_PK(k) (bf16x8){lo[k][0], lo[k][1], lo[k][2], lo[k][3], hh[k][0], hh[k][1], hh[k][2], hh[k][3]}
        o[d0] = __builtin_amdgcn_mfma_f32_32x32x16_bf16(pa0, ATT_PK(0), o[d0], 0, 0, 0);
        o[d0] = __builtin_amdgcn_mfma_f32_32x32x16_bf16(pa1, ATT_PK(1), o[d0], 0, 0, 0);
        o[d0] = __builtin_amdgcn_mfma_f32_32x32x16_bf16(pa2, ATT_PK(2), o[d0], 0, 0, 0);
        o[d0] = __builtin_amdgcn_mfma_f32_32x32x16_bf16(pa3, ATT_PK(3), o[d0], 0, 0, 0);
#undef ATT_PK
    }
}

template <bool DIFF, int MODE = 0>
__device__ __forceinline__ void attn_unit(const AttnArgs& A, int b, int h, int qb, unsigned char* shm) {
    constexpr int ND0 = DIFF ? 4 : 12;
    constexpr int QROWS = DIFF ? 128 : 256;
    constexpr int KSLOT = DIFF ? 16384 : 24576;
    constexpr int NSLOT = 3;
    constexpr int V_OFF = NSLOT * KSLOT;
    constexpr int FDM = ATT_RING - 2;
    constexpr int NDF = DIFF ? 4 : 5;
    static_assert(V_OFF + NSLOT * 16384 <= WS_OFF, "rings fit below the scratch");
    int tid_ = threadIdx.x; asm volatile("" : "+v"(tid_));
    const int tid = tid_, lane = tid & 63, r32 = lane & 31, hi = lane >> 5; const int wid = __builtin_amdgcn_readfirstlane(tid >> 6);
    const int grp = wid >> 2;
    const int map = DIFF ? grp : 0, wrow = DIFF ? (wid & 3) : wid;
    const int q0 = qb * QROWS + wrow * 32;
    const int cw = q0 >> 6;
    const int NT = (qb * QROWS + QROWS) >> 6;
    const int KL = DIFF ? 3 : 2 + grp, VL = 1 + grp;
    const long rowbase = (long)b * SEQ;
    const unsigned lds0 = (unsigned)(uintptr_t)shm;
    ALDS unsigned char* shm3 = (ALDS unsigned char*)shm;
    ALDS float* wsf = (ALDS float*)(shm3 + WS_OFF) + wid * 64;
    ALDS float* tabl = (ALDS float*)(shm3 + TAB_OFF) + map * 256;
    const int vrow = 16 * (wid & 3) + (lane >> 2), vcol = (wid >> 2) * 32 + (lane & 3) * 8;
    constexpr int PITCHB = DIFF ? 6144 : 4096;
    const int krow = 8 * wid + (lane >> 3), kchk = (lane & 7) ^ ((krow >> 1) & 7);
    const unsigned voffK = (unsigned)(krow * PITCHB + kchk * 16), voffV = (unsigned)(vrow * PITCHB + vcol * 2), voffR = (unsigned)(krow * 128 + kchk * 16);
    const unsigned char* kvbase = DIFF ? (const unsigned char*)(A.QKV + rowbase * 3072 + 1024 + h * 128) : (const unsigned char*)(A.KVM + rowbase * 2048 + h * 256);
    const unsigned char* krbase = (const unsigned char*)(A.KR + rowbase * 64);
    const unsigned kd0 = lds0 + wid * 1024, vd0 = lds0 + V_OFF + wid * 1024;
    constexpr int VIMM = DIFF ? 2048 : 256;
#define ATT_DMA_K(t, sl) do { const long _t = (t); const unsigned _so = (unsigned)((sl) * KSLOT); const unsigned char* _b = uni_ptr(kvbase + _t * (64L * PITCHB)); \
        glds16s<0>(_b, voffK, (unsigned)__builtin_amdgcn_readfirstlane(kd0 + _so)); \
        glds16s<128>(_b, voffK, (unsigned)__builtin_amdgcn_readfirstlane(kd0 + 8192 + _so)); \
        if (!DIFF) glds16s<0>(uni_ptr(krbase + _t * (64L * 128)), voffR, (unsigned)__builtin_amdgcn_readfirstlane(kd0 + 16384 + _so)); } while (0)
#define ATT_DMA_V(t, sl) do { const long _t = (t); const unsigned _so = (unsigned)((sl) * 16384); const unsigned char* _b = uni_ptr(kvbase + _t * (64L * PITCHB)); \
        glds16s<VIMM>(_b, voffV, (unsigned)__builtin_amdgcn_readfirstlane(vd0 + _so)); \
        glds16s<VIMM + 128>(_b, voffV, (unsigned)__builtin_amdgcn_readfirstlane(vd0 + 8192 + _so)); } while (0)
    if (MODE < 2) { ATT_DMA_K(0, 0); ATT_DMA_K(1, 1); if (KL > 2 && 2 < NT) ATT_DMA_K(2, 2);
    ATT_DMA_V(0, 0); if (VL > 1) ATT_DMA_V(1, 1); }
    if (DIFF) { ((ALDS float*)(shm3 + TAB_OFF))[tid] = A.biastab[(h * 2 + (tid >> 8)) * 256 + (tid & 255)]; }
    bf16x8 qr[ND0];
    { const bf16* Qw = DIFF ? A.QKV + (rowbase + q0 + r32) * 3072 + h * 128 + map * 64 + hi * 8 : A.QM + (rowbase + q0 + r32) * 1536 + h * 192 + hi * 8;
#pragma unroll
      for (int d0 = 0; d0 < ND0; ++d0) qr[d0] = *reinterpret_cast<const bf16x8*>(Qw + d0 * 16); }
    float boff = 0.f; if (DIFF) boff = A.biastab[(h * 2 + map) * 256];
    float m_ref = 0.f, l_reg = 0.f; f32x16 o[4];
#pragma unroll
    for (int d = 0; d < 4; ++d) o[d] = f32x16{};
    const int kfo = (DIFF ? map * 8192 : 0) + r32 * 128;
    int ko[4];
#pragma unroll
    for (int i = 0; i < 4; ++i) ko[i] = 16 * ((2 * i + hi) ^ ((r32 >> 1) & 7));
    const int vbo = V_OFF + ((lane >> 4) & 1) * 32 + (lane & 3) * 8 + (4 * hi + ((lane & 15) >> 2)) * 64;
    f32x16 S0, S1; float al = 1.f;
    u32x4 pw[4]; if (MODE >= 1) { pw[0] = pw[1] = pw[2] = pw[3] = (u32x4){0u, 0u, 0u, 0u}; }
    bf16x8 vfix = {1, 2, 3, 4, 5, 6, 7, 8}; if (MODE == 25) { const unsigned hsh_ = (unsigned)(threadIdx.x * 2654435761u); vfix = (bf16x8){(short)(0x3f00 + (hsh_ & 0xff)), (short)(0xbf00 + ((hsh_ >> 8) & 0xff)), (short)(0x3e80 + ((hsh_ >> 16) & 0xff)), (short)(0xbe00 + ((hsh_ >> 24) & 0xff)), (short)(0x3f40 + ((hsh_ >> 4) & 0xff)), (short)(0xbf20 + ((hsh_ >> 12) & 0xff)), (short)(0x3ec0 + ((hsh_ >> 20) & 0xff)), (short)(0xbe80 + ((hsh_ >> 2) & 0xff))}; } if (MODE >= 14) asm volatile("" : "+v"(vfix));
    bf16x8 kf[8]; bf16x8 fb[ATT_RING]; f32x16 negm; float negv = 3e38f;
#pragma unroll
    for (int r = 0; r < 16; ++r) negm[r] = 0.f;
#define ATT_MF(acc, a, b) acc = __builtin_amdgcn_mfma_f32_32x32x16_bf16(a, b, acc, 0, 0, 0)
#define ATT_XBAR() asm volatile("s_waitcnt lgkmcnt(0)\n\ts_barrier" ::: "memory")
#define ATT_KFRD(SL) do { ALDS const unsigned char* kp_ = shm3 + (SL) * KSLOT + kfo; \
        _Pragma("unroll") for (int d0 = 0; d0 < 4; ++d0) { kf[2 * d0] = *(ALDS const bf16x8*)(kp_ + ko[d0]); kf[2 * d0 + 1] = *(ALDS const bf16x8*)(kp_ + ko[d0] + 4096); } } while (0)
#define ATT_LDK(f) do { if (MODE >= 14 && MODE != 28 && MODE != 29) { fb[(f) % ATT_RING] = vfix; break; } fb[(f) % ATT_RING] = *(ALDS const bf16x8*)(kp_ + ((f) >> 3) * 8192 + ko[((f) >> 1) & 3] + ((f) & 1) * 4096); } while (0)
#define ATT_LDV(g) do { if (MODE >= 14 && MODE != 28 && MODE != 29) { fb[(g) % ATT_RING] = vfix; \
        if (MODE == 20) { s16x4 t0_, t1_; asm volatile("ds_read_b64_tr_b16 %0, %2 offset:%c3\n\tds_read_b64_tr_b16 %1, %2 offset:%c4" : "=&v"(t0_), "=&v"(t1_) : "v"(vp_), "i"(((g) & 3) * 4096 + ((g) >> 2) * 1024), "i"(((g) & 3) * 4096 + ((g) >> 2) * 1024 + 512) : "memory"); } \
        if (MODE == 24) { s16x4 t0_, t1_; asm volatile("ds_read_b64_tr_b16 %0, %2 offset:%c3\n\tds_read_b64_tr_b16 %1, %2 offset:%c4\n\ts_waitcnt lgkmcnt(10)" : "=&v"(t0_), "=&v"(t1_) : "v"(vp_), "i"(((g) & 3) * 4096 + ((g) >> 2) * 1024), "i"(((g) & 3) * 4096 + ((g) >> 2) * 1024 + 512) : "memory"); } \
        if (MODE == 21) { s16x4 t0_, t1_; asm volatile("ds_read_b64 %0, %2 offset:%c3\n\tds_read_b64 %1, %2 offset:%c4" : "=&v"(t0_), "=&v"(t1_) : "v"(vp_), "i"(((g) & 3) * 4096 + ((g) >> 2) * 1024), "i"(((g) & 3) * 4096 + ((g) >> 2) * 1024 + 512) : "memory"); } \
        if (MODE == 22) { s16x4 t0_, t1_; asm volatile("ds_read_b64_tr_b16 %0, %2 offset:%c3\n\tds_read_b64_tr_b16 %1, %2 offset:%c4" : "=&v"(t0_), "=&v"(t1_) : "v"(vp_ - V_OFF), "i"(((g) & 3) * 4096 + ((g) >> 2) * 1024), "i"(((g) & 3) * 4096 + ((g) >> 2) * 1024 + 512) : "memory"); } \
        if (MODE == 23) { bf16x8 t0_; asm volatile("ds_read_b128 %0, %1 offset:%c2" : "=&v"(t0_) : "v"(vp_), "i"(((g) & 3) * 4096 + ((g) >> 2) * 1024) : "memory"); } \
        break; } const s16x4 l_ = vtr(vp_ + ((g) & 3) * 4096 + ((g) >> 2) * 1024), h_ = vtr(vp_ + ((g) & 3) * 4096 + ((g) >> 2) * 1024 + 512); \
        fb[(g) % ATT_RING] = (bf16x8){l_[0], l_[1], l_[2], l_[3], h_[0], h_[1], h_[2], h_[3]}; } while (0)
#define ATT_XQK_D(T, WITHV) do { const float nb_ = (((T) + 2 < cw) ? boff : 0.f) - m_ref; \
        if (__any(nb_ != negv)) { negv = nb_; _Pragma("unroll") for (int r = 0; r < 16; ++r) negm[r] = nb_; asm volatile("" : "+v"(negm)); } \
        S0 = __builtin_amdgcn_mfma_f32_32x32x16_bf16(kf[0], qr[0], negm, 0, 0, 0); if (WITHV) ATT_LDV(0); ASBAR(); \
        S1 = __builtin_amdgcn_mfma_f32_32x32x16_bf16(kf[1], qr[0], negm, 0, 0, 0); if (WITHV) ATT_LDV(1); ASBAR(); \
        _Pragma("unroll") for (int m_ = 2; m_ < 8; ++m_) { if (m_ & 1) ATT_MF(S1, kf[m_], qr[m_ >> 1]); else ATT_MF(S0, kf[m_], qr[m_ >> 1]); if (WITHV) ATT_LDV(m_); ASBAR(); } } while (0)
#define ATT_XQK_M(SL, WITHV) do { ALDS const unsigned char* kp_ = shm3 + (SL) * KSLOT + kfo; const float nb_ = -m_ref; \
        _Pragma("unroll") for (int f_ = 0; f_ < FDM; ++f_) ATT_LDK(f_); \
        if (__all(nb_ == 0.f)) { const f32x16 z16_ = f32x16{};     \
            S0 = __builtin_amdgcn_mfma_f32_32x32x16_bf16(fb[0], qr[0], z16_, 0, 0, 0); S1 = __builtin_amdgcn_mfma_f32_32x32x16_bf16(fb[1], qr[0], z16_, 0, 0, 0); } \
        else { _Pragma("unroll") for (int r = 0; r < 16; ++r) { S0[r] = nb_; S1[r] = nb_; } \
            ATT_MF(S0, fb[0], qr[0]); ATT_MF(S1, fb[1], qr[0]); } \
        ATT_LDK(FDM); ATT_LDK(FDM + 1); ASBAR(); \
        _Pragma("unroll") for (int m_ = 2; m_ < 24; ++m_) { if (m_ & 1) ATT_MF(S1, fb[m_ % ATT_RING], qr[m_ >> 1]); else ATT_MF(S0, fb[m_ % ATT_RING], qr[m_ >> 1]); \
            if (m_ + FDM < 24) ATT_LDK(m_ + FDM); else if (WITHV) ATT_LDV(m_ + FDM - 24); ASBAR(); } } while (0)
#define ATT_XPV(FD) do { _Pragma("unroll") for (int g_ = 0; g_ < 16; ++g_) { if (MODE == 28) ATT_MF(o[g_ & 3], fb[g_ % ATT_RING], __builtin_bit_cast(bf16x8, pw[g_ >> 2])); else ATT_MF(o[g_ & 3], __builtin_bit_cast(bf16x8, pw[g_ >> 2]), fb[g_ % ATT_RING]); if (g_ + (FD) < 16) ATT_LDV(g_ + (FD)); ASBAR(); } } while (0)
#define ATT_RESC(AL) do { if (__any((AL) < 1.f)) { l_reg *= (AL); if (hi == 0) wsf[r32] = (AL); asm volatile("s_waitcnt lgkmcnt(0)" ::: "memory"); \
        _Pragma("unroll") for (int r = 0; r < 16; ++r) { const float al_ = wsf[crow(r, hi)]; _Pragma("unroll") for (int d = 0; d < 4; ++d) o[d][r] *= al_; } } } while (0)
    if (MODE == 29) { for (int i_ = tid * 16; i_ < V_OFF + NSLOT * 16384; i_ += 8192) *(ALDS u32x4*)(shm3 + i_) = (u32x4){0u, 0u, 0u, 0u}; }
    ATT_WAIT_BAR();
    int s0 = 0;
    { ALDS const unsigned char* vp_ = shm3 + vbo; (void)vp_; if (DIFF) { ATT_KFRD(0); ATT_XQK_D(0, false); } else ATT_XQK_M(0, false); }
    ATT_XBAR();
    if (MODE != 5 && MODE != 15 && grp) ATT_XBAR();
    for (int j = 0; j < NT; ++j) {
        const int s1 = (s0 == 2) ? 0 : s0 + 1, s2 = (s1 == 2) ? 0 : s1 + 1;
        int nd_ = 0;
        { const int tk_ = j + KL, tv_ = j + VL; const int slk_ = DIFF ? s0 : (grp ? s0 : s2), slv_ = grp ? s2 : s1;
          if (MODE < 2) { if (tk_ < NT) { ATT_DMA_K(tk_, slk_); nd_ += DIFF ? 2 : 3; }
          if (tv_ < NT) { ATT_DMA_V(tv_, slv_); nd_ += 2; } } }
        if ((MODE == 7 || MODE >= 14) && j <= cw) { if (DIFF) ATT_KFRD(s1); l_reg += S0[0] + S1[3]; }
        if (MODE != 1 && MODE != 10 && MODE != 3 && MODE != 7 && MODE < 14 && j <= cw) {
            if (DIFF) ATT_KFRD(s1);
            if (DIFF && (j + 2 >= cw)) { ALDS const float* tb_ = tabl + (64 * j - q0 - r32 + 192);
#pragma unroll
                for (int r = 0; r < 16; ++r) { const int kk_ = crow(r, hi); S0[r] += tb_[kk_]; S1[r] += tb_[kk_ + 32]; } }
            f32x16 P0, P1;
#pragma unroll
            for (int r = 0; r < 16; ++r) { P0[r] = __builtin_amdgcn_exp2f(S0[r]); P1[r] = __builtin_amdgcn_exp2f(S1[r]); }
            float ps_;
            { float a0_ = fadd_s(P0[0], P1[0]), a1_ = fadd_s(P0[1], P1[1]), a2_ = fadd_s(P0[2], P1[2]), a3_ = fadd_s(P0[3], P1[3]);
#pragma unroll
              for (int r = 4; r < 16; r += 4) { a0_ = fadd_s(a0_, fadd_s(P0[r], P1[r])); a1_ = fadd_s(a1_, fadd_s(P0[r + 1], P1[r + 1])); a2_ = fadd_s(a2_, fadd_s(P0[r + 2], P1[r + 2])); a3_ = fadd_s(a3_, fadd_s(P0[r + 3], P1[r + 3])); }
              ps_ = fadd_s(fadd_s(a0_, a1_), fadd_s(a2_, a3_)); }
            l_reg += ps_;
            pw[0] = (u32x4){cvtpk_s(P0[0], P0[1]), cvtpk_s(P0[2], P0[3]), cvtpk_s(P0[4], P0[5]), cvtpk_s(P0[6], P0[7])};
            pw[1] = (u32x4){cvtpk_s(P0[8], P0[9]), cvtpk_s(P0[10], P0[11]), cvtpk_s(P0[12], P0[13]), cvtpk_s(P0[14], P0[15])};
            pw[2] = (u32x4){cvtpk_s(P1[0], P1[1]), cvtpk_s(P1[2], P1[3]), cvtpk_s(P1[4], P1[5]), cvtpk_s(P1[6], P1[7])};
            pw[3] = (u32x4){cvtpk_s(P1[8], P1[9]), cvtpk_s(P1[10], P1[11]), cvtpk_s(P1[12], P1[13]), cvtpk_s(P1[14], P1[15])};
            al = 1.f;
            if (__any(ps_ > 65536.f)) { const float pr_ = swapsum(ps_); const float dl_ = pr_ > 65536.f ? __builtin_amdgcn_logf(pr_) : 0.f; m_ref += dl_; al = __builtin_amdgcn_exp2f(-dl_); }
        }
        if (nd_ == NDF) { if (DIFF) ATT_WAIT_BAR_N(4); else ATT_WAIT_BAR_N(5); } else ATT_WAIT_BAR();
        if (MODE != 1 && MODE != 10 && MODE != 4 && j <= cw) {
            ALDS const unsigned char* vp_ = shm3 + vbo + s0 * 16384;
            if (ATT_PRIO) __builtin_amdgcn_s_setprio(ATT_PRIO);
            if (DIFF) { if (j < cw) ATT_XQK_D(j + 1, true); else { _Pragma("unroll") for (int g_ = 0; g_ < 8; ++g_) ATT_LDV(g_); } ASBAR(); ATT_XPV(8); }
            else { if (j < cw) ATT_XQK_M(s1, true); else { _Pragma("unroll") for (int g_ = 0; g_ < FDM; ++g_) ATT_LDV(g_); } ASBAR(); ATT_XPV(FDM); }
            ATT_RESC(al);
            if (ATT_PRIO) __builtin_amdgcn_s_setprio(0);
        }
        ATT_XBAR();
        s0 = s1;
    }
    if (MODE != 5 && MODE != 15 && !grp) ATT_XBAR();
#undef ATT_DMA_K
#undef ATT_DMA_V
#undef ATT_KFRD
#undef ATT_LDK
#undef ATT_LDV
#undef ATT_XQK_D
#undef ATT_XQK_M
#undef ATT_XPV
#undef ATT_MF
#undef ATT_RESC
#undef ATT_XBAR
    if (MODE >= 1) { asm volatile("" : "+v"(l_reg)); ATT_WAIT_BAR(); if (l_reg == 123456.f) A.Y[tid] = (bf16)(int)(o[0][0] + o[1][1] + o[2][2] + o[3][3] + m_ref); ATT_WAIT_BAR(); return; }
    {
    int tid2_ = threadIdx.x; asm volatile("" : "+v"(tid2_));
    const int lane = tid2_ & 63, r32 = lane & 31, hi = lane >> 5; const int wid = __builtin_amdgcn_readfirstlane(tid2_ >> 6);
    const int map = DIFF ? (wid >> 2) : 0, wrow = DIFF ? (wid & 3) : wid;
    const int q0 = qb * QROWS + wrow * 32;
    ALDS float* wsf = (ALDS float*)(shm3 + WS_OFF) + wid * 64;
    ATT_WAIT_BAR();
    l_reg = swapsum(l_reg);
    if (hi == 0) wsf[32 + r32] = __builtin_amdgcn_rcpf(l_reg);
    asm volatile("s_waitcnt lgkmcnt(0)" ::: "memory");
    float rli[16];
#pragma unroll
    for (int r = 0; r < 16; ++r) rli[r] = wsf[32 + crow(r, hi)];
    ALDS bf16* stg;
    bool writer = true;
    if (DIFF) {
        ALDS float* X = (ALDS float*)(shm3 + (wid & 3) * 16384);
        if (map == 1) {
            const float lam = A.lam;
#pragma unroll
            for (int r = 0; r < 16; ++r) { const float f = rli[r] * lam; const int orow = crow(r, hi);
#pragma unroll
                for (int d = 0; d < 4; ++d) X[orow * 128 + d * 32 + r32] = o[d][r] * f; }
        }
        ATT_WAIT_BAR();
        stg = (ALDS bf16*)(shm3 + (wid & 3) * 16384);
        if (map == 0) {
            float g4[4];
#pragma unroll
            for (int d = 0; d < 4; ++d) g4[d] = A.subg[d * 32 + r32] * A.oml;
            float ss[16];
#pragma unroll
            for (int r = 0; r < 16; ++r) { const int orow = crow(r, hi); float s = 0.f;
#pragma unroll
                for (int d = 0; d < 4; ++d) { const float v = o[d][r] * rli[r] - X[orow * 128 + d * 32 + r32]; o[d][r] = v; s += v * v; }
                ss[r] = s; }
#pragma unroll
            for (int r = 0; r < 16; ++r) { float s = ss[r];
                s += __shfl_xor(s, 1); s += __shfl_xor(s, 2); s += __shfl_xor(s, 4); s += __shfl_xor(s, 8); s += __shfl_xor(s, 16);
                ss[r] = 1.0f / sqrtf(s * (1.0f / 128.0f) + EPS); }
            asm volatile("s_waitcnt lgkmcnt(0)" ::: "memory");
#pragma unroll
            for (int r = 0; r < 16; ++r) { const int orow = crow(r, hi);
#pragma unroll
                for (int d = 0; d < 4; ++d) stg[orow * 128 + d * 32 + r32] = (bf16)(cvtpk_s(o[d][r] * ss[r] * g4[d], 0.f) & 0xffffu); }
        } else writer = false;
    } else {
        stg = (ALDS bf16*)(shm3 + wid * 8192);
#pragma unroll
        for (int r = 0; r < 16; ++r) { const int orow = crow(r, hi);
#pragma unroll
            for (int d = 0; d < 4; ++d) stg[orow * 128 + d * 32 + r32] = (bf16)(cvtpk_s(o[d][r] * rli[r], 0.f) & 0xffffu); }
    }
    if (writer) {
        asm volatile("s_waitcnt lgkmcnt(0)" ::: "memory");
        const int gcol = (DIFF ? 0 : 1024) + h * 128;
#pragma unroll
        for (int i = 0; i < 8; ++i) { const int row = i * 4 + (lane >> 4), ch = lane & 15;
            const u32x4 ov = *(ALDS const u32x4*)(stg + row * 128 + ch * 8);
            const size_t gi = (size_t)(rowbase + q0 + row) * 2048 + gcol + ch * 8;
            const u32x4 gv = *(const u32x4*)(A.GATE + gi);
            u32x4 yv;
#pragma unroll
            for (int e = 0; e < 4; ++e) {
                const float o_lo = __uint_as_float(ov[e] << 16), o_hi = __uint_as_float(ov[e] & 0xffff0000u);
                const float g_lo = __uint_as_float(gv[e] << 16), g_hi = __uint_as_float(gv[e] & 0xffff0000u);
                const float s_lo = g_lo * __builtin_amdgcn_rcpf(1.0f + __builtin_amdgcn_exp2f(-g_lo * LOG2E));
                const float s_hi = g_hi * __builtin_amdgcn_rcpf(1.0f + __builtin_amdgcn_exp2f(-g_hi * LOG2E));
                yv[e] = cvtpk_s(o_lo * s_lo, o_hi * s_hi); }
            *(u32x4*)(A.Y + gi) = yv; }
    }
    ATT_WAIT_BAR();
    }
}
#undef ASBAR
}
constexpr size_t MiB = 1u << 20;
constexpr size_t WS_CTL = 0, CTL_ZERO_BYTES = 1 * MiB;
constexpr size_t WS_ROPEC = 1 * MiB, WS_ROPES = WS_ROPEC + 512 * 1024;
constexpr size_t WS_SMALL = 2 * MiB;
constexpr size_t SM_BIAS = 1024, SM_RSQ = 128 * 1024, SM_RSKV = 256 * 1024;
constexpr size_t WS_WIN = 4 * MiB;
constexpr size_t WS_WQB = 52 * MiB;
constexpr size_t WS_WKVB = 55 * MiB;
constexpr size_t WS_WOUT = 57 * MiB;
constexpr size_t WS_H = 80 * MiB;
constexpr size_t WS_Y = WS_H;
constexpr size_t WS_QKV = 144 * MiB;
constexpr size_t WS_CQ = 240 * MiB;
constexpr size_t WS_CKV = 256 * MiB;
constexpr size_t WS_KR = 264 * MiB;
constexpr size_t WS_GATE = 272 * MiB;
constexpr size_t WS_QM = 336 * MiB;
constexpr size_t WS_KVM = 384 * MiB;
constexpr size_t WS_XB = 448 * MiB;
constexpr size_t WS_END = 512 * MiB;
constexpr int CW_BAR = 4096;
constexpr size_t CTL_SSQ = 65536;

constexpr int RING_OFF = 0, RING_BYTES = 139264;
constexpr int LDSCTL_OFF = RING_BYTES, MISC_OFF = LDSCTL_OFF + 320;
constexpr int LDS_BYTES = 147456;
constexpr int NWAVES = 8;
static_assert(att::ATT_LDS_BYTES <= RING_BYTES, "attention scratch fits the ring region");

__device__ __forceinline__ float wave_sum(float v) {
#pragma unroll
    for (int o = 1; o < 64; o <<= 1) v += __shfl_xor(v, o);
    return v;
}
__device__ __forceinline__ int in_srccol(int n) {
    if (n < 3840) return n;
    if (n < 3904) { const int p = n - 3840, a = p >> 3, j = p & 7; return 3840 + (j < 4 ? 4 * a + j : 32 + 4 * a + (j - 4)); }
    if (n < 4096) return -1;
    return n - 192;
}
__device__ __forceinline__ int qb_srccol(int n) {
    const int hh = n / 192, off = n - hh * 192; if (off < 128) return n;
    const int p = off - 128, a = p >> 3, j = p & 7; return hh * 192 + 128 + (j < 4 ? 4 * a + j : 32 + 4 * a + (j - 4));
}
template <int MODE>
__device__ __forceinline__ void transpose_item(const float* W, int K, int Nsrc, int Ndst, bf16* WT, const float* gk, LAS float* scr, int item, int lane) {
    const int nblk = Ndst / 32, kb = item / nblk, nb = item - kb * nblk, k0 = 64 * kb, n0 = 32 * nb;
    const int nd = n0 + (lane & 31);
    const int src = (MODE == 1) ? in_srccol(nd) : (MODE == 2) ? qb_srccol(nd) : nd;
    float v[32];
#pragma unroll
    for (int i = 0; i < 32; ++i) { const int kk = 2 * i + (lane >> 5); v[i] = 0.f;
        if (src >= 0) { v[i] = W[(size_t)(k0 + kk) * Nsrc + src]; if (gk) v[i] *= gk[k0 + kk]; } }
#pragma unroll
    for (int i = 0; i < 32; ++i) { const int kk = 2 * i + (lane >> 5); scr[kk * 33 + (lane & 31)] = v[i]; }
    LDS_WAIT(); asm volatile("" ::: "memory");
    const int c = lane & 7;
#pragma unroll
    for (int j = 0; j < 4; ++j) { const int n = (lane >> 3) + 8 * j; const LAS float* s = scr + (8 * c) * 33 + n;
        v4u o; o.x = pk2(s[0 * 33], s[1 * 33]); o.y = pk2(s[2 * 33], s[3 * 33]); o.z = pk2(s[4 * 33], s[5 * 33]); o.w = pk2(s[6 * 33], s[7 * 33]);
        *(GAS v4u*)(WT + (size_t)(n0 + n) * K + k0 + 8 * c) = o; }
    LDS_WAIT(); asm volatile("" ::: "memory");
}
__device__ __forceinline__ void rms_row_to_bf16(const float* xrow, const float* g, bf16* orow, int lane) {
    const GAS f32x4* xr = (const GAS f32x4*)xrow + lane; const GAS f32x4* gr = (const GAS f32x4*)g + lane;
    f32x4 v[8]; float s = 0.f;
#pragma unroll
    for (int j = 0; j < 8; ++j) { v[j] = xr[64 * j]; s += (v[j].x * v[j].x + v[j].y * v[j].y) + (v[j].z * v[j].z + v[j].w * v[j].w); }
    const float rstd = 1.0f / sqrtf(wave_sum(s) * (1.0f / DM) + EPS);
    GAS unsigned long long* o8 = (GAS unsigned long long*)orow + lane;
#pragma unroll
    for (int j = 0; j < 8; ++j) { const f32x4 gg = gr[64 * j];
        o8[64 * j] = (unsigned long long)pk2(v[j].x * rstd * gg.x, v[j].y * rstd * gg.y) | ((unsigned long long)pk2(v[j].z * rstd * gg.z, v[j].w * rstd * gg.w) << 32); }
}
template <bool TOF32> __device__ __forceinline__ void rms_row_from_bf16(const bf16* xrow, const float* g, void* orow, int lane) {
    const GAS v4u* xr = (const GAS v4u*)xrow + lane; const GAS f32x4* gr = (const GAS f32x4*)g + 2 * lane;
    float v[4][8]; float s = 0.f;
#pragma unroll
    for (int j = 0; j < 4; ++j) { const v4u w = xr[64 * j]; const unsigned ww[4] = {w.x, w.y, w.z, w.w};
#pragma unroll
        for (int e = 0; e < 4; ++e) { v[j][2 * e] = __uint_as_float(ww[e] << 16); v[j][2 * e + 1] = __uint_as_float(ww[e] & 0xffff0000u); }
#pragma unroll
        for (int e = 0; e < 8; e += 2) s += v[j][e] * v[j][e] + v[j][e + 1] * v[j][e + 1]; }
    const float rstd = 1.0f / sqrtf(wave_sum(s) * (1.0f / DM) + EPS);
#pragma unroll
    for (int j = 0; j < 4; ++j) { const f32x4 g0 = gr[128 * j], g1 = gr[128 * j + 1];
        if (TOF32) { GAS f32x4* o4 = (GAS f32x4*)orow + 2 * lane + 128 * j;
            f32x4 a, b; a.x = v[j][0] * rstd * g0.x; a.y = v[j][1] * rstd * g0.y; a.z = v[j][2] * rstd * g0.z; a.w = v[j][3] * rstd * g0.w;
            b.x = v[j][4] * rstd * g1.x; b.y = v[j][5] * rstd * g1.y; b.z = v[j][6] * rstd * g1.z; b.w = v[j][7] * rstd * g1.w; o4[0] = a; o4[1] = b; }
        else { v4u o; o.x = pk2(v[j][0] * rstd * g0.x, v[j][1] * rstd * g0.y); o.y = pk2(v[j][2] * rstd * g0.z, v[j][3] * rstd * g0.w);
            o.z = pk2(v[j][4] * rstd * g1.x, v[j][5] * rstd * g1.y); o.w = pk2(v[j][6] * rstd * g1.z, v[j][7] * rstd * g1.w); ((GAS v4u*)orow)[lane + 64 * j] = o; } }
}
__device__ __forceinline__ void rms_row_f32(const float* xrow, const float* g, float* orow, int lane) {
    const GAS f32x4* xr = (const GAS f32x4*)xrow + lane; const GAS f32x4* gr = (const GAS f32x4*)g + lane;
    f32x4 v[8]; float s = 0.f;
#pragma unroll
    for (int j = 0; j < 8; ++j) { v[j] = xr[64 * j]; s += (v[j].x * v[j].x + v[j].y * v[j].y) + (v[j].z * v[j].z + v[j].w * v[j].w); }
    const float rstd = 1.0f / sqrtf(wave_sum(s) * (1.0f / DM) + EPS);
    GAS f32x4* o4 = (GAS f32x4*)orow + lane;
#pragma unroll
    for (int j = 0; j < 8; ++j) { const f32x4 gg = gr[64 * j]; o4[64 * j] = v[j] * rstd * gg; }
}
__device__ __forceinline__ int rel_bucket(int rel) {
    const int n = rel < 0 ? -rel : rel; int bk;
    if (n < 8) bk = n; else if (n < 12) bk = 8; else if (n < 16) bk = 9; else if (n < 23) bk = 10; else if (n < 32) bk = 11;
    else if (n < 46) bk = 12; else if (n < 64) bk = 13; else if (n < 91) bk = 14; else bk = 15;
    return (rel > 0 ? 16 : 0) + bk;
}

struct Args { const float* in[12]; float* out; unsigned char* ws; int ph_lo, ph_hi; };
constexpr int N_PHASES = 11;

#define IN(k) (lo <= (k) && (k) < hi)
#ifndef MK_REP_G23
#define MK_REP_G23 1
#endif
#ifndef MK_REP_G4
#define MK_REP_G4 1
#endif
#ifndef MK_REP_NORM
#define MK_REP_NORM 1
#endif
#ifndef MK_REP_RS
#define MK_REP_RS 1
#endif
#ifndef MK_ATT_MIX
#define MK_ATT_MIX 1
#endif
#ifndef MK_ATT_PROBE
#define MK_ATT_PROBE 0
#endif
#ifndef MK_REP_G1
#define MK_REP_G1 1
#endif
#ifndef MK_REP_P0
#define MK_REP_P0 1
#endif
#ifndef MK_CG_ONLY
#define MK_CG_ONLY 0
#endif
#ifdef MK_STAMP
#define STAMP(k) do { if (blockIdx.x == 0 && threadIdx.x == 0) WSP(unsigned long long, WS_SMALL + 64)[(k)] = __builtin_amdgcn_s_memrealtime(); } while (0)
#else
#define STAMP(k) do { } while (0)
#endif
#define SEAM(k) do { if (IN(k) && IN((k) + 1)) { if (MK_CG_ONLY || (k) == 0) grid.sync(); else xcd_barrier(bar); } STAMP((k) + 1); } while (0)
#define WSP(T, off) ((T*)(args.ws + (off)))

__device__ __forceinline__ void prologue_phase(const Args& args, unsigned char* lds, int G, int vcu) {
    int tid_ = threadIdx.x; asm volatile("" : "+v"(tid_));
    const int tid = tid_, lane = tid & 63, wave = __builtin_amdgcn_readfirstlane(tid >> 6);
    const int gw = vcu * NWAVES + wave, NGW = G * NWAVES;
    const float* x = args.in[0]; const float* norm_g = args.in[1]; const float* w_in = args.in[2]; const float* diff_lambda = args.in[3];
    const float* qnorm_g = args.in[5]; const float* w_qb = args.in[6]; const float* kvnorm_g = args.in[7];
    const float* w_kvb = args.in[8]; const float* w_out = args.in[9]; const float* rel_bias = args.in[10];
    float* ropec = WSP(float, WS_ROPEC); float* ropes = WSP(float, WS_ROPES); float* smallf = WSP(float, WS_SMALL); float* biastab = WSP(float, WS_SMALL + SM_BIAS);
    bf16* Win_t = WSP(bf16, WS_WIN); bf16* Wqb_t = WSP(bf16, WS_WQB); bf16* Wkvb_t = WSP(bf16, WS_WKVB); bf16* Wout_t = WSP(bf16, WS_WOUT); bf16* Hb = WSP(bf16, WS_H);
    LAS float* scr = (LAS float*)((LAS unsigned char*)lds + RING_OFF + wave * 16384);
    constexpr int I_IN = (DM / 64) * (NINP / 32), I_QB = (QLORA / 64) * (NQB / 32), I_KVB = (KVLORA / 64) * (NKVB / 32), I_OUT = (DM / 64) * (DM / 32);
    constexpr int PER_L = I_IN + I_QB + I_KVB + I_OUT;
    for (int it = gw; it < DEPTH * PER_L; it += NGW) {
        const int l = it / PER_L; int r = it - l * PER_L;
        if (r < I_IN) { transpose_item<1>(w_in + (size_t)l * DM * NIN, DM, NIN, NINP, Win_t + (size_t)l * NINP * DM, nullptr, scr, r, lane); continue; } r -= I_IN;
        if (r < I_QB) { transpose_item<2>(w_qb + (size_t)l * QLORA * NQB, QLORA, NQB, NQB, Wqb_t + (size_t)l * NQB * QLORA, qnorm_g + l * QLORA, scr, r, lane); continue; } r -= I_QB;
        if (r < I_KVB) { transpose_item<0>(w_kvb + (size_t)l * KVLORA * NKVB, KVLORA, NKVB, NKVB, Wkvb_t + (size_t)l * NKVB * KVLORA, kvnorm_g + l * KVLORA, scr, r, lane); continue; } r -= I_KVB;
        transpose_item<0>(w_out + (size_t)l * DM * DM, DM, DM, DM, Wout_t + (size_t)l * DM * DM, nullptr, scr, r, lane);
    }
    const int gt = vcu * (NWAVES * 64) + tid, NGT = G * NWAVES * 64;
    for (int e = gt; e < SEQ * 32; e += NGT) { const int s = e >> 5, i = e & 31;
        const float inv = powf(10000.0f, -(float)i * (1.0f / 32.0f)); const float ang = (float)s * inv;
        ropec[e] = cosf(ang); ropes[e] = sinf(ang); }
    for (int e = gt; e < 16 * 256; e += NGT) { const int mh = e >> 8, idx = e & 255; biastab[e] = rel_bias[rel_bucket(idx - 192) * 16 + mh] * LOG2E; }
    if (gt < DEPTH) { const float* lp = diff_lambda + gt * 256; float s01 = 0.f, s23 = 0.f;
        for (int i = 0; i < 64; ++i) { s01 += lp[i] * lp[64 + i]; s23 += lp[128 + i] * lp[192 + i]; }
        const float lam_init = 0.8f - 0.6f * expf(-0.3f * (float)gt);
        smallf[gt] = expf(s01) - expf(s23) + lam_init; smallf[8 + gt] = 1.0f - lam_init; }
    for (int m = gw; m < MROWS; m += NGW) rms_row_to_bf16(x + (size_t)m * DM, norm_g, Hb + (size_t)m * DM, lane);
}

template <int L>
__device__ __forceinline__ void layer_phases(const Args& args, unsigned char* lds, cg::grid_group& grid, const XcdBarrier& bar, int lo, int hi, int G, int bx, int vcu) {
    constexpr int pb = 1 + 5 * L;
    LAS unsigned char* ldsl = (LAS unsigned char*)lds;
#ifdef MK_CLK
    if (L == 0 && blockIdx.x == 0 && threadIdx.x == 0) { unsigned long long* ts = WSP(unsigned long long, WS_SMALL + 64); ts[10] = __builtin_amdgcn_s_memtime(); ts[11] = __builtin_amdgcn_s_memrealtime(); }
#endif
    if (IN(pb)) {
        pg8::Gemm g{WSP(bf16, WS_H), WSP(bf16, WS_WIN) + (size_t)L * NINP * DM, MROWS, NINP, DM}; pg8::StaticOrder S; S.init(MROWS, NINP, G, bx);
        pg8::EpiInProj E{WSP(bf16, WS_QKV), WSP(bf16, WS_CQ), WSP(bf16, WS_CKV), WSP(bf16, WS_KR), WSP(bf16, WS_GATE), WSP(float, WS_ROPEC), WSP(float, WS_ROPES), WSP(float, WS_CTL + CTL_SSQ + (size_t)(2 * L) * 65536), WSP(float, WS_CTL + CTL_SSQ + (size_t)(2 * L + 1) * 65536)};
        for (int rep_ = 0; rep_ < MK_REP_G1; ++rep_)
        pg8::gemm_phase<pg8::EpiInProj, pg8::StaticOrder, true, true>(ldsl + RING_OFF, g, S, E);
    }
#ifdef MK_CLK
    if (L == 0 && blockIdx.x == 0 && threadIdx.x == 0) { unsigned long long* ts = WSP(unsigned long long, WS_SMALL + 64); ts[12] = __builtin_amdgcn_s_memtime(); ts[13] = __builtin_amdgcn_s_memrealtime(); }
#endif
    SEAM(pb);
    if (IN(pb + 1)) for (int rep_ = 0; rep_ < MK_REP_G23; ++rep_) {
        { pg8::Gemm g{WSP(bf16, WS_CQ), WSP(bf16, WS_WQB) + (size_t)L * NQB * QLORA, MROWS, NQB, QLORA}; pg8::StaticOrder S; S.init(MROWS, NQB, G, bx);
          pg8::EpiRowScale<true> E{WSP(bf16, WS_QM), NQB, WSP(float, WS_CTL + CTL_SSQ + (size_t)(2 * L) * 65536), 1.0f / QLORA, WSP(float, WS_ROPEC), WSP(float, WS_ROPES), 0.07216878364870323f * LOG2E};
#ifndef NO_G2
          pg8::gemm_phase<pg8::EpiRowScale<true>, pg8::StaticOrder, true, true>(ldsl + RING_OFF, g, S, E);
#endif
        }
        { pg8::Gemm g{WSP(bf16, WS_CKV), WSP(bf16, WS_WKVB) + (size_t)L * NKVB * KVLORA, MROWS, NKVB, KVLORA}; pg8::KvOrder S; S.init(MROWS, NKVB, G, bx);
          pg8::EpiRowScale<false> E{WSP(bf16, WS_KVM), NKVB, WSP(float, WS_CTL + CTL_SSQ + (size_t)(2 * L + 1) * 65536), 1.0f / KVLORA, nullptr, nullptr, 1.0f};
#ifndef NO_G3
          pg8::gemm_phase<pg8::EpiRowScale<false>, pg8::KvOrder, true, true>(ldsl + RING_OFF, g, S, E);
#endif
        }
    }
    SEAM(pb + 1);
#ifdef MK_CLK
    if (L == 0 && blockIdx.x == 0 && threadIdx.x == 0) { unsigned long long* ts = WSP(unsigned long long, WS_SMALL + 64); ts[2] = __builtin_amdgcn_s_memtime(); ts[3] = __builtin_amdgcn_s_memrealtime(); }
#endif
    if (IN(pb + 2)) {
        const float* smallf = WSP(float, WS_SMALL);
        att::AttnArgs A{WSP(void, WS_CTL + 524288), WSP(bf16, WS_QKV), WSP(bf16, WS_QM), WSP(bf16, WS_KVM), WSP(bf16, WS_KR), WSP(bf16, WS_GATE), WSP(bf16, WS_Y), WSP(float, WS_SMALL + SM_BIAS), args.in[4] + L * 128, smallf[L], smallf[8 + L]};
        for (int p = vcu; p < 256; p += G) {
            const int bh = p >> 3, s = p & 7, b = bh >> 3, h = bh & 7;
            for (int pass_ = 0; pass_ < 2; ++pass_) {
                const bool mla_ = ((pass_ == 0) == ((s & 1) == 0)) || !MK_ATT_MIX;
                if (MK_ATT_MIX ? mla_ : pass_ == 0) { for (int i = 0; i < 2; ++i) att::attn_unit<false>(A, b, h, i == 0 ? 15 - s : s, lds + RING_OFF); }
                else { for (int i = 0; i < 4; ++i) att::attn_unit<true>(A, b, h, i == 0 ? 31 - 2 * s : i == 1 ? 30 - 2 * s : i == 2 ? 2 * s + 1 : 2 * s, lds + RING_OFF); }
            }
#if MK_ATT_PROBE
#ifndef MK_ATT_PROBE_KIND
#define MK_ATT_PROBE_KIND 3
#endif
            if (MK_ATT_PROBE_KIND & 1) for (int i = 0; i < 2; ++i) att::attn_unit<false, MK_ATT_PROBE>(A, b, h, i == 0 ? 15 - s : s, lds + RING_OFF);
            if (MK_ATT_PROBE_KIND & 2) for (int i = 0; i < 4; ++i) att::attn_unit<true, MK_ATT_PROBE>(A, b, h, i == 0 ? 31 - 2 * s : i == 1 ? 30 - 2 * s : i == 2 ? 2 * s + 1 : 2 * s, lds + RING_OFF);
#endif
        }
    }
#ifdef MK_CLK
    if (L == 0 && blockIdx.x == 0 && threadIdx.x == 0) { unsigned long long* ts = WSP(unsigned long long, WS_SMALL + 64); ts[4] = __builtin_amdgcn_s_memtime(); ts[5] = __builtin_amdgcn_s_memrealtime(); }
#endif
    SEAM(pb + 2);
    if (IN(pb + 3)) {
        pg8::Gemm g{WSP(bf16, WS_Y), WSP(bf16, WS_WOUT) + (size_t)L * DM * DM, MROWS, DM, DM}; pg8::StaticOrder S; S.init(MROWS, DM, G, bx);
        pg8::EpiResB<L != 0> E{L == 0 ? (const void*)args.in[0] : (const void*)WSP(bf16, WS_XB), WSP(bf16, WS_XB), DM};
        pg8::gemm_phase<pg8::EpiResB<L != 0>, pg8::StaticOrder, true, true>(ldsl + RING_OFF, g, S, E);
    }
    SEAM(pb + 3);
    if (IN(pb + 4)) {
        int tid_ = threadIdx.x; asm volatile("" : "+v"(tid_));
        const int lane = tid_ & 63, wave = __builtin_amdgcn_readfirstlane(tid_ >> 6); const int gw = vcu * NWAVES + wave, NGW = G * NWAVES;
        const bf16* XB = WSP(bf16, WS_XB);
        if (L == 0) { bf16* Hb = WSP(bf16, WS_H); const float* g = args.in[1] + DM;
            for (int m = gw; m < MROWS; m += NGW) rms_row_from_bf16<false>(XB + (size_t)m * DM, g, Hb + (size_t)m * DM, lane); }
        else { const float* g = args.in[11]; float* out = args.out;
            for (int m = gw; m < MROWS; m += NGW) rms_row_from_bf16<true>(XB + (size_t)m * DM, g, out + (size_t)m * DM, lane); }
    }
    SEAM(pb + 4);
}

__global__ void __launch_bounds__(NWAVES * 64, 2) mk_fwd(Args args) {
    extern __shared__ __attribute__((aligned(16))) unsigned char lds[];
    cg::grid_group grid = cg::this_grid();
    const int G = gridDim.x; const int bx = blockIdx.x; const int vcu = (G % 8 == 0) ? (bx % 8) * (G / 8) + bx / 8 : bx;
    const int lo = args.ph_lo, hi = args.ph_hi;
    volatile LAS unsigned* MISC = (volatile LAS unsigned*)((LAS unsigned char*)lds + MISC_OFF);
    if (threadIdx.x < 32) MISC[threadIdx.x] = 0u;
    __syncthreads();
    const XcdBarrier bar = xcd_barrier_post(WSP(unsigned, WS_CTL) + CW_BAR, MISC + 8);
    STAMP(0);
#ifdef MK_UB
    {
        typedef short ub8 __attribute__((ext_vector_type(8))); typedef float uf16 __attribute__((ext_vector_type(16))); typedef short us4 __attribute__((ext_vector_type(4)));
        LAS unsigned char* lb_ = (LAS unsigned char*)lds + (threadIdx.x & 63) * 16 + (threadIdx.x >> 6) * 8192;
        ub8 a_, b_; for (int i = 0; i < 8; ++i) { a_[i] = (short)(0x3c00 + threadIdx.x + i); b_[i] = (short)(0x3a00 + i); }
        for (int i = 0; i < 8; ++i) *(LAS ub8*)(lb_ + i * 1024) = a_;
        __syncthreads();
        uf16 acc_; for (int i = 0; i < 16; ++i) acc_[i] = 0.f;
        float x_[12]; for (int i = 0; i < 12; ++i) x_[i] = 0.001f * (float)(threadIdx.x + i);
        ub8 nx_ = *(LAS const ub8*)(lb_);
        for (int it = 0; it < MK_UB_IT; ++it) {
            ub8 cur_ = a_;
            if (MK_UB_LDS == 1) cur_ = *(LAS const ub8*)(lb_ + (it & 7) * 1024);
            if (MK_UB_LDS == 2) { cur_ = nx_; nx_ = *(LAS const ub8*)(lb_ + ((it + 1) & 7) * 1024); }
            if (MK_UB_LDS == 3) { cur_ = nx_; const us4 l_ = __builtin_bit_cast(us4, __builtin_amdgcn_ds_read_tr16_b64_v4i16((LAS us4*)(lb_ - (threadIdx.x & 63) * 8 + ((it + 1) & 7) * 1024))), h_ = __builtin_bit_cast(us4, __builtin_amdgcn_ds_read_tr16_b64_v4i16((LAS us4*)(lb_ - (threadIdx.x & 63) * 8 + ((it + 1) & 7) * 1024 + 512))); nx_ = (ub8){l_[0], l_[1], l_[2], l_[3], h_[0], h_[1], h_[2], h_[3]}; }
#if MK_UB_ACC == 1
            asm volatile("v_mfma_f32_32x32x16_bf16 %0, %1, %2, %0" : "+a"(acc_) : "v"(cur_), "v"(b_));
#elif MK_UB_ACC == 2
            asm volatile("v_mfma_f32_32x32x16_bf16 %0, %1, %2, %0" : "+v"(acc_) : "v"(cur_), "v"(b_));
#else
            acc_ = __builtin_amdgcn_mfma_f32_32x32x16_bf16(cur_, b_, acc_, 0, 0, 0);
#endif
#pragma unroll
            for (int i = 0; i < MK_UB_N; ++i) { if (MK_UB_EXP) x_[i] = __builtin_amdgcn_exp2f(x_[i]); else x_[i] = fmaf(x_[i], 0.999f, 0.001f); asm volatile("" : "+v"(x_[i])); }
            __builtin_amdgcn_sched_barrier(0);
        }
        float sum_ = acc_[0] + acc_[5]; for (int i = 0; i < 12; ++i) sum_ += x_[i];
        if (sum_ == 123456.789f) args.out[threadIdx.x] = sum_;
        __syncthreads();
    }
#endif
    if (IN(0)) { for (int rep_ = 0; rep_ < MK_REP_P0; ++rep_) prologue_phase(args, lds, G, vcu); }
    SEAM(0);
    layer_phases<0>(args, lds, grid, bar, lo, hi, G, bx, vcu);
    layer_phases<1>(args, lds, grid, bar, lo, hi, G, bx, vcu);
#ifdef MK_TPROF
    xcd_barrier(bar);
    { const unsigned long long* a_ = WSP(unsigned long long, WS_CTL + 524288); const float n_ = (float)a_[3];
      const float qa = floorf((float)a_[MK_TPROF_A] / n_ * (1.0f / MK_TPROF_Q) + 0.5f), qb = floorf((float)a_[MK_TPROF_B] / n_ * (1.0f / MK_TPROF_Q) + 0.5f);
      float* o = args.out; const int gt = blockIdx.x * 512 + threadIdx.x;
      for (int i = gt; i < MROWS * DM; i += gridDim.x * 512) o[i] = (i == 0) ? 16.f * qb : qa; }
#endif
#ifdef MK_CLK
    xcd_barrier(bar);
    { const unsigned long long* ts = WSP(unsigned long long, WS_SMALL + 64);
      const float ca = (float)(ts[4] - ts[2]) / (float)(ts[5] - ts[3]), cg = (float)(ts[12] - ts[10]) / (float)(ts[13] - ts[11]);
      const float qa = floorf(ca + 0.5f), qg = floorf(cg + 0.5f);
      float* o = args.out; const int gt = blockIdx.x * 512 + threadIdx.x;
      for (int i = gt; i < MROWS * DM; i += gridDim.x * 512) o[i] = (i == 0) ? 16.f * qg : qa; }
#endif
#ifdef MK_STAMP
    xcd_barrier(bar);
    { const unsigned long long* ts = WSP(unsigned long long, WS_SMALL + 64);
      float da = 0.f, db = 0.f;
      for (int p = 0; p < N_PHASES; ++p) { const int kind = p == 0 ? 0 : 1 + (p - 1) % 6; const float d = (float)(ts[p + 1] - ts[p]) * 0.01f; if (kind == MK_STAMP_A) da += d; if (kind == MK_STAMP_B) db += d; }
      float* o = args.out; const int gt = blockIdx.x * 512 + threadIdx.x;
      for (int i = gt; i < MROWS * DM; i += gridDim.x * 512) o[i] = (i == 0) ? 16.f * db : da; }
#endif
}
#undef IN
#undef SEAM
#undef WSP

#ifndef MK_PH_MAX
#define MK_PH_MAX N_PHASES
#endif
#ifndef MK_PH_MIN
#define MK_PH_MIN 0
#endif
#ifndef MK_LAUNCH_PER_PHASE
#define MK_LAUNCH_PER_PHASE 0
#endif
__global__ void diag_fill(float* o, int n, float c) { for (int i = blockIdx.x * 256 + threadIdx.x; i < n; i += gridDim.x * 256) o[i] = c; }
#ifdef MK_UBK
__global__ void __launch_bounds__(512, 2) ub_kernel(float* out) {
    typedef short ub8 __attribute__((ext_vector_type(8))); typedef float uf16 __attribute__((ext_vector_type(16)));
    ub8 a_, b_; for (int i = 0; i < 8; ++i) { a_[i] = (short)(0x3c00 + threadIdx.x + i); b_[i] = (short)(0x3a00 + i); }
    uf16 acc_; for (int i = 0; i < 16; ++i) acc_[i] = 0.f;
    float x_[12]; for (int i = 0; i < 12; ++i) x_[i] = 0.001f * (float)(threadIdx.x + i);
    for (int it = 0; it < MK_UBK_IT; ++it) {
#if MK_UBK_ACC == 1
        asm volatile("v_mfma_f32_32x32x16_bf16 %0, %1, %2, %0" : "+a"(acc_) : "v"(a_), "v"(b_));
#else
        asm volatile("v_mfma_f32_32x32x16_bf16 %0, %1, %2, %0" : "+v"(acc_) : "v"(a_), "v"(b_));
#endif
#pragma unroll
        for (int i = 0; i < MK_UBK_N; ++i) { x_[i] = fmaf(x_[i], 0.999f, 0.001f); asm volatile("" : "+v"(x_[i])); }
        __builtin_amdgcn_sched_barrier(0);
    }
    float sum_ = acc_[0] + acc_[5]; for (int i = 0; i < 12; ++i) sum_ += x_[i];
    if (sum_ == 123456.789f) out[threadIdx.x] = sum_;
}
#endif
extern "C" void kernel_launch(void* const* d_in, const int* in_sizes, int n_in, void* d_out, int out_size, void* d_ws, size_t ws_size, hipStream_t stream) {
    static int grid = 0;
    if (grid == 0) {
        if (n_in != 12 || in_sizes[0] != MROWS * DM || out_size != MROWS * DM || ws_size < WS_END) {
            fprintf(stderr, "kernel_launch: unexpected shapes: n_in %d in0 %d out %d ws %zu (need >= %zu)\n", n_in, n_in > 0 ? in_sizes[0] : -1, out_size, ws_size, (size_t)WS_END);
            const float code = (n_in != 12) ? 30.f : (in_sizes[0] != MROWS * DM) ? 40.f : (out_size != MROWS * DM) ? 50.f : (float)(ws_size >> 26);
            hipLaunchKernelGGL(diag_fill, dim3(1024), dim3(256), 0, stream, (float*)d_out, out_size, code); return; }
        int dev = 0, cus = 0, per_cu = 0;
        if (hipGetDevice(&dev) != hipSuccess || hipDeviceGetAttribute(&cus, hipDeviceAttributeMultiprocessorCount, dev) != hipSuccess) { fprintf(stderr, "kernel_launch: device query failed\n"); grid = -1; return; }
        if (hipFuncSetAttribute((const void*)mk_fwd, hipFuncAttributeMaxDynamicSharedMemorySize, LDS_BYTES) != hipSuccess) { fprintf(stderr, "kernel_launch: hipFuncSetAttribute failed\n"); grid = -1; return; }
        if (hipOccupancyMaxActiveBlocksPerMultiprocessor(&per_cu, (const void*)mk_fwd, NWAVES * 64, LDS_BYTES) != hipSuccess || per_cu < 1) {
            fprintf(stderr, "kernel_launch: occupancy query reports %d workgroups per CU\n", per_cu); (void)hipGetLastError(); per_cu = 1; }
        grid = cus;
        if (grid > 256) grid = 256;
    }
    if (grid < 0) return;
    (void)hipMemsetAsync((char*)d_ws + WS_CTL, 0, CTL_ZERO_BYTES, stream);
#ifdef MK_UBK
    hipLaunchKernelGGL(ub_kernel, dim3(256), dim3(512), 0, stream, (float*)d_ws + (WS_END >> 2) - 4096);
#endif
    Args a{};
    for (int i = 0; i < 12; ++i) a.in[i] = (const float*)d_in[i];
    a.out = (float*)d_out; a.ws = (unsigned char*)d_ws;
#if MK_LAUNCH_PER_PHASE
    for (int p = MK_PH_MIN; p < MK_PH_MAX; ++p) { a.ph_lo = p; a.ph_hi = p + 1; hipLaunchKernelGGL(mk_fwd, dim3(grid), dim3(NWAVES * 64), LDS_BYTES, stream, a); }
    { const hipError_t le = hipPeekAtLastError(); if (le != hipSuccess) fprintf(stderr, "kernel_launch: launch failed: %s\n", hipGetErrorName(le)); }
#else
    a.ph_lo = 0; a.ph_hi = N_PHASES;
    void* kargs[] = {&a};
    const hipError_t e = hipLaunchCooperativeKernel((const void*)mk_fwd, dim3(grid), dim3(NWAVES * 64), kargs, LDS_BYTES, stream);
    if (e != hipSuccess) fprintf(stderr, "kernel_launch: cooperative launch failed: %s (grid %d)\n", hipGetErrorString(e), grid);
#endif
}
```

```cpp
#include <hip/hip_runtime.h>
#include <hip/hip_cooperative_groups.h>
#include <cstdio>
#include <cstdint>
namespace cg = cooperative_groups;

constexpr int BATCH = 4, SEQ = 4096, DM = 2048, MROWS = BATCH * SEQ, DEPTH = 2;
constexpr int NIN = 5952, NINP = 6144;
constexpr int QLORA = 512, KVLORA = 256, NQB = 1536, NKVB = 2048;
constexpr float EPS = 1e-6f;
constexpr float LOG2E = 1.4426950408889634f;
namespace pg8 {
#define PG8_LAS __attribute__((address_space(3)))
typedef unsigned short bf16_t;
typedef short bf16x8 __attribute__((ext_vector_type(8)));
typedef float f32x4 __attribute__((ext_vector_type(4)));
typedef unsigned u32x4 __attribute__((ext_vector_type(4)));
constexpr int BM = 256, BK = 64, HALF = 128, HTB = HALF * BK * 2  , STAGE_BYTES = 8 * HTB, NXCD = 8, WGM = 8;

__host__ __device__ __forceinline__ int lds_byte(int r, int c) { const int st = (r >> 4) * 2 + (c >> 5), rr = r & 15, cc = c & 31, ob = rr * 64 + cc * 2; return st * 1024 + (ob ^ (((ob >> 9) & 1) << 5)); }
__host__ __device__ __forceinline__ void stage_rc(int b, int& R, int& C) { const int st = b / 1024, sb = b % 1024, swz = sb ^ (((sb >> 9) & 1) << 5); R = (st >> 1) * 16 + swz / 64; C = (st & 1) * 32 + (swz % 64) / 2; }
__host__ __device__ __forceinline__ int perm32(int rho) { const int n = rho >> 4, i = rho & 15; return 8 * (i >> 2) + 4 * n + (i & 3); }

struct Unit { int pm, pn; };
struct Gemm { const bf16_t* A; const bf16_t* Bt; int M, N, K; };

struct StaticOrder {
    int nM, nN, nwg, G, c;
    __host__ __device__ void init(int M, int N, int G_, int c_) { nM = M / BM; nN = N / BM; nwg = nM * nN; G = G_; c = c_; }
    __host__ __device__ bool next(int i, Unit& u) const {
        const long L = (long)i * G + c; if (L >= nwg) return false;
        int wgid = (int)L; { const int q = nwg / NXCD, r = nwg % NXCD, xcd = wgid % NXCD, off = wgid / NXCD; wgid = (xcd < r ? xcd * (q + 1) : r * (q + 1) + (xcd - r) * q) + off; }
        const int nig = WGM * nN, gid = wgid / nig, fm = gid * WGM, gsz = (nM - fm) < WGM ? (nM - fm) : WGM;
        u.pm = fm + ((wgid % nig) % gsz); u.pn = (wgid % nig) / gsz; return true;
    }
    __device__ __forceinline__ void a_ready(const Unit&) const {}
    __device__ __forceinline__ void done(const Unit&) const {}
};

__device__ __forceinline__ unsigned cvt_pk_bf16(float lo, float hi) { unsigned r; asm volatile("v_cvt_pk_bf16_f32 %0, %1, %2" : "=v"(r) : "v"(lo), "v"(hi)); return r; }
typedef float f32x2 __attribute__((ext_vector_type(2)));
struct EpiInProj {
    static constexpr bool PERM = true, AFTER_DRAIN = false;
    bf16_t *QKV, *CQ, *CKV, *KR, *GATE; const float* ropec; const float* ropes; float* ssq_q; float* ssq_kv;
    __device__ __forceinline__ void operator()(const f32x4 (&acc)[2][2][4][2], const Unit& u, int wr, int wc, int fr, int fq) const {
        const int row0 = u.pm * BM + wr * 64 + fr; const int pn = u.pn;
        if (pn == 15) {
            if (wc < 2) {
                const int a = wc * 4 + fq;
#pragma unroll
                for (int ai = 0; ai < 2; ++ai)
#pragma unroll
                    for (int m = 0; m < 4; ++m) { const int row = row0 + ai * HALF + m * 16, s = row & (SEQ - 1);
                        const f32x4 c = *(const f32x4*)(ropec + s * 32 + 4 * a), sn = *(const f32x4*)(ropes + s * 32 + 4 * a);
                        const f32x4 x1 = acc[ai][0][m][0], x2 = acc[ai][0][m][1];
                        const f32x4 y1 = x1 * c - x2 * sn, y2 = x1 * sn + x2 * c;
                        u32x4 w; w.x = cvt_pk_bf16(y1[0], y1[1]); w.y = cvt_pk_bf16(y1[2], y1[3]); w.z = cvt_pk_bf16(y2[0], y2[1]); w.w = cvt_pk_bf16(y2[2], y2[3]);
                        *(u32x4*)(KR + (size_t)row * 64 + 8 * a) = w; }
            }
            return;
        }
        bf16_t* base; int ldc, colt;
        if (pn < 12) { base = QKV; ldc = 3072; colt = pn * 256; }
        else if (pn < 14) { base = CQ; ldc = 512; colt = (pn - 12) * 256; }
        else if (pn == 14) { base = CKV; ldc = 256; colt = 0; }
        else { base = GATE; ldc = 2048; colt = (pn - 16) * 256; }
        const int col0 = colt + wc * 32 + 8 * fq;
        const float sc = (pn < 4) ? 0.125f * 1.4426950408889634f : 1.0f;
#pragma unroll
        for (int ai = 0; ai < 2; ++ai)
#pragma unroll
            for (int m = 0; m < 4; ++m) { bf16_t* rowp = base + (size_t)(row0 + ai * HALF + m * 16) * ldc + col0;
#pragma unroll
                for (int bj = 0; bj < 2; ++bj) { const f32x4 v0 = acc[ai][bj][m][0] * sc, v1 = acc[ai][bj][m][1] * sc;
                    u32x4 w; w.x = cvt_pk_bf16(v0[0], v0[1]); w.y = cvt_pk_bf16(v0[2], v0[3]); w.z = cvt_pk_bf16(v1[0], v1[1]); w.w = cvt_pk_bf16(v1[2], v1[3]);
                    *(u32x4*)(rowp + bj * HALF) = w; } }
        if (pn >= 12 && pn <= 14) {
            float* ssq = (pn == 14) ? ssq_kv : ssq_q;
#pragma unroll
            for (int ai = 0; ai < 2; ++ai)
#pragma unroll
                for (int m = 0; m < 4; ++m) { float s = 0.f;
#pragma unroll
                    for (int bj = 0; bj < 2; ++bj)
#pragma unroll
                        for (int n = 0; n < 2; ++n) { const f32x4 v = acc[ai][bj][m][n]; s += (v[0] * v[0] + v[1] * v[1]) + (v[2] * v[2] + v[3] * v[3]); }
                    s += __shfl_xor(s, 16); s += __shfl_xor(s, 32);
                    if (fq == 0) __hip_atomic_fetch_add(ssq + row0 + ai * HALF + m * 16, s, __ATOMIC_RELAXED, __HIP_MEMORY_SCOPE_AGENT); }
        }
    }
};
template <bool ROPE> struct EpiRowScale {
    static constexpr bool PERM = true, AFTER_DRAIN = false;
    bf16_t* O; int ldc; const float* ssq; float inv_n; const float* ropec; const float* ropes; float qscale;
    __device__ __forceinline__ void operator()(const f32x4 (&acc)[2][2][4][2], const Unit& u, int wr, int wc, int fr, int fq) const {
        const int row0 = u.pm * BM + wr * 64 + fr; const int col0 = u.pn * BM + wc * 32 + 8 * fq;
        bool isr[2]; int ra[2];
#pragma unroll
        for (int bj = 0; bj < 2; ++bj) { const int c0 = col0 + bj * HALF, off = c0 % 192; isr[bj] = ROPE && (off >= 128); ra[bj] = (off - 128) >> 3; }
#pragma unroll
        for (int ai = 0; ai < 2; ++ai)
#pragma unroll
            for (int m = 0; m < 4; ++m) { const int row = row0 + ai * HALF + m * 16, s = row & (SEQ - 1); const float r = qscale / sqrtf(ssq[row] * inv_n + 1e-6f);
                bf16_t* rowp = O + (size_t)row * ldc + col0;
#pragma unroll
                for (int bj = 0; bj < 2; ++bj) { f32x4 v0 = acc[ai][bj][m][0] * r, v1 = acc[ai][bj][m][1] * r;
                    if (ROPE) { if (isr[bj]) { const f32x4 c = *(const f32x4*)(ropec + s * 32 + 4 * ra[bj]), sn = *(const f32x4*)(ropes + s * 32 + 4 * ra[bj]);
                        const f32x4 y1 = v0 * c - v1 * sn, y2 = v0 * sn + v1 * c; v0 = y1; v1 = y2; } }
                    u32x4 w; w.x = cvt_pk_bf16(v0[0], v0[1]); w.y = cvt_pk_bf16(v0[2], v0[3]); w.z = cvt_pk_bf16(v1[0], v1[1]); w.w = cvt_pk_bf16(v1[2], v1[3]);
                    *(u32x4*)(rowp + bj * HALF) = w; } }
    }
};
struct EpiResF32 {
    static constexpr bool PERM = false, AFTER_DRAIN = false;
    const float* base; float* out; int ldc;
    __device__ __forceinline__ void operator()(const f32x4 (&acc)[2][2][4][2], const Unit& u, int wr, int wc, int fr, int fq) const {
        const int row0 = u.pm * BM + wr * 64 + fr, col0 = u.pn * BM + wc * 32 + 4 * fq;
#pragma unroll
        for (int ai = 0; ai < 2; ++ai)
#pragma unroll
            for (int m = 0; m < 4; ++m) { const size_t off = (size_t)(row0 + ai * HALF + m * 16) * ldc + col0;
#pragma unroll
                for (int bj = 0; bj < 2; ++bj)
#pragma unroll
                    for (int n = 0; n < 2; ++n) { const f32x4 bs = *(const f32x4*)(base + off + bj * HALF + n * 16); *(f32x4*)(out + off + bj * HALF + n * 16) = bs + acc[ai][bj][m][n]; } }
    }
};
template <bool BASE_BF16> struct EpiResB {
    static constexpr bool PERM = true, AFTER_DRAIN = false;
    const void* base; bf16_t* out; int ldc;
    __device__ __forceinline__ void operator()(const f32x4 (&acc)[2][2][4][2], const Unit& u, int wr, int wc, int fr, int fq) const {
        const int row0 = u.pm * BM + wr * 64 + fr, col0 = u.pn * BM + wc * 32 + 8 * fq;
#pragma unroll
        for (int ai = 0; ai < 2; ++ai)
#pragma unroll
            for (int m = 0; m < 4; ++m) { const size_t off = (size_t)(row0 + ai * HALF + m * 16) * ldc + col0;
#pragma unroll
                for (int bj = 0; bj < 2; ++bj) { f32x4 b0, b1;
                    if (BASE_BF16) { const u32x4 bv = *(const u32x4*)((const bf16_t*)base + off + bj * HALF);
                        b0[0] = __uint_as_float(bv.x << 16); b0[1] = __uint_as_float(bv.x & 0xffff0000u); b0[2] = __uint_as_float(bv.y << 16); b0[3] = __uint_as_float(bv.y & 0xffff0000u);
                        b1[0] = __uint_as_float(bv.z << 16); b1[1] = __uint_as_float(bv.z & 0xffff0000u); b1[2] = __uint_as_float(bv.w << 16); b1[3] = __uint_as_float(bv.w & 0xffff0000u); }
                    else { b0 = *(const f32x4*)((const float*)base + off + bj * HALF); b1 = *(const f32x4*)((const float*)base + off + bj * HALF + 4); }
                    const f32x4 v0 = b0 + acc[ai][bj][m][0], v1 = b1 + acc[ai][bj][m][1];
                    u32x4 w; w.x = cvt_pk_bf16(v0[0], v0[1]); w.y = cvt_pk_bf16(v0[2], v0[3]); w.z = cvt_pk_bf16(v1[0], v1[1]); w.w = cvt_pk_bf16(v1[2], v1[3]);
                    *(u32x4*)(out + off + bj * HALF) = w; } }
    }
};
struct KvOrder : StaticOrder {
    __host__ __device__ bool next(int i, Unit& u) const {
        long L; if (G != 256) { L = (long)i * G + c; if (L >= nwg) return false; }
        else if (c < 128) { if (i > 0) return false; L = c; }
        else { if (i > 2) return false; L = 128 + 3 * (c - 128) + i; }
        int wgid = (int)L; { const int q = nwg / NXCD, r = nwg % NXCD, xcd = wgid % NXCD, off = wgid / NXCD; wgid = (xcd < r ? xcd * (q + 1) : r * (q + 1) + (xcd - r) * q) + off; }
        const int nig = WGM * nN, gid = wgid / nig, fm = gid * WGM, gsz = (nM - fm) < WGM ? (nM - fm) : WGM;
        u.pm = fm + ((wgid % nig) % gsz); u.pn = (wgid % nig) / gsz; return true;
    }
};
template <class Epi, class Sched, bool ALIGN_EPI = false, bool SP2 = false>
__device__ __forceinline__ void gemm_phase(PG8_LAS unsigned char* lds, const Gemm g, const Sched& S, const Epi& E) {
    int tid_ = threadIdx.x; asm volatile("" : "+v"(tid_));
    const int tid = tid_, wid = __builtin_amdgcn_readfirstlane(tid >> 6), lane = tid & 63, wr = wid >> 2, wc = wid & 3, fr = lane & 15, fq = lane >> 4;
    const int K = g.K, nt = K / BK;
    unsigned voffA[2], voffB[2];
#pragma unroll
    for (int i = 0; i < 2; ++i) { int R, C; stage_rc(tid * 16 + i * 8192, R, C); const int Rb = Epi::PERM ? ((R & ~31) + perm32(R & 31)) : R;
        voffA[i] = (unsigned)(R * K + C) * 2u; voffB[i] = (unsigned)(Rb * K + C) * 2u; }
    const size_t kstep = (size_t)(BK * 2);
    const size_t hstep = (size_t)HALF * K * 2;
    const size_t tstep = 2 * hstep;
    const unsigned ldsw = (unsigned)wid * 1024u;
    const int aoff = lds_byte(wr * 64 + fr, fq * 8), boff = lds_byte(wc * 32 + fr, fq * 8);
#define PG8_SA(b, h) (((b) * 2 + (h)) * HTB)
#define PG8_SB(b, h) ((4 + (b) * 2 + (h)) * HTB)
#define PG8_STAGE(bufoff, gbase, voff) do { _Pragma("unroll") for (int _i = 0; _i < 2; ++_i) \
        __builtin_amdgcn_global_load_lds((const unsigned*)((const char*)(gbase) + (voff)[_i]), (PG8_LAS unsigned*)(lds + (bufoff) + ldsw + _i * 8192), 16, 0, 0); } while (0)
#define PG8_LDA(dst, b, h) do { _Pragma("unroll") for (int m = 0; m < 4; ++m) _Pragma("unroll") for (int k = 0; k < 2; ++k) dst[m][k] = *(const PG8_LAS bf16x8*)(lds + PG8_SA(b, h) + aoff + m * 2048 + k * 1024); } while (0)
#define PG8_LDB(dst, b, h) do { _Pragma("unroll") for (int n = 0; n < 2; ++n) _Pragma("unroll") for (int k = 0; k < 2; ++k) dst[n][k] = *(const PG8_LAS bf16x8*)(lds + PG8_SB(b, h) + boff + n * 2048 + k * 1024); } while (0)
#define PG8_MMA(ai, bj, At, Bt) do { __builtin_amdgcn_s_setprio(1); _Pragma("unroll") for (int m = 0; m < 4; ++m) _Pragma("unroll") for (int n = 0; n < 2; ++n) _Pragma("unroll") for (int k = 0; k < 2; ++k) \
        acc[ai][bj][m][n] = __builtin_amdgcn_mfma_f32_16x16x32_bf16(Bt[n][k], At[m][k], acc[ai][bj][m][n], 0, 0, 0); __builtin_amdgcn_s_setprio(0); } while (0)
#define PG8_WAIT_V(n) asm volatile("s_waitcnt vmcnt(" #n ")" ::: "memory")
#define PG8_WAIT_L(n) asm volatile("s_waitcnt lgkmcnt(" #n ")" ::: "memory")
#define PG8_BAR __builtin_amdgcn_s_barrier()
#define PG8_SCHED __builtin_amdgcn_sched_barrier(0)
    Unit cur, nxt; int ui = 0;
    if (!S.next(0, cur)) return;
    f32x4 acc[2][2][4][2];
#pragma unroll
    for (int a = 0; a < 2; ++a)
#pragma unroll
        for (int b = 0; b < 2; ++b)
#pragma unroll
            for (int m = 0; m < 4; ++m)
#pragma unroll
                for (int n = 0; n < 2; ++n) acc[a][b][m][n] = (f32x4){0.f, 0.f, 0.f, 0.f};
    bf16x8 At[4][2], B0[2][2], B1[2][2];
    const char* cA = (const char*)g.A + (size_t)cur.pm * tstep; const char* cB = (const char*)g.Bt + (size_t)cur.pn * tstep;
    S.a_ready(cur);
    if constexpr (SP2) {
        PG8_STAGE(PG8_SB(0, 0), cB, voffB); PG8_STAGE(PG8_SB(0, 1), cB + hstep, voffB); PG8_STAGE(PG8_SA(0, 0), cA, voffA); PG8_STAGE(PG8_SA(0, 1), cA + hstep, voffA);
        if (wr == 1) PG8_BAR;
        PG8_WAIT_V(2); PG8_BAR;
        PG8_STAGE(PG8_SB(1, 0), cB + kstep, voffB); PG8_STAGE(PG8_SA(1, 0), cA + kstep, voffA); PG8_STAGE(PG8_SB(1, 1), cB + hstep + kstep, voffB);
        PG8_WAIT_V(6); PG8_BAR;
    } else {
        PG8_STAGE(PG8_SB(0, 0), cB, voffB); PG8_STAGE(PG8_SA(0, 0), cA, voffA); PG8_STAGE(PG8_SB(0, 1), cB + hstep, voffB); PG8_STAGE(PG8_SA(0, 1), cA + hstep, voffA);
        if (wr == 1) PG8_BAR;
        PG8_WAIT_V(4); PG8_BAR;
        PG8_STAGE(PG8_SB(1, 0), cB + kstep, voffB); PG8_STAGE(PG8_SA(1, 0), cA + kstep, voffA); PG8_STAGE(PG8_SB(1, 1), cB + hstep + kstep, voffB);
        PG8_WAIT_V(6); PG8_BAR;
    }
    for (;;) {
        const bool has_next = S.next(ui + 1, nxt);
        const char* nA = has_next ? (const char*)g.A + (size_t)nxt.pm * tstep : cA; const char* nB = has_next ? (const char*)g.Bt + (size_t)nxt.pn * tstep : cB;
        for (int t = 0; t < nt; t += 2) {
            const bool last = (t == nt - 2);
            const char* a1 = cA + (size_t)(t + 1) * kstep;
            const char* a2 = last ? nA : cA + (size_t)(t + 2) * kstep; const char* b2 = last ? nB : cB + (size_t)(t + 2) * kstep;
            const char* a3 = a2 + kstep; const char* b3 = b2 + kstep;
            if (last && has_next) S.a_ready(nxt);
            if constexpr (SP2) {
            PG8_LDB(B0, 0, 0); PG8_LDB(B1, 0, 1); PG8_SCHED; PG8_LDA(At, 0, 0); PG8_STAGE(PG8_SA(1, 1), a1 + hstep, voffA);
            PG8_WAIT_V(8); PG8_WAIT_L(0); PG8_BAR; PG8_MMA(0, 0, At, B0); PG8_MMA(0, 1, At, B1); PG8_BAR; PG8_SCHED;
            PG8_LDA(At, 0, 1); PG8_STAGE(PG8_SB(0, 0), b2, voffB); PG8_STAGE(PG8_SB(0, 1), b2 + hstep, voffB); PG8_STAGE(PG8_SA(0, 0), a2, voffA);
            PG8_WAIT_V(8); PG8_WAIT_L(0); PG8_BAR; PG8_MMA(1, 0, At, B0); PG8_MMA(1, 1, At, B1); PG8_BAR; PG8_SCHED;
            PG8_LDB(B0, 1, 0); PG8_LDB(B1, 1, 1); PG8_SCHED; PG8_LDA(At, 1, 0); PG8_STAGE(PG8_SA(0, 1), a2 + hstep, voffA);
            PG8_WAIT_V(8); PG8_WAIT_L(0); PG8_BAR; PG8_MMA(0, 0, At, B0); PG8_MMA(0, 1, At, B1); PG8_BAR; PG8_SCHED;
            PG8_LDA(At, 1, 1); PG8_STAGE(PG8_SB(1, 0), b3, voffB); PG8_STAGE(PG8_SB(1, 1), b3 + hstep, voffB); PG8_STAGE(PG8_SA(1, 0), a3, voffA);
            PG8_WAIT_V(8); PG8_WAIT_L(0); PG8_BAR; PG8_MMA(1, 0, At, B0); PG8_MMA(1, 1, At, B1); PG8_BAR; PG8_SCHED;
            } else {
            PG8_LDB(B0, 0, 0); PG8_SCHED; PG8_LDA(At, 0, 0); PG8_STAGE(PG8_SA(1, 1), a1 + hstep, voffA);
            PG8_WAIT_L(8); PG8_BAR; PG8_WAIT_L(0); PG8_MMA(0, 0, At, B0); PG8_BAR; PG8_SCHED;
            PG8_LDB(B1, 0, 1); PG8_STAGE(PG8_SB(0, 0), b2, voffB);
            PG8_BAR; PG8_WAIT_L(0); PG8_MMA(0, 1, At, B1); PG8_BAR;
            PG8_LDA(At, 0, 1); PG8_STAGE(PG8_SA(0, 0), a2, voffA);
            PG8_BAR; PG8_WAIT_L(0); PG8_MMA(1, 0, At, B0); PG8_BAR; PG8_SCHED;
            PG8_STAGE(PG8_SB(0, 1), b2 + hstep, voffB);
            PG8_WAIT_V(6); PG8_BAR; PG8_MMA(1, 1, At, B1); PG8_BAR;
            PG8_LDB(B0, 1, 0); PG8_SCHED; PG8_LDA(At, 1, 0); PG8_STAGE(PG8_SA(0, 1), a2 + hstep, voffA);
            PG8_WAIT_L(8); PG8_BAR; PG8_WAIT_L(0); PG8_MMA(0, 0, At, B0); PG8_BAR; PG8_SCHED;
            PG8_LDB(B1, 1, 1); PG8_STAGE(PG8_SB(1, 0), b3, voffB);
            PG8_BAR; PG8_WAIT_L(0); PG8_MMA(0, 1, At, B1); PG8_BAR;
            PG8_LDA(At, 1, 1); PG8_STAGE(PG8_SA(1, 0), a3, voffA);
            PG8_BAR; PG8_WAIT_L(0); PG8_MMA(1, 0, At, B0); PG8_BAR; PG8_SCHED;
            PG8_STAGE(PG8_SB(1, 1), b3 + hstep, voffB);
            PG8_WAIT_V(6); PG8_BAR; PG8_MMA(1, 1, At, B1); PG8_BAR;
            }
        }
        if constexpr (ALIGN_EPI) { if (wr == 0) PG8_BAR; }
        if constexpr (!Epi::AFTER_DRAIN) { E(acc, cur, wr, wc, fr, fq); S.done(cur); }
        if (!has_next) break;
#pragma unroll
        for (int a = 0; a < 2; ++a)
#pragma unroll
            for (int b = 0; b < 2; ++b)
#pragma unroll
                for (int m = 0; m < 4; ++m)
#pragma unroll
                    for (int n = 0; n < 2; ++n) acc[a][b][m][n] = (f32x4){0.f, 0.f, 0.f, 0.f};
        cur = nxt; cA = nA; cB = nB; ++ui;
        if constexpr (ALIGN_EPI) { if (wr == 1) PG8_BAR; }
    }
    PG8_WAIT_V(0);
    if constexpr (!ALIGN_EPI) { if (wr == 0) PG8_BAR; }
    PG8_BAR;
    if constexpr (Epi::AFTER_DRAIN) { E.fused(acc, cur, wr, wc, fr, fq, lds, wid, lane); S.done(cur); }
#undef PG8_SA
#undef PG8_SB
#undef PG8_STAGE
#undef PG8_LDA
#undef PG8_LDB
#undef PG8_MMA
#undef PG8_WAIT_V
#undef PG8_WAIT_L
#undef PG8_BAR
#undef PG8_SCHED
}
}
#define GAS __attribute__((address_space(1)))
#define LAS __attribute__((address_space(3)))
typedef unsigned short bf16;
typedef unsigned v4u __attribute__((ext_vector_type(4)));
typedef float f32x4 __attribute__((ext_vector_type(4)));
typedef short bf16x8 __attribute__((ext_vector_type(8)));
typedef GAS unsigned gu32;
typedef GAS unsigned long long gu64;
#define RLX_AGENT __ATOMIC_RELAXED, __HIP_MEMORY_SCOPE_AGENT
#define LDS_WAIT() asm volatile("s_waitcnt lgkmcnt(0)" ::: "memory")
#define VM_WAIT() asm volatile("s_waitcnt vmcnt(0)" ::: "memory")
__device__ __forceinline__ unsigned long long rt() { return __builtin_amdgcn_s_memrealtime(); }
__device__ __forceinline__ unsigned f2bf(float f) { unsigned u = __builtin_bit_cast(unsigned, f); return (u + 0x7fffu + ((u >> 16) & 1u)) >> 16; }
__device__ __forceinline__ unsigned pk2(float lo, float hi) { return f2bf(lo) | (f2bf(hi) << 16); }

#define XB_TMO      128
#define XB_XCNT(j)  (256  + 64 * (j))
#define XB_XSUB(j)  (1280 + 64 * (j))
#define XB_XGEN(j)  (2304 + 64 * (j))
#define XB_TOP      3328
#define XB_TOPGEN   3392
#define XCD_BAR_WORDS 3456
#define XB_SPIN_CAP (1u << 18)

__device__ __forceinline__ unsigned xb_ld(unsigned* p)              { return __hip_atomic_load(p, __ATOMIC_RELAXED, __HIP_MEMORY_SCOPE_AGENT); }
__device__ __forceinline__ unsigned xb_add(unsigned* p, unsigned v) { return __hip_atomic_fetch_add(p, v, __ATOMIC_RELAXED, __HIP_MEMORY_SCOPE_AGENT); }
__device__ __forceinline__ unsigned xb_xcc_id() { return (unsigned)__builtin_amdgcn_s_getreg((3 << 11) | 20) & 0xFu; }
#define XB_SPIN(cond, bar) do { unsigned _sp = 0; while (cond) { __builtin_amdgcn_s_sleep(1); \
    if ((++_sp & 255u) == 0u) { if (xb_ld(&(bar)[XB_TMO])) break; if (_sp > XB_SPIN_CAP) { atomicAdd(&(bar)[XB_TMO], 1u); break; } } } } while (0)

struct XcdBarrier {
    unsigned* bar; unsigned x;
    volatile LAS unsigned* st;
};

__device__ __forceinline__ XcdBarrier xcd_barrier_post(unsigned* bar, volatile LAS unsigned* st) {
    XcdBarrier b; b.bar = bar; b.x = xb_xcc_id(); b.st = st;
    if (threadIdx.x == 0) (void)xb_add(&bar[XB_XCNT(b.x)], 1u);
    return b;
}
__device__ __forceinline__ void xcd_barrier_complete(unsigned* bar, unsigned x, unsigned& nloc, unsigned& nx) {
    const unsigned G = gridDim.x * gridDim.y * gridDim.z;
    unsigned sum, cnt, mine, sp = 0u;
    for (;;) {
        sum = 0u; cnt = 0u; mine = 0u;
#pragma unroll
        for (unsigned j = 0; j < 16; ++j) { const unsigned c = xb_ld(&bar[XB_XCNT(j)]); sum += c; cnt += (c > 0u) ? 1u : 0u; mine = (j == x) ? c : mine; }
        if (sum == G) break;
        __builtin_amdgcn_s_sleep(1);
        if ((++sp & 255u) == 0u) { if (xb_ld(&bar[XB_TMO])) break; if (sp > XB_SPIN_CAP) { atomicAdd(&bar[XB_TMO], 1u); break; } }
    }
    nloc = mine > 0u ? mine : 1u; nx = cnt > 0u ? cnt : 1u;
}

__device__ __forceinline__ void xcd_barrier(const XcdBarrier& b) {
    asm volatile("s_waitcnt vmcnt(0)" ::: "memory");
    __syncthreads();
    if (threadIdx.x == 0) {
        unsigned* bar = b.bar;
        __builtin_amdgcn_s_waitcnt(0);
        unsigned nloc = b.st[0], nx = b.st[1];
        if (nloc == 0u) { xcd_barrier_complete(bar, b.x, nloc, nx); b.st[0] = nloc; b.st[1] = nx; }
        const unsigned old = xb_add(&bar[XB_XSUB(b.x)], 1u);
        const unsigned gen = old / nloc;
        if (old + 1u == (gen + 1u) * nloc) {
            __builtin_amdgcn_fence(__ATOMIC_RELEASE, "agent");
            asm volatile("s_waitcnt vmcnt(0)" ::: "memory");
            const unsigned og = xb_add(&bar[XB_TOP], 1u);
            const unsigned tg = og / nx;
            if (og + 1u == (tg + 1u) * nx) xb_add(&bar[XB_TOPGEN], 1u);
            else XB_SPIN(xb_ld(&bar[XB_TOPGEN]) == tg, bar);
            __builtin_amdgcn_fence(__ATOMIC_ACQUIRE, "agent");
            xb_add(&bar[XB_XGEN(b.x)], 1u);
            asm volatile("s_waitcnt vmcnt(0)" ::: "memory");
        } else {
            XB_SPIN(xb_ld(&bar[XB_XGEN(b.x)]) == gen, bar);
            __builtin_amdgcn_fence(__ATOMIC_ACQUIRE, "agent");
            asm volatile("s_waitcnt vmcnt(0)" ::: "memory");
        }
    }
    __syncthreads();
}
namespace att {
typedef unsigned short bf16;
typedef short bf16x8 __attribute__((ext_vector_type(8)));
typedef short s16x4 __attribute__((ext_vector_type(4)));
typedef short v4i16_t __attribute__((ext_vector_type(4)));
typedef float f32x16 __attribute__((ext_vector_type(16)));
typedef unsigned u32x4 __attribute__((ext_vector_type(4)));
typedef float f32x2_t __attribute__((ext_vector_type(2)));
typedef __bf16 bf16x2_t __attribute__((ext_vector_type(2)));
#define ALDS __attribute__((address_space(3)))
#define ASBAR() __builtin_amdgcn_sched_barrier(0)
constexpr int WS_OFF = 147456;
constexpr int TAB_OFF = WS_OFF + 2048;
constexpr int QR_OFF = 81920;
constexpr int NQL = 6;
constexpr int ATT_LDS_BYTES = TAB_OFF + 2048;
#ifndef ATT_PRIO
#define ATT_PRIO 0
#endif
#ifndef ATT_YPRIO
#define ATT_YPRIO 1
#endif
#ifndef ATT_RING
#define ATT_RING 8
#endif
#ifndef ATT_STAGGER
#define ATT_STAGGER 0
#endif
constexpr float THR2 = 8.0f;
__device__ __forceinline__ int crow(int r, int hi) { return (r & 3) + 8 * (r >> 2) + 4 * hi; }
__device__ __forceinline__ void glds16(const void* gsrc, unsigned lds_dst) { unsigned keep;
    asm volatile("s_mov_b32 %0, m0\n\ts_mov_b32 m0, %2\n\ts_nop 0\n\tglobal_load_lds_dwordx4 %1, off\n\ts_mov_b32 m0, %0" : "=&s"(keep) : "v"(gsrc), "s"(lds_dst) : "memory"); }
template <int IMM> __device__ __forceinline__ void glds16s(const void* sbase, unsigned voff, unsigned lds_dst_) { const unsigned lds_dst = lds_dst_ - (unsigned)IMM;
    asm volatile("s_mov_b32 m0, %2\n\ts_nop 0\n\tglobal_load_lds_dwordx4 %0, %1 offset:%c3" :: "v"(voff), "s"(sbase), "s"(lds_dst), "i"(IMM) : "m0", "memory"); }
__device__ __forceinline__ const unsigned char* uni_ptr(const void* p) { const unsigned long long v = (unsigned long long)p;
    const unsigned lo = __builtin_amdgcn_readfirstlane((unsigned)v), hi = __builtin_amdgcn_readfirstlane((unsigned)(v >> 32)); return (const unsigned char*)(((unsigned long long)hi << 32) | lo); }
__device__ __forceinline__ unsigned cvtpk_s(float lo, float hi) { f32x2_t v = {lo, hi}; bf16x2_t b = __builtin_convertvector(v, bf16x2_t); return __builtin_bit_cast(unsigned, b); }
__device__ __forceinline__ float swapmax(float v) { auto rr = __builtin_amdgcn_permlane32_swap(__float_as_uint(v), __float_as_uint(v), false, false); return fmaxf(__uint_as_float(rr[0]), __uint_as_float(rr[1])); }
__device__ __forceinline__ float swapsum(float v) { auto rr = __builtin_amdgcn_permlane32_swap(__float_as_uint(v), __float_as_uint(v), false, false); return __uint_as_float(rr[0]) + __uint_as_float(rr[1]); }
#define ATT_WAIT_BAR() asm volatile("s_waitcnt vmcnt(0) lgkmcnt(0)\n\ts_barrier" ::: "memory")
#define ATT_WAIT_BAR_N(N) asm volatile("s_waitcnt vmcnt(" #N ") lgkmcnt(0)\n\ts_barrier" ::: "memory")

__device__ __forceinline__ float fadd_s(float a, float b) { float r; asm("v_add_f32_e32 %0, %1, %2" : "=v"(r) : "v"(a), "v"(b)); return r; }
__device__ __forceinline__ s16x4 vtr(ALDS const unsigned char* p) { return __builtin_bit_cast(s16x4, __builtin_amdgcn_ds_read_tr16_b64_v4i16((ALDS v4i16_t*)p)); }

struct AttnArgs { void* prof; const bf16* QKV; const bf16* QM; const bf16* KVM; const bf16* KR; const bf16* GATE; bf16* Y; const float* biastab; const float* subg; float lam; float oml; };

__device__ __forceinline__ void pv4(f32x16* o, int vb, bf16x8 pa0, bf16x8 pa1, bf16x8 pa2, bf16x8 pa3) {
#pragma unroll
    for (int d0 = 0; d0 < 4; ++d0) { s16x4 lo[4], hh[4];
#pragma unroll
        for (int ks = 0; ks < 4; ++ks) {
            asm volatile("ds_read_b64_tr_b16 %0, %1 offset:%c2" : "=&v"(lo[ks]) : "v"(vb), "i"(d0 * 4096 + ks * 1024) : "memory");
            asm volatile("ds_read_b64_tr_b16 %0, %1 offset:%c2" : "=&v"(hh[ks]) : "v"(vb), "i"(d0 * 4096 + ks * 1024 + 512) : "memory"); }
        asm volatile("s_waitcnt lgkmcnt(0)" ::: "memory"); ASBAR();
#define ATT_PK(k) (bf16x8){lo[k][0], lo[k][1], lo[k][2], lo[k][3], hh[k][0], hh[k][1], hh[k][2], hh[k][3]}
        o[d0] = __builtin_amdgcn_mfma_f32_32x32x16_bf16(pa0, ATT_PK(0), o[d0], 0, 0, 0);
        o[d0] = __builtin_amdgcn_mfma_f32_32x32x16_bf16(pa1, ATT_PK(1), o[d0], 0, 0, 0);
        o[d0] = __builtin_amdgcn_mfma_f32_32x32x16_bf16(pa2, ATT_PK(2), o[d0], 0, 0, 0);
        o[d0] = __builtin_amdgcn_mfma_f32_32x32x16_bf16(pa3, ATT_PK(3), o[d0], 0, 0, 0);
#undef ATT_PK
    }
}

template <bool DIFF, int MODE = 0>
__device__ __forceinline__ void attn_unit(const AttnArgs& A, int b, int h, int qb, unsigned char* shm) {
    constexpr int ND0 = DIFF ? 4 : 12;
    constexpr int QROWS = DIFF ? 128 : 256;
    constexpr int KSLOT = DIFF ? 16384 : 24576;
    constexpr int NSLOT = 3;
    constexpr int NKS = DIFF ? 3 : 4;
    constexpr int V_OFF = NKS * KSLOT;
    constexpr int FDM = ATT_RING - 2;
    constexpr int NDF = DIFF ? 4 : 5;
    static_assert(V_OFF + NSLOT * 16384 <= WS_OFF, "rings fit below the scratch");
    int tid_ = threadIdx.x; asm volatile("" : "+v"(tid_));
    const int tid = tid_, lane = tid & 63, r32 = lane & 31, hi = lane >> 5; const int wid = __builtin_amdgcn_readfirstlane(tid >> 6);
    const int grp = wid >> 2;
    const int map = DIFF ? grp : 0, wrow = DIFF ? (wid & 3) : wid;
    const int q0 = qb * QROWS + wrow * 32;
    const int cw = q0 >> 6;
    const int NT = (qb * QROWS + QROWS) >> 6;
    const int KL = 3, VL = 1 + grp;
    const long rowbase = (long)b * SEQ;
    const unsigned lds0 = (unsigned)(uintptr_t)shm;
    ALDS unsigned char* shm3 = (ALDS unsigned char*)shm;
    ALDS float* wsf = (ALDS float*)(shm3 + WS_OFF) + wid * 64;
    ALDS float* tabl = (ALDS float*)(shm3 + TAB_OFF) + map * 256;
    const int vrow = 16 * (wid & 3) + (lane >> 2), vcol = (wid >> 2) * 32 + (lane & 3) * 8;
    constexpr int PITCHB = DIFF ? 6144 : 4096;
    const int krow = 8 * wid + (lane >> 3), kchk = (lane & 7) ^ ((krow >> 1) & 7);
    const unsigned voffK = (unsigned)(krow * PITCHB + kchk * 16), voffV = (unsigned)(vrow * PITCHB + vcol * 2), voffR = (unsigned)(krow * 128 + kchk * 16);
    const unsigned char* kvbase = DIFF ? (const unsigned char*)(A.QKV + rowbase * 3072 + 1024 + h * 128) : (const unsigned char*)(A.KVM + rowbase * 2048 + h * 256);
    const unsigned char* krbase = (const unsigned char*)(A.KR + rowbase * 64);
    const unsigned kd0 = lds0 + wid * 1024, vd0 = lds0 + V_OFF + wid * 1024;
    constexpr int VIMM = DIFF ? 2048 : 256;
#define ATT_DMA_K(t, sl) do { const long _t = (t); const unsigned _so = (unsigned)((sl) * KSLOT); const unsigned char* _b = uni_ptr(kvbase + _t * (64L * PITCHB)); \
        glds16s<0>(_b, voffK, (unsigned)__builtin_amdgcn_readfirstlane(kd0 + _so)); \
        glds16s<128>(_b, voffK, (unsigned)__builtin_amdgcn_readfirstlane(kd0 + 8192 + _so)); \
        if (!DIFF) glds16s<0>(uni_ptr(krbase + _t * (64L * 128)), voffR, (unsigned)__builtin_amdgcn_readfirstlane(kd0 + 16384 + _so)); } while (0)
#define ATT_DMA_V(t, sl) do { const long _t = (t); const unsigned _so = (unsigned)((sl) * 16384); const unsigned char* _b = uni_ptr(kvbase + _t * (64L * PITCHB)); \
        glds16s<VIMM>(_b, voffV, (unsigned)__builtin_amdgcn_readfirstlane(vd0 + _so)); \
        glds16s<VIMM + 128>(_b, voffV, (unsigned)__builtin_amdgcn_readfirstlane(vd0 + 8192 + _so)); } while (0)
    if (MODE < 2 || MODE == 30) { ATT_DMA_K(0, 0); ATT_DMA_K(1, 1); if (KL > 2 && 2 < NT) ATT_DMA_K(2, 2);
    ATT_DMA_V(0, 0); if (VL > 1) ATT_DMA_V(1, 1); }
    if (DIFF) { ((ALDS float*)(shm3 + TAB_OFF))[tid] = A.biastab[(h * 2 + (tid >> 8)) * 256 + (tid & 255)]; }
    bf16x8 qr[ND0];
    { const bf16* Qw = DIFF ? A.QKV + (rowbase + q0 + r32) * 3072 + h * 128 + map * 64 + hi * 8 : A.QM + (rowbase + q0 + r32) * 1536 + h * 192 + hi * 8;
#pragma unroll
      for (int d0 = 0; d0 < ND0; ++d0) qr[d0] = *reinterpret_cast<const bf16x8*>(Qw + d0 * 16); }
    float boff = 0.f; if (DIFF) boff = A.biastab[(h * 2 + map) * 256];
    float m_ref = 0.f, l_reg = 0.f; f32x16 o[4];
#pragma unroll
    for (int d = 0; d < 4; ++d) o[d] = f32x16{};
    const int kfo = (DIFF ? map * 8192 : 0) + r32 * 128;
    int ko[4];
#pragma unroll
    for (int i = 0; i < 4; ++i) ko[i] = 16 * ((2 * i + hi) ^ ((r32 >> 1) & 7));
    const int vbo = V_OFF + ((lane >> 4) & 1) * 32 + (lane & 3) * 8 + (4 * hi + ((lane & 15) >> 2)) * 64;
    f32x16 S0, S1; float al = 1.f;
    u32x4 pw[4]; if (MODE >= 1) { pw[0] = pw[1] = pw[2] = pw[3] = (u32x4){0u, 0u, 0u, 0u}; }
    bf16x8 vfix = {1, 2, 3, 4, 5, 6, 7, 8}; if (MODE == 25) { const unsigned hsh_ = (unsigned)(threadIdx.x * 2654435761u); vfix = (bf16x8){(short)(0x3f00 + (hsh_ & 0xff)), (short)(0xbf00 + ((hsh_ >> 8) & 0xff)), (short)(0x3e80 + ((hsh_ >> 16) & 0xff)), (short)(0xbe00 + ((hsh_ >> 24) & 0xff)), (short)(0x3f40 + ((hsh_ >> 4) & 0xff)), (short)(0xbf20 + ((hsh_ >> 12) & 0xff)), (short)(0x3ec0 + ((hsh_ >> 20) & 0xff)), (short)(0xbe80 + ((hsh_ >> 2) & 0xff))}; } if (MODE >= 14) asm volatile("" : "+v"(vfix));
    bf16x8 kf[8]; bf16x8 fb[ATT_RING]; f32x16 negm; float negv = 3e38f;
#pragma unroll
    for (int r = 0; r < 16; ++r) negm[r] = 0.f;
#define ATT_MF(acc, a, b) acc = __builtin_amdgcn_mfma_f32_32x32x16_bf16(a, b, acc, 0, 0, 0)
#define ATT_XBAR() asm volatile("s_waitcnt lgkmcnt(0)\n\ts_barrier" ::: "memory")
#define ATT_KFRD(SL) do { ALDS const unsigned char* kp_ = shm3 + (SL) * KSLOT + kfo; \
        _Pragma("unroll") for (int d0 = 0; d0 < 4; ++d0) { kf[2 * d0] = *(ALDS const bf16x8*)(kp_ + ko[d0]); kf[2 * d0 + 1] = *(ALDS const bf16x8*)(kp_ + ko[d0] + 4096); } } while (0)
#define ATT_LDK(f) do { if (MODE >= 14 && MODE < 28) { fb[(f) % ATT_RING] = vfix; break; } fb[(f) % ATT_RING] = *(ALDS const bf16x8*)(kp_ + ((f) >> 3) * 8192 + ko[((f) >> 1) & 3] + ((f) & 1) * 4096); } while (0)
#define ATT_LDV(g) do { if (MODE >= 14 && MODE < 28) { fb[(g) % ATT_RING] = vfix; \
        if (MODE == 20) { s16x4 t0_, t1_; asm volatile("ds_read_b64_tr_b16 %0, %2 offset:%c3\n\tds_read_b64_tr_b16 %1, %2 offset:%c4" : "=&v"(t0_), "=&v"(t1_) : "v"(vp_), "i"(((g) & 3) * 4096 + ((g) >> 2) * 1024), "i"(((g) & 3) * 4096 + ((g) >> 2) * 1024 + 512) : "memory"); } \
        if (MODE == 24) { s16x4 t0_, t1_; asm volatile("ds_read_b64_tr_b16 %0, %2 offset:%c3\n\tds_read_b64_tr_b16 %1, %2 offset:%c4\n\ts_waitcnt lgkmcnt(10)" : "=&v"(t0_), "=&v"(t1_) : "v"(vp_), "i"(((g) & 3) * 4096 + ((g) >> 2) * 1024), "i"(((g) & 3) * 4096 + ((g) >> 2) * 1024 + 512) : "memory"); } \
        if (MODE == 21) { s16x4 t0_, t1_; asm volatile("ds_read_b64 %0, %2 offset:%c3\n\tds_read_b64 %1, %2 offset:%c4" : "=&v"(t0_), "=&v"(t1_) : "v"(vp_), "i"(((g) & 3) * 4096 + ((g) >> 2) * 1024), "i"(((g) & 3) * 4096 + ((g) >> 2) * 1024 + 512) : "memory"); } \
        if (MODE == 22) { s16x4 t0_, t1_; asm volatile("ds_read_b64_tr_b16 %0, %2 offset:%c3\n\tds_read_b64_tr_b16 %1, %2 offset:%c4" : "=&v"(t0_), "=&v"(t1_) : "v"(vp_ - V_OFF), "i"(((g) & 3) * 4096 + ((g) >> 2) * 1024), "i"(((g) & 3) * 4096 + ((g) >> 2) * 1024 + 512) : "memory"); } \
        if (MODE == 23) { bf16x8 t0_; asm volatile("ds_read_b128 %0, %1 offset:%c2" : "=&v"(t0_) : "v"(vp_), "i"(((g) & 3) * 4096 + ((g) >> 2) * 1024) : "memory"); } \
        break; } const s16x4 l_ = vtr(vp_ + ((g) & 3) * 4096 + ((g) >> 2) * 1024), h_ = vtr(vp_ + ((g) & 3) * 4096 + ((g) >> 2) * 1024 + 512); \
        fb[(g) % ATT_RING] = (bf16x8){l_[0], l_[1], l_[2], l_[3], h_[0], h_[1], h_[2], h_[3]}; } while (0)
#define ATT_XQK_D(T, WITHV) do { const float nb_ = (((T) + 2 < cw) ? boff : 0.f) - m_ref; \
        if (__any(nb_ != negv)) { negv = nb_; _Pragma("unroll") for (int r = 0; r < 16; ++r) negm[r] = nb_; asm volatile("" : "+v"(negm)); } \
        S0 = __builtin_amdgcn_mfma_f32_32x32x16_bf16(kf[0], qr[0], negm, 0, 0, 0); if (WITHV) ATT_LDV(0); ASBAR(); \
        S1 = __builtin_amdgcn_mfma_f32_32x32x16_bf16(kf[1], qr[0], negm, 0, 0, 0); if (WITHV) ATT_LDV(1); ASBAR(); \
        _Pragma("unroll") for (int m_ = 2; m_ < 8; ++m_) { if (m_ & 1) ATT_MF(S1, kf[m_], qr[m_ >> 1]); else ATT_MF(S0, kf[m_], qr[m_ >> 1]); if (WITHV) ATT_LDV(m_); ASBAR(); } } while (0)
#define ATT_XQK_M(SL, WITHV, PRE) do { ALDS const unsigned char* kp_ = shm3 + (SL) * KSLOT + kfo; const float nb_ = -m_ref; \
        if (PRE) { _Pragma("unroll") for (int f_ = 0; f_ < FDM; ++f_) ATT_LDK(f_); } \
        if (__all(nb_ == 0.f)) { const f32x16 z16_ = f32x16{};     \
            S0 = __builtin_amdgcn_mfma_f32_32x32x16_bf16(fb[0], qr[0], z16_, 0, 0, 0); S1 = __builtin_amdgcn_mfma_f32_32x32x16_bf16(fb[1], qr[0], z16_, 0, 0, 0); } \
        else { _Pragma("unroll") for (int r = 0; r < 16; ++r) { S0[r] = nb_; S1[r] = nb_; } \
            ATT_MF(S0, fb[0], qr[0]); ATT_MF(S1, fb[1], qr[0]); } \
        ATT_LDK(FDM); ATT_LDK(FDM + 1); ASBAR(); \
        _Pragma("unroll") for (int m_ = 2; m_ < 24; ++m_) { if (m_ & 1) ATT_MF(S1, fb[m_ % ATT_RING], qr[m_ >> 1]); else ATT_MF(S0, fb[m_ % ATT_RING], qr[m_ >> 1]); \
            if (m_ + FDM < 24) ATT_LDK(m_ + FDM); else if (WITHV) ATT_LDV(m_ + FDM - 24); ASBAR(); } } while (0)
#define ATT_XPV(FD) do { _Pragma("unroll") for (int g_ = 0; g_ < 16; ++g_) { if (MODE == 28) ATT_MF(o[g_ & 3], fb[g_ % ATT_RING], __builtin_bit_cast(bf16x8, pw[g_ >> 2])); else ATT_MF(o[g_ & 3], __builtin_bit_cast(bf16x8, pw[g_ >> 2]), fb[g_ % ATT_RING]); if (g_ + (FD) < 16) ATT_LDV(g_ + (FD)); ASBAR(); } } while (0)
#define ATT_RESC(AL) do { if (__any((AL) < 1.f)) { l_reg *= (AL); if (hi == 0) wsf[r32] = (AL); asm volatile("s_waitcnt lgkmcnt(0)" ::: "memory"); \
        _Pragma("unroll") for (int r = 0; r < 16; ++r) { const float al_ = wsf[crow(r, hi)]; _Pragma("unroll") for (int d = 0; d < 4; ++d) o[d][r] *= al_; } } } while (0)
    if (MODE == 29) { for (int i_ = tid * 16; i_ < V_OFF + NSLOT * 16384; i_ += 8192) *(ALDS u32x4*)(shm3 + i_) = (u32x4){0u, 0u, 0u, 0u}; }
    ATT_WAIT_BAR();
    int s0 = 0, k0 = 0;
    { ALDS const unsigned char* vp_ = shm3 + vbo; (void)vp_; if (DIFF) { ATT_KFRD(0); ATT_XQK_D(0, false); } else ATT_XQK_M(0, false, true); }
    ATT_XBAR();
    if (MODE != 5 && MODE != 15 && grp) ATT_XBAR();
    for (int j = 0; j < NT; ++j) {
        const int s1 = (s0 == 2) ? 0 : s0 + 1, s2 = (s1 == 2) ? 0 : s1 + 1; const int k1 = (k0 == NKS - 1) ? 0 : k0 + 1, k3 = (NKS == 3) ? k0 : ((k0 == 0) ? 3 : k0 - 1);
        int nd_ = 0;
        { const int tk_ = j + KL, tv_ = j + VL; const int slk_ = k3, slv_ = grp ? s2 : s1;
          if (MODE < 2 || MODE == 30) { if (tk_ < NT) { ATT_DMA_K(tk_, slk_); nd_ += DIFF ? 2 : 3; }
          if (tv_ < NT) { ATT_DMA_V(tv_, slv_); nd_ += 2; } } }
        if ((MODE == 7 || (MODE >= 14 && MODE < 30)) && j <= cw) { if (DIFF) ATT_KFRD(k1); l_reg += S0[0] + S1[3]; }
        if (MODE != 1 && MODE != 10 && MODE != 3 && MODE != 7 && (MODE < 14 || MODE >= 30) && j <= cw) {
            if (ATT_YPRIO && DIFF) __builtin_amdgcn_s_setprio(ATT_YPRIO);
            if (DIFF) ATT_KFRD(k1);
            else if (j < cw) { ALDS const unsigned char* kp_ = shm3 + k1 * KSLOT + kfo;
#pragma unroll
                for (int f_ = 0; f_ < FDM; ++f_) ATT_LDK(f_); }
            if (DIFF && (j + 2 >= cw)) { ALDS const float* tb_ = tabl + (64 * j - q0 - r32 + 192);
#pragma unroll
                for (int r = 0; r < 16; ++r) { const int kk_ = crow(r, hi); S0[r] += tb_[kk_]; S1[r] += tb_[kk_ + 32]; } }
            f32x16 P0, P1;
#pragma unroll
            for (int r = 0; r < 16; ++r) { if (MODE == 33) { P0[r] = S0[r]; P1[r] = S1[r]; } else { P0[r] = __builtin_amdgcn_exp2f(S0[r]); P1[r] = __builtin_amdgcn_exp2f(S1[r]); } }
            float ps_;
            if (MODE == 34) { ps_ = P0[0] + P1[5] + P0[9] + P1[13] + P0[2] + P1[7] + P0[11] + P1[15] + P0[4] + P1[1] + P0[6] + P1[3] + P0[8] + P1[10] + P0[12] + P1[14] + P0[1] + P0[3] + P0[5] + P0[7] + P0[10] + P0[13] + P0[14] + P0[15] + P1[0] + P1[2] + P1[4] + P1[6] + P1[8] + P1[9] + P1[11] + P1[12]; } else
            { float a0_ = fadd_s(P0[0], P1[0]), a1_ = fadd_s(P0[1], P1[1]), a2_ = fadd_s(P0[2], P1[2]), a3_ = fadd_s(P0[3], P1[3]);
#pragma unroll
              for (int r = 4; r < 16; r += 4) { a0_ = fadd_s(a0_, fadd_s(P0[r], P1[r])); a1_ = fadd_s(a1_, fadd_s(P0[r + 1], P1[r + 1])); a2_ = fadd_s(a2_, fadd_s(P0[r + 2], P1[r + 2])); a3_ = fadd_s(a3_, fadd_s(P0[r + 3], P1[r + 3])); }
              ps_ = fadd_s(fadd_s(a0_, a1_), fadd_s(a2_, a3_)); }
            l_reg += ps_;
            pw[0] = (u32x4){cvtpk_s(P0[0], P0[1]), cvtpk_s(P0[2], P0[3]), cvtpk_s(P0[4], P0[5]), cvtpk_s(P0[6], P0[7])};
            pw[1] = (u32x4){cvtpk_s(P0[8], P0[9]), cvtpk_s(P0[10], P0[11]), cvtpk_s(P0[12], P0[13]), cvtpk_s(P0[14], P0[15])};
            pw[2] = (u32x4){cvtpk_s(P1[0], P1[1]), cvtpk_s(P1[2], P1[3]), cvtpk_s(P1[4], P1[5]), cvtpk_s(P1[6], P1[7])};
            pw[3] = (u32x4){cvtpk_s(P1[8], P1[9]), cvtpk_s(P1[10], P1[11]), cvtpk_s(P1[12], P1[13]), cvtpk_s(P1[14], P1[15])};
            al = 1.f;
            if (ATT_YPRIO && DIFF) __builtin_amdgcn_s_setprio(0);
            if (__any(ps_ > 65536.f)) { const float pr_ = swapsum(ps_); const float dl_ = pr_ > 65536.f ? __builtin_amdgcn_logf(pr_) : 0.f; m_ref += dl_; al = __builtin_amdgcn_exp2f(-dl_); }
        }
        if (nd_ == NDF) { if (DIFF) ATT_WAIT_BAR_N(4); else ATT_WAIT_BAR_N(5); } else ATT_WAIT_BAR();
        if (MODE != 1 && MODE != 10 && MODE != 4 && j <= cw) {
            ALDS const unsigned char* vp_ = shm3 + vbo + s0 * 16384;
            if (ATT_PRIO) __builtin_amdgcn_s_setprio(ATT_PRIO);
            if (DIFF) { if (MODE != 32 && j < cw) ATT_XQK_D(j + 1, true); else { _Pragma("unroll") for (int g_ = 0; g_ < 8; ++g_) ATT_LDV(g_); } ASBAR(); ATT_XPV(8); }
            else { if (j < cw) ATT_XQK_M(k1, true, false); else { _Pragma("unroll") for (int g_ = 0; g_ < FDM; ++g_) ATT_LDV(g_); } ASBAR(); ATT_XPV(FDM); }
            ATT_RESC(al);
            if (ATT_PRIO) __builtin_amdgcn_s_setprio(0);
        }
        ATT_XBAR();
        s0 = s1; k0 = k1;
    }
    if (MODE != 5 && MODE != 15 && !grp) ATT_XBAR();
#undef ATT_DMA_K
#undef ATT_DMA_V
#undef ATT_KFRD
#undef ATT_LDK
#undef ATT_LDV
#undef ATT_XQK_D
#undef ATT_XQK_M
#undef ATT_XPV
#undef ATT_MF
#undef ATT_RESC
#undef ATT_XBAR
    if (MODE >= 1) { asm volatile("" : "+v"(l_reg)); ATT_WAIT_BAR(); if (l_reg == 123456.f) A.Y[tid] = (bf16)(int)(o[0][0] + o[1][1] + o[2][2] + o[3][3] + m_ref); ATT_WAIT_BAR(); return; }
    {
    int tid2_ = threadIdx.x; asm volatile("" : "+v"(tid2_));
    const int lane = tid2_ & 63, r32 = lane & 31, hi = lane >> 5; const int wid = __builtin_amdgcn_readfirstlane(tid2_ >> 6);
    const int map = DIFF ? (wid >> 2) : 0, wrow = DIFF ? (wid & 3) : wid;
    const int q0 = qb * QROWS + wrow * 32;
    ALDS float* wsf = (ALDS float*)(shm3 + WS_OFF) + wid * 64;
    ATT_WAIT_BAR();
    l_reg = swapsum(l_reg);
    if (hi == 0) wsf[32 + r32] = __builtin_amdgcn_rcpf(l_reg);
    asm volatile("s_waitcnt lgkmcnt(0)" ::: "memory");
    float rli[16];
#pragma unroll
    for (int r = 0; r < 16; ++r) rli[r] = wsf[32 + crow(r, hi)];
    ALDS bf16* stg;
    bool writer = true;
    if (DIFF) {
        ALDS float* X = (ALDS float*)(shm3 + (wid & 3) * 16384);
        if (map == 1) {
            const float lam = A.lam;
#pragma unroll
            for (int r = 0; r < 16; ++r) { const float f = rli[r] * lam; const int orow = crow(r, hi);
#pragma unroll
                for (int d = 0; d < 4; ++d) X[orow * 128 + d * 32 + r32] = o[d][r] * f; }
        }
        ATT_WAIT_BAR();
        stg = (ALDS bf16*)(shm3 + (wid & 3) * 16384);
        if (map == 0) {
            float g4[4];
#pragma unroll
            for (int d = 0; d < 4; ++d) g4[d] = A.subg[d * 32 + r32] * A.oml;
            float ss[16];
#pragma unroll
            for (int r = 0; r < 16; ++r) { const int orow = crow(r, hi); float s = 0.f;
#pragma unroll
                for (int d = 0; d < 4; ++d) { const float v = o[d][r] * rli[r] - X[orow * 128 + d * 32 + r32]; o[d][r] = v; s += v * v; }
                ss[r] = s; }
#pragma unroll
            for (int r = 0; r < 16; ++r) { float s = ss[r];
                s += __shfl_xor(s, 1); s += __shfl_xor(s, 2); s += __shfl_xor(s, 4); s += __shfl_xor(s, 8); s += __shfl_xor(s, 16);
                ss[r] = 1.0f / sqrtf(s * (1.0f / 128.0f) + EPS); }
            asm volatile("s_waitcnt lgkmcnt(0)" ::: "memory");
#pragma unroll
            for (int r = 0; r < 16; ++r) { const int orow = crow(r, hi);
#pragma unroll
                for (int d = 0; d < 4; ++d) stg[orow * 128 + d * 32 + r32] = (bf16)(cvtpk_s(o[d][r] * ss[r] * g4[d], 0.f) & 0xffffu); }
        } else writer = false;
    } else {
        stg = (ALDS bf16*)(shm3 + wid * 8192);
#pragma unroll
        for (int r = 0; r < 16; ++r) { const int orow = crow(r, hi);
#pragma unroll
            for (int d = 0; d < 4; ++d) stg[orow * 128 + d * 32 + r32] = (bf16)(cvtpk_s(o[d][r] * rli[r], 0.f) & 0xffffu); }
    }
    if (writer) {
        asm volatile("s_waitcnt lgkmcnt(0)" ::: "memory");
        const int gcol = (DIFF ? 0 : 1024) + h * 128;
#pragma unroll
        for (int i = 0; i < 8; ++i) { const int row = i * 4 + (lane >> 4), ch = lane & 15;
            const u32x4 ov = *(ALDS const u32x4*)(stg + row * 128 + ch * 8);
            const size_t gi = (size_t)(rowbase + q0 + row) * 2048 + gcol + ch * 8;
            const u32x4 gv = *(const u32x4*)(A.GATE + gi);
            u32x4 yv;
#pragma unroll
            for (int e = 0; e < 4; ++e) {
                const float o_lo = __uint_as_float(ov[e] << 16), o_hi = __uint_as_float(ov[e] & 0xffff0000u);
                const float g_lo = __uint_as_float(gv[e] << 16), g_hi = __uint_as_float(gv[e] & 0xffff0000u);
                const float s_lo = g_lo * __builtin_amdgcn_rcpf(1.0f + __builtin_amdgcn_exp2f(-g_lo * LOG2E));
                const float s_hi = g_hi * __builtin_amdgcn_rcpf(1.0f + __builtin_amdgcn_exp2f(-g_hi * LOG2E));
                yv[e] = cvtpk_s(o_lo * s_lo, o_hi * s_hi); }
            *(u32x4*)(A.Y + gi) = yv; }
    }
    ATT_WAIT_BAR();
    }
}
#undef ASBAR
}
constexpr size_t MiB = 1u << 20;
constexpr size_t WS_CTL = 0, CTL_ZERO_BYTES = 1 * MiB;
constexpr size_t WS_ROPEC = 1 * MiB, WS_ROPES = WS_ROPEC + 512 * 1024;
constexpr size_t WS_SMALL = 2 * MiB;
constexpr size_t SM_BIAS = 1024, SM_RSQ = 128 * 1024, SM_RSKV = 256 * 1024;
constexpr size_t WS_WIN = 4 * MiB;
constexpr size_t WS_WQB = 52 * MiB;
constexpr size_t WS_WKVB = 55 * MiB;
constexpr size_t WS_WOUT = 57 * MiB;
constexpr size_t WS_H = 80 * MiB;
constexpr size_t WS_Y = WS_H;
constexpr size_t WS_QKV = 144 * MiB;
constexpr size_t WS_CQ = 240 * MiB;
constexpr size_t WS_CKV = 256 * MiB;
constexpr size_t WS_KR = 264 * MiB;
constexpr size_t WS_GATE = 272 * MiB;
constexpr size_t WS_QM = 336 * MiB;
constexpr size_t WS_KVM = 384 * MiB;
constexpr size_t WS_XB = 448 * MiB;
constexpr size_t WS_END = 512 * MiB;
constexpr int CW_BAR = 4096;
constexpr size_t CTL_SSQ = 65536;

constexpr int RING_OFF = 0, RING_BYTES = 155648;
constexpr int LDSCTL_OFF = RING_BYTES, MISC_OFF = LDSCTL_OFF + 320;
constexpr int LDS_BYTES = 163840;
constexpr int NWAVES = 8;
static_assert(att::ATT_LDS_BYTES <= RING_BYTES, "attention scratch fits the ring region");

__device__ __forceinline__ float wave_sum(float v) {
#pragma unroll
    for (int o = 1; o < 64; o <<= 1) v += __shfl_xor(v, o);
    return v;
}
__device__ __forceinline__ int in_srccol(int n) {
    if (n < 3840) return n;
    if (n < 3904) { const int p = n - 3840, a = p >> 3, j = p & 7; return 3840 + (j < 4 ? 4 * a + j : 32 + 4 * a + (j - 4)); }
    if (n < 4096) return -1;
    return n - 192;
}
__device__ __forceinline__ int qb_srccol(int n) {
    const int hh = n / 192, off = n - hh * 192; if (off < 128) return n;
    const int p = off - 128, a = p >> 3, j = p & 7; return hh * 192 + 128 + (j < 4 ? 4 * a + j : 32 + 4 * a + (j - 4));
}
template <int MODE>
__device__ __forceinline__ void transpose_item(const float* W, int K, int Nsrc, int Ndst, bf16* WT, const float* gk, LAS float* scr, int item, int lane) {
    const int nblk = Ndst / 32, kb = item / nblk, nb = item - kb * nblk, k0 = 64 * kb, n0 = 32 * nb;
    const int nd = n0 + (lane & 31);
    const int src = (MODE == 1) ? in_srccol(nd) : (MODE == 2) ? qb_srccol(nd) : nd;
    float v[32];
#pragma unroll
    for (int i = 0; i < 32; ++i) { const int kk = 2 * i + (lane >> 5); v[i] = 0.f;
        if (src >= 0) { v[i] = W[(size_t)(k0 + kk) * Nsrc + src]; if (gk) v[i] *= gk[k0 + kk]; } }
#pragma unroll
    for (int i = 0; i < 32; ++i) { const int kk = 2 * i + (lane >> 5); scr[kk * 33 + (lane & 31)] = v[i]; }
    LDS_WAIT(); asm volatile("" ::: "memory");
    const int c = lane & 7;
#pragma unroll
    for (int j = 0; j < 4; ++j) { const int n = (lane >> 3) + 8 * j; const LAS float* s = scr + (8 * c) * 33 + n;
        v4u o; o.x = pk2(s[0 * 33], s[1 * 33]); o.y = pk2(s[2 * 33], s[3 * 33]); o.z = pk2(s[4 * 33], s[5 * 33]); o.w = pk2(s[6 * 33], s[7 * 33]);
        *(GAS v4u*)(WT + (size_t)(n0 + n) * K + k0 + 8 * c) = o; }
    LDS_WAIT(); asm volatile("" ::: "memory");
}
__device__ __forceinline__ void rms_row_to_bf16(const float* xrow, const float* g, bf16* orow, int lane) {
    const GAS f32x4* xr = (const GAS f32x4*)xrow + lane; const GAS f32x4* gr = (const GAS f32x4*)g + lane;
    f32x4 v[8]; float s = 0.f;
#pragma unroll
    for (int j = 0; j < 8; ++j) { v[j] = xr[64 * j]; s += (v[j].x * v[j].x + v[j].y * v[j].y) + (v[j].z * v[j].z + v[j].w * v[j].w); }
    const float rstd = 1.0f / sqrtf(wave_sum(s) * (1.0f / DM) + EPS);
    GAS unsigned long long* o8 = (GAS unsigned long long*)orow + lane;
#pragma unroll
    for (int j = 0; j < 8; ++j) { const f32x4 gg = gr[64 * j];
        o8[64 * j] = (unsigned long long)pk2(v[j].x * rstd * gg.x, v[j].y * rstd * gg.y) | ((unsigned long long)pk2(v[j].z * rstd * gg.z, v[j].w * rstd * gg.w) << 32); }
}
template <bool TOF32> __device__ __forceinline__ void rms_row_from_bf16(const bf16* xrow, const float* g, void* orow, int lane) {
    const GAS v4u* xr = (const GAS v4u*)xrow + lane; const GAS f32x4* gr = (const GAS f32x4*)g + 2 * lane;
    float v[4][8]; float s = 0.f;
#pragma unroll
    for (int j = 0; j < 4; ++j) { const v4u w = xr[64 * j]; const unsigned ww[4] = {w.x, w.y, w.z, w.w};
#pragma unroll
        for (int e = 0; e < 4; ++e) { v[j][2 * e] = __uint_as_float(ww[e] << 16); v[j][2 * e + 1] = __uint_as_float(ww[e] & 0xffff0000u); }
#pragma unroll
        for (int e = 0; e < 8; e += 2) s += v[j][e] * v[j][e] + v[j][e + 1] * v[j][e + 1]; }
    const float rstd = 1.0f / sqrtf(wave_sum(s) * (1.0f / DM) + EPS);
#pragma unroll
    for (int j = 0; j < 4; ++j) { const f32x4 g0 = gr[128 * j], g1 = gr[128 * j + 1];
        if (TOF32) { GAS f32x4* o4 = (GAS f32x4*)orow + 2 * lane + 128 * j;
            f32x4 a, b; a.x = v[j][0] * rstd * g0.x; a.y = v[j][1] * rstd * g0.y; a.z = v[j][2] * rstd * g0.z; a.w = v[j][3] * rstd * g0.w;
            b.x = v[j][4] * rstd * g1.x; b.y = v[j][5] * rstd * g1.y; b.z = v[j][6] * rstd * g1.z; b.w = v[j][7] * rstd * g1.w; o4[0] = a; o4[1] = b; }
        else { v4u o; o.x = pk2(v[j][0] * rstd * g0.x, v[j][1] * rstd * g0.y); o.y = pk2(v[j][2] * rstd * g0.z, v[j][3] * rstd * g0.w);
            o.z = pk2(v[j][4] * rstd * g1.x, v[j][5] * rstd * g1.y); o.w = pk2(v[j][6] * rstd * g1.z, v[j][7] * rstd * g1.w); ((GAS v4u*)orow)[lane + 64 * j] = o; } }
}
__device__ __forceinline__ void rms_row_f32(const float* xrow, const float* g, float* orow, int lane) {
    const GAS f32x4* xr = (const GAS f32x4*)xrow + lane; const GAS f32x4* gr = (const GAS f32x4*)g + lane;
    f32x4 v[8]; float s = 0.f;
#pragma unroll
    for (int j = 0; j < 8; ++j) { v[j] = xr[64 * j]; s += (v[j].x * v[j].x + v[j].y * v[j].y) + (v[j].z * v[j].z + v[j].w * v[j].w); }
    const float rstd = 1.0f / sqrtf(wave_sum(s) * (1.0f / DM) + EPS);
    GAS f32x4* o4 = (GAS f32x4*)orow + lane;
#pragma unroll
    for (int j = 0; j < 8; ++j) { const f32x4 gg = gr[64 * j]; o4[64 * j] = v[j] * rstd * gg; }
}
__device__ __forceinline__ int rel_bucket(int rel) {
    const int n = rel < 0 ? -rel : rel; int bk;
    if (n < 8) bk = n; else if (n < 12) bk = 8; else if (n < 16) bk = 9; else if (n < 23) bk = 10; else if (n < 32) bk = 11;
    else if (n < 46) bk = 12; else if (n < 64) bk = 13; else if (n < 91) bk = 14; else bk = 15;
    return (rel > 0 ? 16 : 0) + bk;
}

struct Args { const float* in[12]; float* out; unsigned char* ws; int ph_lo, ph_hi; };
constexpr int N_PHASES = 11;

#define IN(k) (lo <= (k) && (k) < hi)
#ifndef MK_REP_G23
#define MK_REP_G23 1
#endif
#ifndef MK_REP_G4
#define MK_REP_G4 1
#endif
#ifndef MK_REP_NORM
#define MK_REP_NORM 1
#endif
#ifndef MK_REP_RS
#define MK_REP_RS 1
#endif
#ifndef MK_ATT_MIX
#define MK_ATT_MIX 1
#endif
#ifndef MK_ATT_PROBE
#define MK_ATT_PROBE 0
#endif
#ifndef MK_REP_G1
#define MK_REP_G1 1
#endif
#ifndef MK_REP_P0
#define MK_REP_P0 1
#endif
#ifndef MK_CG_SEAM
#define MK_CG_SEAM 0
#endif
#ifndef MK_CG_ONLY
#define MK_CG_ONLY 0
#endif
#ifdef MK_STAMP
#define STAMP(k) do { if (blockIdx.x == 0 && threadIdx.x == 0) WSP(unsigned long long, WS_SMALL + 64)[(k)] = __builtin_amdgcn_s_memrealtime(); } while (0)
#else
#define STAMP(k) do { } while (0)
#endif
#define SEAM(k) do { if (IN(k) && IN((k) + 1)) { if (MK_CG_ONLY || (k) == MK_CG_SEAM) grid.sync(); else xcd_barrier(bar); } STAMP((k) + 1); } while (0)
#define WSP(T, off) ((T*)(args.ws + (off)))

__device__ __forceinline__ void prologue_phase(const Args& args, unsigned char* lds, int G, int vcu) {
    int tid_ = threadIdx.x; asm volatile("" : "+v"(tid_));
    const int tid = tid_, lane = tid & 63, wave = __builtin_amdgcn_readfirstlane(tid >> 6);
    const int gw = vcu * NWAVES + wave, NGW = G * NWAVES;
    const float* x = args.in[0]; const float* norm_g = args.in[1]; const float* w_in = args.in[2]; const float* diff_lambda = args.in[3];
    const float* qnorm_g = args.in[5]; const float* w_qb = args.in[6]; const float* kvnorm_g = args.in[7];
    const float* w_kvb = args.in[8]; const float* w_out = args.in[9]; const float* rel_bias = args.in[10];
    float* ropec = WSP(float, WS_ROPEC); float* ropes = WSP(float, WS_ROPES); float* smallf = WSP(float, WS_SMALL); float* biastab = WSP(float, WS_SMALL + SM_BIAS);
    bf16* Win_t = WSP(bf16, WS_WIN); bf16* Wqb_t = WSP(bf16, WS_WQB); bf16* Wkvb_t = WSP(bf16, WS_WKVB); bf16* Wout_t = WSP(bf16, WS_WOUT); bf16* Hb = WSP(bf16, WS_H);
    LAS float* scr = (LAS float*)((LAS unsigned char*)lds + RING_OFF + wave * 16384);
    constexpr int I_IN = (DM / 64) * (NINP / 32), I_QB = (QLORA / 64) * (NQB / 32), I_KVB = (KVLORA / 64) * (NKVB / 32), I_OUT = (DM / 64) * (DM / 32);
    constexpr int PER_L = I_IN + I_QB + I_KVB + I_OUT;
    for (int it = gw; it < DEPTH * PER_L; it += NGW) {
        const int l = it / PER_L; int r = it - l * PER_L;
        if (r < I_IN) { transpose_item<1>(w_in + (size_t)l * DM * NIN, DM, NIN, NINP, Win_t + (size_t)l * NINP * DM, nullptr, scr, r, lane); continue; } r -= I_IN;
        if (r < I_QB) { transpose_item<2>(w_qb + (size_t)l * QLORA * NQB, QLORA, NQB, NQB, Wqb_t + (size_t)l * NQB * QLORA, qnorm_g + l * QLORA, scr, r, lane); continue; } r -= I_QB;
        if (r < I_KVB) { transpose_item<0>(w_kvb + (size_t)l * KVLORA * NKVB, KVLORA, NKVB, NKVB, Wkvb_t + (size_t)l * NKVB * KVLORA, kvnorm_g + l * KVLORA, scr, r, lane); continue; } r -= I_KVB;
        transpose_item<0>(w_out + (size_t)l * DM * DM, DM, DM, DM, Wout_t + (size_t)l * DM * DM, nullptr, scr, r, lane);
    }
    const int gt = vcu * (NWAVES * 64) + tid, NGT = G * NWAVES * 64;
    for (int e = gt; e < SEQ * 32; e += NGT) { const int s = e >> 5, i = e & 31;
        const float inv = powf(10000.0f, -(float)i * (1.0f / 32.0f)); const float ang = (float)s * inv;
        ropec[e] = cosf(ang); ropes[e] = sinf(ang); }
    for (int e = gt; e < 16 * 256; e += NGT) { const int mh = e >> 8, idx = e & 255; biastab[e] = rel_bias[rel_bucket(idx - 192) * 16 + mh] * LOG2E; }
    if (gt < DEPTH) { const float* lp = diff_lambda + gt * 256; float s01 = 0.f, s23 = 0.f;
        for (int i = 0; i < 64; ++i) { s01 += lp[i] * lp[64 + i]; s23 += lp[128 + i] * lp[192 + i]; }
        const float lam_init = 0.8f - 0.6f * expf(-0.3f * (float)gt);
        smallf[gt] = expf(s01) - expf(s23) + lam_init; smallf[8 + gt] = 1.0f - lam_init; }
    for (int m = gw; m < MROWS; m += NGW) rms_row_to_bf16(x + (size_t)m * DM, norm_g, Hb + (size_t)m * DM, lane);
}

template <int L>
__device__ __forceinline__ void layer_phases(const Args& args, unsigned char* lds, cg::grid_group& grid, const XcdBarrier& bar, int lo, int hi, int G, int bx, int vcu) {
    constexpr int pb = 1 + 5 * L;
    LAS unsigned char* ldsl = (LAS unsigned char*)lds;
#ifdef MK_CLK
    if (L == 0 && blockIdx.x == 0 && threadIdx.x == 0) { unsigned long long* ts = WSP(unsigned long long, WS_SMALL + 64); ts[10] = __builtin_amdgcn_s_memtime(); ts[11] = __builtin_amdgcn_s_memrealtime(); }
#endif
    if (IN(pb)) {
        pg8::Gemm g{WSP(bf16, WS_H), WSP(bf16, WS_WIN) + (size_t)L * NINP * DM, MROWS, NINP, DM}; pg8::StaticOrder S; S.init(MROWS, NINP, G, bx);
        pg8::EpiInProj E{WSP(bf16, WS_QKV), WSP(bf16, WS_CQ), WSP(bf16, WS_CKV), WSP(bf16, WS_KR), WSP(bf16, WS_GATE), WSP(float, WS_ROPEC), WSP(float, WS_ROPES), WSP(float, WS_CTL + CTL_SSQ + (size_t)(2 * L) * 65536), WSP(float, WS_CTL + CTL_SSQ + (size_t)(2 * L + 1) * 65536)};
        for (int rep_ = 0; rep_ < MK_REP_G1; ++rep_)
        pg8::gemm_phase<pg8::EpiInProj, pg8::StaticOrder, true, true>(ldsl + RING_OFF, g, S, E);
    }
#ifdef MK_CLK
    if (L == 0 && blockIdx.x == 0 && threadIdx.x == 0) { unsigned long long* ts = WSP(unsigned long long, WS_SMALL + 64); ts[12] = __builtin_amdgcn_s_memtime(); ts[13] = __builtin_amdgcn_s_memrealtime(); }
#endif
    SEAM(pb);
    if (IN(pb + 1)) for (int rep_ = 0; rep_ < MK_REP_G23; ++rep_) {
        { pg8::Gemm g{WSP(bf16, WS_CQ), WSP(bf16, WS_WQB) + (size_t)L * NQB * QLORA, MROWS, NQB, QLORA}; pg8::StaticOrder S; S.init(MROWS, NQB, G, bx);
          pg8::EpiRowScale<true> E{WSP(bf16, WS_QM), NQB, WSP(float, WS_CTL + CTL_SSQ + (size_t)(2 * L) * 65536), 1.0f / QLORA, WSP(float, WS_ROPEC), WSP(float, WS_ROPES), 0.07216878364870323f * LOG2E};
#ifndef NO_G2
          pg8::gemm_phase<pg8::EpiRowScale<true>, pg8::StaticOrder, true, true>(ldsl + RING_OFF, g, S, E);
#endif
        }
        { pg8::Gemm g{WSP(bf16, WS_CKV), WSP(bf16, WS_WKVB) + (size_t)L * NKVB * KVLORA, MROWS, NKVB, KVLORA}; pg8::KvOrder S; S.init(MROWS, NKVB, G, bx);
          pg8::EpiRowScale<false> E{WSP(bf16, WS_KVM), NKVB, WSP(float, WS_CTL + CTL_SSQ + (size_t)(2 * L + 1) * 65536), 1.0f / KVLORA, nullptr, nullptr, 1.0f};
#ifndef NO_G3
          pg8::gemm_phase<pg8::EpiRowScale<false>, pg8::KvOrder, true, true>(ldsl + RING_OFF, g, S, E);
#endif
        }
    }
    SEAM(pb + 1);
#ifdef MK_CLK
    if (L == 0 && blockIdx.x == 0 && threadIdx.x == 0) { unsigned long long* ts = WSP(unsigned long long, WS_SMALL + 64); ts[2] = __builtin_amdgcn_s_memtime(); ts[3] = __builtin_amdgcn_s_memrealtime(); }
#endif
    if (IN(pb + 2)) {
        const float* smallf = WSP(float, WS_SMALL);
        att::AttnArgs A{WSP(void, WS_CTL + 524288), WSP(bf16, WS_QKV), WSP(bf16, WS_QM), WSP(bf16, WS_KVM), WSP(bf16, WS_KR), WSP(bf16, WS_GATE), WSP(bf16, WS_Y), WSP(float, WS_SMALL + SM_BIAS), args.in[4] + L * 128, smallf[L], smallf[8 + L]};
        for (int p = vcu; p < 256; p += G) {
            const int bh = p >> 3, s = p & 7, b = bh >> 3, h = bh & 7;
            for (int pass_ = 0; pass_ < 2; ++pass_) {
                const bool mla_ = ((pass_ == 0) == ((s & 1) == 0)) || !MK_ATT_MIX;
                if (MK_ATT_MIX ? mla_ : pass_ == 0) { for (int i = 0; i < 2; ++i) att::attn_unit<false>(A, b, h, i == 0 ? 15 - s : s, lds + RING_OFF); }
                else { for (int i = 0; i < 4; ++i) att::attn_unit<true>(A, b, h, i == 0 ? 31 - 2 * s : i == 1 ? 30 - 2 * s : i == 2 ? 2 * s + 1 : 2 * s, lds + RING_OFF); }
            }
#if MK_ATT_PROBE
#ifndef MK_ATT_PROBE_KIND
#define MK_ATT_PROBE_KIND 3
#endif
            if (MK_ATT_PROBE_KIND & 1) for (int i = 0; i < 2; ++i) att::attn_unit<false, MK_ATT_PROBE>(A, b, h, i == 0 ? 15 - s : s, lds + RING_OFF);
            if (MK_ATT_PROBE_KIND & 2) for (int i = 0; i < 4; ++i) att::attn_unit<true, MK_ATT_PROBE>(A, b, h, i == 0 ? 31 - 2 * s : i == 1 ? 30 - 2 * s : i == 2 ? 2 * s + 1 : 2 * s, lds + RING_OFF);
#endif
        }
    }
#ifdef MK_CLK
    if (L == 0 && blockIdx.x == 0 && threadIdx.x == 0) { unsigned long long* ts = WSP(unsigned long long, WS_SMALL + 64); ts[4] = __builtin_amdgcn_s_memtime(); ts[5] = __builtin_amdgcn_s_memrealtime(); }
#endif
    SEAM(pb + 2);
    if (IN(pb + 3)) {
        pg8::Gemm g{WSP(bf16, WS_Y), WSP(bf16, WS_WOUT) + (size_t)L * DM * DM, MROWS, DM, DM}; pg8::StaticOrder S; S.init(MROWS, DM, G, bx);
        pg8::EpiResB<L != 0> E{L == 0 ? (const void*)args.in[0] : (const void*)WSP(bf16, WS_XB), WSP(bf16, WS_XB), DM};
        pg8::gemm_phase<pg8::EpiResB<L != 0>, pg8::StaticOrder, true, true>(ldsl + RING_OFF, g, S, E);
    }
    SEAM(pb + 3);
    if (IN(pb + 4)) {
        int tid_ = threadIdx.x; asm volatile("" : "+v"(tid_));
        const int lane = tid_ & 63, wave = __builtin_amdgcn_readfirstlane(tid_ >> 6); const int gw = vcu * NWAVES + wave, NGW = G * NWAVES;
        const bf16* XB = WSP(bf16, WS_XB);
        if (L == 0) { bf16* Hb = WSP(bf16, WS_H); const float* g = args.in[1] + DM;
            for (int m = gw; m < MROWS; m += NGW) rms_row_from_bf16<false>(XB + (size_t)m * DM, g, Hb + (size_t)m * DM, lane); }
        else { const float* g = args.in[11]; float* out = args.out;
            for (int m = gw; m < MROWS; m += NGW) rms_row_from_bf16<true>(XB + (size_t)m * DM, g, out + (size_t)m * DM, lane); }
    }
    SEAM(pb + 4);
}

__global__ void __launch_bounds__(NWAVES * 64, 2) mk_fwd(Args args) {
    extern __shared__ __attribute__((aligned(16))) unsigned char lds[];
    cg::grid_group grid = cg::this_grid();
    const int G = gridDim.x; const int bx = blockIdx.x; const int vcu = (G % 8 == 0) ? (bx % 8) * (G / 8) + bx / 8 : bx;
    const int lo = args.ph_lo, hi = args.ph_hi;
    volatile LAS unsigned* MISC = (volatile LAS unsigned*)((LAS unsigned char*)lds + MISC_OFF);
    if (threadIdx.x < 32) MISC[threadIdx.x] = 0u;
    __syncthreads();
    const XcdBarrier bar = xcd_barrier_post(WSP(unsigned, WS_CTL) + CW_BAR, MISC + 8);
    if (MK_CG_SEAM == -1 && lo == 0 && hi == N_PHASES) grid.sync();
    STAMP(0);
#ifdef MK_UB
    {
        typedef short ub8 __attribute__((ext_vector_type(8))); typedef float uf16 __attribute__((ext_vector_type(16))); typedef short us4 __attribute__((ext_vector_type(4)));
        LAS unsigned char* lb_ = (LAS unsigned char*)lds + (threadIdx.x & 63) * 16 + (threadIdx.x >> 6) * 8192;
        ub8 a_, b_; for (int i = 0; i < 8; ++i) { a_[i] = (short)(0x3c00 + threadIdx.x + i); b_[i] = (short)(0x3a00 + i); }
        for (int i = 0; i < 8; ++i) *(LAS ub8*)(lb_ + i * 1024) = a_;
        __syncthreads();
        uf16 acc_; for (int i = 0; i < 16; ++i) acc_[i] = 0.f;
        float x_[12]; for (int i = 0; i < 12; ++i) x_[i] = 0.001f * (float)(threadIdx.x + i);
        ub8 nx_ = *(LAS const ub8*)(lb_);
        for (int it = 0; it < MK_UB_IT; ++it) {
            ub8 cur_ = a_;
            if (MK_UB_LDS == 1) cur_ = *(LAS const ub8*)(lb_ + (it & 7) * 1024);
            if (MK_UB_LDS == 2) { cur_ = nx_; nx_ = *(LAS const ub8*)(lb_ + ((it + 1) & 7) * 1024); }
            if (MK_UB_LDS == 3) { cur_ = nx_; const us4 l_ = __builtin_bit_cast(us4, __builtin_amdgcn_ds_read_tr16_b64_v4i16((LAS us4*)(lb_ - (threadIdx.x & 63) * 8 + ((it + 1) & 7) * 1024))), h_ = __builtin_bit_cast(us4, __builtin_amdgcn_ds_read_tr16_b64_v4i16((LAS us4*)(lb_ - (threadIdx.x & 63) * 8 + ((it + 1) & 7) * 1024 + 512))); nx_ = (ub8){l_[0], l_[1], l_[2], l_[3], h_[0], h_[1], h_[2], h_[3]}; }
#if MK_UB_ACC == 1
            asm volatile("v_mfma_f32_32x32x16_bf16 %0, %1, %2, %0" : "+a"(acc_) : "v"(cur_), "v"(b_));
#elif MK_UB_ACC == 2
            asm volatile("v_mfma_f32_32x32x16_bf16 %0, %1, %2, %0" : "+v"(acc_) : "v"(cur_), "v"(b_));
#else
            acc_ = __builtin_amdgcn_mfma_f32_32x32x16_bf16(cur_, b_, acc_, 0, 0, 0);
#endif
#pragma unroll
            for (int i = 0; i < MK_UB_N; ++i) { if (MK_UB_EXP) x_[i] = __builtin_amdgcn_exp2f(x_[i]); else x_[i] = fmaf(x_[i], 0.999f, 0.001f); asm volatile("" : "+v"(x_[i])); }
            __builtin_amdgcn_sched_barrier(0);
        }
        float sum_ = acc_[0] + acc_[5]; for (int i = 0; i < 12; ++i) sum_ += x_[i];
        if (sum_ == 123456.789f) args.out[threadIdx.x] = sum_;
        __syncthreads();
    }
#endif
    if (IN(0)) { for (int rep_ = 0; rep_ < MK_REP_P0; ++rep_) prologue_phase(args, lds, G, vcu); }
    SEAM(0);
    layer_phases<0>(args, lds, grid, bar, lo, hi, G, bx, vcu);
    layer_phases<1>(args, lds, grid, bar, lo, hi, G, bx, vcu);
#ifdef MK_TPROF
    xcd_barrier(bar);
    { const unsigned long long* a_ = WSP(unsigned long long, WS_CTL + 524288); const float n_ = (float)a_[3];
      const float qa = floorf((float)a_[MK_TPROF_A] / n_ * (1.0f / MK_TPROF_Q) + 0.5f), qb = floorf((float)a_[MK_TPROF_B] / n_ * (1.0f / MK_TPROF_Q) + 0.5f);
      float* o = args.out; const int gt = blockIdx.x * 512 + threadIdx.x;
      for (int i = gt; i < MROWS * DM; i += gridDim.x * 512) o[i] = (i == 0) ? 16.f * qb : qa; }
#endif
#ifdef MK_CLK
    xcd_barrier(bar);
    { const unsigned long long* ts = WSP(unsigned long long, WS_SMALL + 64);
      const float ca = (float)(ts[4] - ts[2]) / (float)(ts[5] - ts[3]), cg = (float)(ts[12] - ts[10]) / (float)(ts[13] - ts[11]);
      const float qa = floorf(ca + 0.5f), qg = floorf(cg + 0.5f);
      float* o = args.out; const int gt = blockIdx.x * 512 + threadIdx.x;
      for (int i = gt; i < MROWS * DM; i += gridDim.x * 512) o[i] = (i == 0) ? 16.f * qg : qa; }
#endif
#ifdef MK_STAMP
    xcd_barrier(bar);
    { const unsigned long long* ts = WSP(unsigned long long, WS_SMALL + 64);
      float da = 0.f, db = 0.f;
      for (int p = 0; p < N_PHASES; ++p) { const int kind = p == 0 ? 0 : 1 + (p - 1) % 6; const float d = (float)(ts[p + 1] - ts[p]) * 0.01f; if (kind == MK_STAMP_A) da += d; if (kind == MK_STAMP_B) db += d; }
      float* o = args.out; const int gt = blockIdx.x * 512 + threadIdx.x;
      for (int i = gt; i < MROWS * DM; i += gridDim.x * 512) o[i] = (i == 0) ? 16.f * db : da; }
#endif
}
#undef IN
#undef SEAM
#undef WSP

#ifndef MK_PH_MAX
#define MK_PH_MAX N_PHASES
#endif
#ifndef MK_PH_MIN
#define MK_PH_MIN 0
#endif
#ifndef MK_LAUNCH_PER_PHASE
#define MK_LAUNCH_PER_PHASE 0
#endif
__global__ void diag_fill(float* o, int n, float c) { for (int i = blockIdx.x * 256 + threadIdx.x; i < n; i += gridDim.x * 256) o[i] = c; }
#ifdef MK_UBK
__global__ void __launch_bounds__(512, 2) ub_kernel(float* out) {
    typedef short ub8 __attribute__((ext_vector_type(8))); typedef float uf16 __attribute__((ext_vector_type(16)));
    ub8 a_, b_; for (int i = 0; i < 8; ++i) { a_[i] = (short)(0x3c00 + threadIdx.x + i); b_[i] = (short)(0x3a00 + i); }
    uf16 acc_; for (int i = 0; i < 16; ++i) acc_[i] = 0.f;
    float x_[12]; for (int i = 0; i < 12; ++i) x_[i] = 0.001f * (float)(threadIdx.x + i);
    for (int it = 0; it < MK_UBK_IT; ++it) {
#if MK_UBK_ACC == 1
        asm volatile("v_mfma_f32_32x32x16_bf16 %0, %1, %2, %0" : "+a"(acc_) : "v"(a_), "v"(b_));
#else
        asm volatile("v_mfma_f32_32x32x16_bf16 %0, %1, %2, %0" : "+v"(acc_) : "v"(a_), "v"(b_));
#endif
#pragma unroll
        for (int i = 0; i < MK_UBK_N; ++i) { x_[i] = fmaf(x_[i], 0.999f, 0.001f); asm volatile("" : "+v"(x_[i])); }
        __builtin_amdgcn_sched_barrier(0);
    }
    float sum_ = acc_[0] + acc_[5]; for (int i = 0; i < 12; ++i) sum_ += x_[i];
    if (sum_ == 123456.789f) out[threadIdx.x] = sum_;
}
#endif
extern "C" void kernel_launch(void* const* d_in, const int* in_sizes, int n_in, void* d_out, int out_size, void* d_ws, size_t ws_size, hipStream_t stream) {
    static int grid = 0;
    if (grid == 0) {
        if (n_in != 12 || in_sizes[0] != MROWS * DM || out_size != MROWS * DM || ws_size < WS_END) {
            fprintf(stderr, "kernel_launch: unexpected shapes: n_in %d in0 %d out %d ws %zu (need >= %zu)\n", n_in, n_in > 0 ? in_sizes[0] : -1, out_size, ws_size, (size_t)WS_END);
            const float code = (n_in != 12) ? 30.f : (in_sizes[0] != MROWS * DM) ? 40.f : (out_size != MROWS * DM) ? 50.f : (float)(ws_size >> 26);
            hipLaunchKernelGGL(diag_fill, dim3(1024), dim3(256), 0, stream, (float*)d_out, out_size, code); return; }
        int dev = 0, cus = 0, per_cu = 0;
        if (hipGetDevice(&dev) != hipSuccess || hipDeviceGetAttribute(&cus, hipDeviceAttributeMultiprocessorCount, dev) != hipSuccess) { fprintf(stderr, "kernel_launch: device query failed\n"); grid = -1; return; }
        if (hipFuncSetAttribute((const void*)mk_fwd, hipFuncAttributeMaxDynamicSharedMemorySize, LDS_BYTES) != hipSuccess) { fprintf(stderr, "kernel_launch: hipFuncSetAttribute failed\n"); grid = -1; return; }
        if (hipOccupancyMaxActiveBlocksPerMultiprocessor(&per_cu, (const void*)mk_fwd, NWAVES * 64, LDS_BYTES) != hipSuccess || per_cu < 1) {
            fprintf(stderr, "kernel_launch: occupancy query reports %d workgroups per CU\n", per_cu); (void)hipGetLastError(); per_cu = 1; }
        grid = cus;
        if (grid > 256) grid = 256;
    }
    if (grid < 0) return;
    (void)hipMemsetAsync((char*)d_ws + WS_CTL, 0, CTL_ZERO_BYTES, stream);
#ifdef MK_UBK
    hipLaunchKernelGGL(ub_kernel, dim3(256), dim3(512), 0, stream, (float*)d_ws + (WS_END >> 2) - 4096);
#endif
    Args a{};
    for (int i = 0; i < 12; ++i) a.in[i] = (const float*)d_in[i];
    a.out = (float*)d_out; a.ws = (unsigned char*)d_ws;
#if MK_LAUNCH_PER_PHASE
    for (int p = MK_PH_MIN; p < MK_PH_MAX; ++p) { a.ph_lo = p; a.ph_hi = p + 1; hipLaunchKernelGGL(mk_fwd, dim3(grid), dim3(NWAVES * 64), LDS_BYTES, stream, a); }
    { const hipError_t le = hipPeekAtLastError(); if (le != hipSuccess) fprintf(stderr, "kernel_launch: launch failed: %s\n", hipGetErrorName(le)); }
#else
    a.ph_lo = 0; a.ph_hi = N_PHASES;
    void* kargs[] = {&a};
    const hipError_t e = hipLaunchCooperativeKernel((const void*)mk_fwd, dim3(grid), dim3(NWAVES * 64), kargs, LDS_BYTES, stream);
    if (e != hipSuccess) fprintf(stderr, "kernel_launch: cooperative launch failed: %s (grid %d)\n", hipGetErrorString(e), grid);
#endif
}
```
